# Optimizing an MI355X kernel written in HIP

```python
import math
import jax, jax.numpy as jnp
from jax import lax
import numpy as np

D_MODEL = 2048
BATCH = 2
SEQ = 4096
DEPTH = 2

HEAD_DIM = 128
N_HEADS = D_MODEL // HEAD_DIM
NA_HEADS = N_HEADS // 2
DA_HEADS = N_HEADS - NA_HEADS
DA_QK_DIM = HEAD_DIM // 2
GRID_W = 64
NA_KH = 8
NA_KW = 16
ROPE_THETA = 10000.0
Q_BLOCK = 128
IN_COLS = 3 * (NA_HEADS + DA_HEADS) * HEAD_DIM
MIX_WIDTH = (NA_HEADS + DA_HEADS) * HEAD_DIM
LRU_WIDTH = D_MODEL
LRU_BLOCKS = 16
LRU_BLOCK_DIM = LRU_WIDTH // LRU_BLOCKS
CONV_WIDTH = 4
CONV_PAD_LEFT = (CONV_WIDTH - 1) // 2
CONV_PAD_RIGHT = CONV_WIDTH - 1 - CONV_PAD_LEFT
LRU_C = 8.0
D_FF = 7 * D_MODEL // 2
N_EXPERTS = 8
TOP_K = 2
D_FF_EXPERT = 7 * D_MODEL // 2
N_EVEN = (DEPTH + 1) // 2
N_ODD = DEPTH // 2
EPS = 1e-6
NEG_INF = -1e30

kernel_name = "hybrid_natten_diffattn_rglru_moe_encoder"


def rms_norm(x, g):
    xf = x.astype(jnp.float32)
    y = xf * lax.rsqrt(jnp.mean(xf * xf, axis=-1, keepdims=True) + EPS)
    return (y * g.astype(jnp.float32)).astype(x.dtype)


def swiglu(h, wg, wu, wd):
    return (jax.nn.silu(h @ wg) * (h @ wu)) @ wd


def rope_tables(seq, dim):
    inv = 1.0 / (ROPE_THETA ** (jnp.arange(0, dim, 2, dtype=jnp.float32) / dim))
    ang = jnp.arange(seq, dtype=jnp.float32)[:, None] * inv[None, :]
    return jnp.cos(ang), jnp.sin(ang)


def apply_rope(x, cos, sin):
    x1, x2 = jnp.split(x, 2, axis=-1)
    c, s = cos.astype(x.dtype), sin.astype(x.dtype)
    return jnp.concatenate([x1 * c - x2 * s, x2 * c + x1 * s], axis=-1)


def neighbourhood_attention(q, k, v, rpb):
    b, s, h, d = q.shape
    rows = s // GRID_W
    kh = min(NA_KH, rows)
    kw = min(NA_KW, GRID_W)
    r = jnp.arange(rows)
    r_start = jnp.clip(r - kh // 2, 0, rows - kh)
    row_idx = r_start[:, None] + jnp.arange(kh)[None, :]
    row_off = row_idx - r[:, None]
    c = jnp.arange(GRID_W)
    c_start = jnp.clip(c - kw // 2, 0, GRID_W - kw)
    col_in = (c[None, :] >= c_start[:, None]) & (c[None, :] < c_start[:, None] + kw)
    col_off = jnp.clip(c[None, :] - c[:, None], -(NA_KW - 1), NA_KW - 1)
    qg = q.reshape(b, rows, GRID_W, h, d)
    kg = k.reshape(b, rows, GRID_W, h, d)[:, row_idx]
    vg = v.reshape(b, rows, GRID_W, h, d)[:, row_idx]
    scores = jnp.einsum('brqhd,brikhd->bhrqik', qg, kg,
                        preferred_element_type=jnp.float32) * (d ** -0.5)
    bias = rpb[:, (row_off + NA_KH - 1)[:, None, :, None],
               (col_off + NA_KW - 1)[None, :, None, :]].astype(jnp.float32)
    scores = jnp.where(col_in[:, None, :], scores + bias[None], NEG_INF)
    p = jax.nn.softmax(scores.reshape(b, h, rows, GRID_W, kh * GRID_W), axis=-1)
    p = p.reshape(b, h, rows, GRID_W, kh, GRID_W).astype(v.dtype)
    out = jnp.einsum('bhrqik,brikhd->brqhd', p, vg)
    return out.reshape(b, s, h * d)


def differential_attention(q, k, v, lq1, lk1, lq2, lk2, subln, lambda_init):
    b, s, h, _, dq = q.shape
    dv = v.shape[-1]
    cos, sin = rope_tables(s, dq)
    cos, sin = cos[:, None, None, :], sin[:, None, None, :]
    q = apply_rope(q, cos, sin)
    k = apply_rope(k, cos, sin)
    lam = (jnp.exp(jnp.sum((lq1 * lk1).astype(jnp.float32)))
           - jnp.exp(jnp.sum((lq2 * lk2).astype(jnp.float32))) + lambda_init)
    scale = dq ** -0.5
    n_blk = s // Q_BLOCK
    qb = q.reshape(b, n_blk, Q_BLOCK, h, 2, dq).transpose(1, 0, 2, 3, 4, 5)

    def block(q_blk):
        sc = jnp.einsum('bqhcd,bkhcd->bchqk', q_blk, k,
                        preferred_element_type=jnp.float32) * scale
        p = jax.nn.softmax(sc, axis=-1)
        attn = (p[:, 0] - lam * p[:, 1]).astype(v.dtype)
        return jnp.einsum('bhqk,bkhd->bqhd', attn, v)

    o = lax.map(block, qb)
    o = o.transpose(1, 0, 2, 3, 4).reshape(b, s, h, dv)
    o = rms_norm(o, subln) * (1.0 - lambda_init)
    return o.reshape(b, s, h * dv)


def _lin_combine(left, right):
    a1, b1 = left
    a2, b2 = right
    return a1 * a2, a2 * b1 + b2


def rg_lru(u, w_a, b_a, w_x, b_x, a_param, reverse):
    b, s, _ = u.shape
    ub = u.reshape(b, s, LRU_BLOCKS, LRU_BLOCK_DIM)
    gate_a = jax.nn.sigmoid(jnp.einsum('bsni,nij->bsnj', ub, w_a) + b_a.reshape(LRU_BLOCKS, LRU_BLOCK_DIM))
    gate_x = jax.nn.sigmoid(jnp.einsum('bsni,nij->bsnj', ub, w_x) + b_x.reshape(LRU_BLOCKS, LRU_BLOCK_DIM))
    gate_a = gate_a.reshape(b, s, LRU_WIDTH).astype(jnp.float32)
    gate_x = gate_x.reshape(b, s, LRU_WIDTH)
    log_a = -LRU_C * gate_a * jax.nn.softplus(-a_param.astype(jnp.float32))
    a = jnp.exp(log_a)
    mult = jnp.sqrt(-jnp.expm1(2.0 * log_a))
    bt = mult * (gate_x * u).astype(jnp.float32)
    _, hs = lax.associative_scan(_lin_combine, (a, bt), axis=1, reverse=reverse)
    return hs.astype(u.dtype)


def moe_swiglu(h, router, wg, wu, wd):
    b, s, d = h.shape
    t = h.reshape(b * s, d)
    logits = (t @ router).astype(jnp.float32)
    top_vals, top_idx = lax.top_k(logits, TOP_K)
    gates = jax.nn.softmax(top_vals, axis=-1)
    combine = jnp.sum(jax.nn.one_hot(top_idx, N_EXPERTS, dtype=jnp.float32) * gates[..., None], axis=1)
    combine = combine.astype(t.dtype)
    out = jnp.zeros_like(t)
    for e in range(N_EXPERTS):
        out = out + combine[:, e:e + 1] * swiglu(t, wg[e], wu[e], wd[e])
    return out.reshape(b, s, d)


def setup_inputs(seed: int = 0) -> dict:
    key = jax.random.key(seed)
    ks = iter(jax.random.split(key, 40))
    nrm = lambda shape, scale: jax.random.normal(next(ks), shape, jnp.float32) * scale
    gain = lambda shape: 1.0 + nrm(shape, 0.01)
    NE, NO, D = N_EVEN, N_ODD, D_MODEL
    a_init = jax.random.uniform(next(ks), (NO, 2, LRU_WIDTH), jnp.float32, 0.9, 0.999)
    return {
        "x": nrm((BATCH, SEQ, D), 1.0),
        "ev_mix_norm": gain((NE, D)),
        "ev_w_in": nrm((NE, D, IN_COLS), D ** -0.5),
        "ev_na_rpb": nrm((NE, NA_HEADS, 2 * NA_KH - 1, 2 * NA_KW - 1), 0.1),
        "ev_da_lambda_q1": nrm((NE, DA_QK_DIM), 0.1),
        "ev_da_lambda_k1": nrm((NE, DA_QK_DIM), 0.1),
        "ev_da_lambda_q2": nrm((NE, DA_QK_DIM), 0.1),
        "ev_da_lambda_k2": nrm((NE, DA_QK_DIM), 0.1),
        "ev_da_subln": gain((NE, HEAD_DIM)),
        "ev_w_out": nrm((NE, MIX_WIDTH, D), MIX_WIDTH ** -0.5),
        "ev_ffn_norm": gain((NE, D)),
        "ev_ffn_w_gate": nrm((NE, D, D_FF), D ** -0.5),
        "ev_ffn_w_up": nrm((NE, D, D_FF), D ** -0.5),
        "ev_ffn_w_down": nrm((NE, D_FF, D), D_FF ** -0.5),
        "od_mix_norm": gain((NO, D)),
        "od_w_in": nrm((NO, D, 2 * LRU_WIDTH), D ** -0.5),
        "od_conv_w": nrm((NO, CONV_WIDTH, LRU_WIDTH), CONV_WIDTH ** -0.5),
        "od_conv_b": nrm((NO, LRU_WIDTH), 0.01),
        "od_lru_w_a": nrm((NO, 2, LRU_BLOCKS, LRU_BLOCK_DIM, LRU_BLOCK_DIM), LRU_BLOCK_DIM ** -0.5),
        "od_lru_b_a": nrm((NO, 2, LRU_WIDTH), 0.1),
        "od_lru_w_x": nrm((NO, 2, LRU_BLOCKS, LRU_BLOCK_DIM, LRU_BLOCK_DIM), LRU_BLOCK_DIM ** -0.5),
        "od_lru_b_x": nrm((NO, 2, LRU_WIDTH), 0.1),
        "od_lru_a_param": jnp.log(a_init) - jnp.log1p(-a_init),
        "od_w_out": nrm((NO, LRU_WIDTH, D), LRU_WIDTH ** -0.5),
        "od_ffn_norm": gain((NO, D)),
        "od_router": nrm((NO, D, N_EXPERTS), D ** -0.5),
        "od_moe_w_gate": nrm((NO, N_EXPERTS, D, D_FF_EXPERT), D ** -0.5),
        "od_moe_w_up": nrm((NO, N_EXPERTS, D, D_FF_EXPERT), D ** -0.5),
        "od_moe_w_down": nrm((NO, N_EXPERTS, D_FF_EXPERT, D), D_FF_EXPERT ** -0.5),
        "final_norm": gain((D,)),
    }


def reference(x, ev_mix_norm, ev_w_in, ev_na_rpb, ev_da_lambda_q1, ev_da_lambda_k1,
              ev_da_lambda_q2, ev_da_lambda_k2, ev_da_subln, ev_w_out, ev_ffn_norm,
              ev_ffn_w_gate, ev_ffn_w_up, ev_ffn_w_down, od_mix_norm, od_w_in, od_conv_w,
              od_conv_b, od_lru_w_a, od_lru_b_a, od_lru_w_x, od_lru_b_x, od_lru_a_param,
              od_w_out, od_ffn_norm, od_router, od_moe_w_gate, od_moe_w_up, od_moe_w_down,
              final_norm):
    b, s, _ = x.shape
    na_w = NA_HEADS * HEAD_DIM
    da_w = DA_HEADS * HEAD_DIM
    split_at = (na_w, 2 * na_w, 3 * na_w, 3 * na_w + da_w, 3 * na_w + 2 * da_w)
    for layer in range(DEPTH):
        if layer % 2 == 0:
            i = layer // 2
            lambda_init = 0.8 - 0.6 * math.exp(-0.3 * layer)
            h = rms_norm(x, ev_mix_norm[i])
            proj = h @ ev_w_in[i]
            na_q, na_k, na_v, da_q, da_k, da_v = jnp.split(proj, split_at, axis=-1)
            na_out = neighbourhood_attention(
                na_q.reshape(b, s, NA_HEADS, HEAD_DIM), na_k.reshape(b, s, NA_HEADS, HEAD_DIM),
                na_v.reshape(b, s, NA_HEADS, HEAD_DIM), ev_na_rpb[i])
            da_out = differential_attention(
                da_q.reshape(b, s, DA_HEADS, 2, DA_QK_DIM), da_k.reshape(b, s, DA_HEADS, 2, DA_QK_DIM),
                da_v.reshape(b, s, DA_HEADS, HEAD_DIM), ev_da_lambda_q1[i], ev_da_lambda_k1[i],
                ev_da_lambda_q2[i], ev_da_lambda_k2[i], ev_da_subln[i], lambda_init)
            x = x + jnp.concatenate([na_out, da_out], axis=-1) @ ev_w_out[i]
            h = rms_norm(x, ev_ffn_norm[i])
            x = x + swiglu(h, ev_ffn_w_gate[i], ev_ffn_w_up[i], ev_ffn_w_down[i])
        else:
            i = layer // 2
            h = rms_norm(x, od_mix_norm[i])
            proj = h @ od_w_in[i]
            gate_branch, rec_branch = jnp.split(proj, 2, axis=-1)
            y = jax.nn.gelu(gate_branch)
            u = lax.conv_general_dilated(
                rec_branch, od_conv_w[i][:, None, :], window_strides=(1,),
                padding=[(CONV_PAD_LEFT, CONV_PAD_RIGHT)],
                dimension_numbers=('NWC', 'WIO', 'NWC'),
                feature_group_count=LRU_WIDTH) + od_conv_b[i]
            h_fwd = rg_lru(u, od_lru_w_a[i, 0], od_lru_b_a[i, 0], od_lru_w_x[i, 0],
                           od_lru_b_x[i, 0], od_lru_a_param[i, 0], reverse=False)
            h_bwd = rg_lru(u, od_lru_w_a[i, 1], od_lru_b_a[i, 1], od_lru_w_x[i, 1],
                           od_lru_b_x[i, 1], od_lru_a_param[i, 1], reverse=True)
            x = x + (y * (h_fwd + h_bwd)) @ od_w_out[i]
            h = rms_norm(x, od_ffn_norm[i])
            x = x + moe_swiglu(h, od_router[i], od_moe_w_gate[i], od_moe_w_up[i], od_moe_w_down[i])
    return rms_norm(x, final_norm)
```

```cpp
#include <hip/hip_runtime.h>
#include <stdint.h>
#include <stdio.h>

typedef unsigned short bf16_t;
typedef short bf16x8 __attribute__((ext_vector_type(8)));
typedef float f32x4 __attribute__((ext_vector_type(4)));

constexpr int NB = 2, S = 4096, T = NB * S, D = 2048;
constexpr int HD = 128, NAH = 8, DAH = 8, DQ = 64;
constexpr int GW = 64, GR = S / GW, KH = 8, KW = 16;
constexpr int INC = 6144, FF = 7168, NE = 8;
constexpr int LB = 16, LBD = 128;
constexpr float EPS = 1e-6f;

constexpr size_t MiB = 1048576;
constexpr size_t WS_WBF = 0;
constexpr size_t WS_X1 = 816 * MiB;
constexpr size_t WS_X2 = WS_X1 + 64 * MiB;
constexpr size_t WS_HA = WS_X2 + 64 * MiB;
constexpr size_t WS_HB = WS_HA + 32 * MiB;
constexpr size_t WS_R1 = WS_HB + 32 * MiB;
constexpr size_t WS_QKV = WS_R1;
constexpr size_t WS_ATT = WS_R1 + 96 * MiB;
constexpr size_t WS_ACT = WS_R1 + 128 * MiB;
constexpr size_t WS_AB = WS_R1;
constexpr size_t WS_R2 = WS_R1 + 256 * MiB;
constexpr size_t WS_Y = WS_R2;
constexpr size_t WS_REC = WS_R2 + 32 * MiB;
constexpr size_t WS_U = WS_R2 + 96 * MiB;
constexpr size_t WS_Z = WS_R2 + 160 * MiB;
constexpr size_t WS_R3 = WS_R2 + 192 * MiB;
constexpr size_t WS_HF = WS_R3;
constexpr size_t WS_HBW = WS_R3 + 64 * MiB;
constexpr size_t WS_MISC = WS_R3 + 128 * MiB;
constexpr size_t WS_ROPE = WS_MISC;
constexpr size_t WS_COMB = WS_MISC + 1 * MiB;
constexpr size_t WS_C8SP = WS_COMB + 768 * 1024;
constexpr size_t WS_LIST = WS_COMB + 256 * 1024;
constexpr size_t WS_GATEW = WS_COMB + 512 * 1024;
constexpr size_t WS_MACT = WS_R1;
constexpr size_t WS_PARTK = WS_R1 + 128 * MiB;
constexpr size_t WS_INV = WS_COMB + 576 * 1024;
constexpr size_t WS_CONTRIB = WS_R2;
constexpr size_t WS_END = WS_MISC + 2 * MiB;

__device__ __forceinline__ bf16_t f2bf(float f) { unsigned u = __float_as_uint(f); u += 0x7FFFu + ((u >> 16) & 1u); return (bf16_t)(u >> 16); }
__device__ __forceinline__ float bf2f(bf16_t b) { return __uint_as_float(((unsigned)b) << 16); }
__device__ __forceinline__ float wave_sum(float v) {
#pragma unroll
    for (int o = 1; o < 64; o <<= 1) v += __shfl_xor(v, o);
    return v;
}
__device__ __forceinline__ float wave_max(float v) {
#pragma unroll
    for (int o = 1; o < 64; o <<= 1) v = fmaxf(v, __shfl_xor(v, o));
    return v;
}
__device__ __forceinline__ float sigmoidf_(float x) { return 1.f / (1.f + expf(-x)); }
__device__ __forceinline__ float siluf_(float x) { return x / (1.f + expf(-x)); }
__device__ __forceinline__ float gelu_tanh(float x) { const float u = 0.7978845608028654f * (x + 0.044715f * x * x * x); return 0.5f * x * (1.f + tanhf(u)); }

#define LAS __attribute__((address_space(3)))
#define GAS __attribute__((address_space(1)))
typedef unsigned u32x4 __attribute__((ext_vector_type(4)));
typedef unsigned u32x2 __attribute__((ext_vector_type(2)));
typedef float f32x2 __attribute__((ext_vector_type(2)));
constexpr int NWAVES = 8, NTHR = 512;
constexpr int BM = 256, BK = 64, HALF = 128, HTB = HALF * BK * 2, STAGE_BYTES = 8 * HTB, NXCD = 8, WGM = 8;
constexpr int MISC_OFF = STAGE_BYTES, LDS_BYTES = STAGE_BYTES + 16384;
constexpr size_t WT_IN0 = 0;
constexpr size_t WT_OUT0 = WT_IN0 + (size_t)INC * D;
constexpr size_t WT_GU0 = WT_OUT0 + (size_t)D * D;
constexpr size_t WT_DN0 = WT_GU0 + (size_t)2 * FF * D;
constexpr size_t WT_IN1 = WT_DN0 + (size_t)FF * D;
constexpr size_t WT_OUT1 = WT_IN1 + (size_t)2 * D * D;
constexpr size_t WT_LRU = WT_OUT1 + (size_t)D * D;
constexpr size_t WT_MGU = WT_LRU + (size_t)2 * 2 * LB * LBD * LBD;
constexpr size_t WT_MDN = WT_MGU + (size_t)NE * 2 * FF * D;
constexpr size_t WT_END = WT_MDN + (size_t)NE * FF * D;
static_assert(WT_END * 2 <= 816 * MiB, "weights region");
constexpr size_t WS_CTL = WS_END;
constexpr size_t CTL_BYTES = 256 * 1024;
constexpr int CW_BAR = 0;
constexpr int CW_CNT = 4096;
constexpr int CW_XRANK = 8192;
constexpr int CW_AQ = 8192 + 1024;
#define CW_CVQ (8192 + 2048)
#ifndef NCV_PER_XCD
#define NCV_PER_XCD 16
#endif
constexpr size_t WS_XB = WS_CTL + CTL_BYTES;
constexpr size_t WS_PART = WS_XB + 32 * MiB;
constexpr size_t WS_SUMM = WS_PART + 1 * MiB;
constexpr size_t WS_CARRY = WS_SUMM + 8 * MiB;
constexpr size_t WS_END2 = WS_CARRY + 4 * MiB;

__device__ __forceinline__ int opaque_tid() { int t = threadIdx.x; asm volatile("" : "+v"(t)); return t; }
__device__ __forceinline__ float sat8(float x) { return __builtin_amdgcn_fmed3f(x, -448.f, 448.f); }
__device__ __forceinline__ unsigned pk4_fp8(float a, float b, float c, float d) { unsigned w = 0; w = __builtin_amdgcn_cvt_pk_fp8_f32(sat8(a), sat8(b), w, false); w = __builtin_amdgcn_cvt_pk_fp8_f32(sat8(c), sat8(d), w, true); return w; }
constexpr float W8_SCALE = 64.f, W8_INV = 1.f / 64.f;
#ifndef FFN_F8
#define FFN_F8 0
#endif
constexpr bool FFN8 = FFN_F8;
#define XB_TMO      128
#define XB_XCNT(j)  (256  + 64 * (j))
#define XB_XSUB(j)  (1280 + 64 * (j))
#define XB_XGEN(j)  (2304 + 64 * (j))
#define XB_TOP      3328
#define XB_TOPGEN   3392
#define XCD_BAR_WORDS 3456
#define XB_SPIN_CAP (1u << 18)
__device__ __forceinline__ unsigned xb_ld(unsigned* p)              { return __hip_atomic_load(p, __ATOMIC_RELAXED, __HIP_MEMORY_SCOPE_AGENT); }
__device__ __forceinline__ unsigned xb_add(unsigned* p, unsigned v) { return __hip_atomic_fetch_add(p, v, __ATOMIC_RELAXED, __HIP_MEMORY_SCOPE_AGENT); }
__device__ __forceinline__ unsigned xb_xcc_id() { return (unsigned)__builtin_amdgcn_s_getreg((3 << 11) | 20) & 0xFu; }
#define XB_SPIN(cond, bar) do { unsigned _sp = 0; while (cond) { __builtin_amdgcn_s_sleep(1); \
    if ((++_sp & 255u) == 0u) { if (xb_ld(&(bar)[XB_TMO])) break; if (_sp > XB_SPIN_CAP) { atomicAdd(&(bar)[XB_TMO], 1u); break; } } } } while (0)
struct XcdBarrier { unsigned* bar; unsigned x; volatile LAS unsigned* st; };
__device__ __forceinline__ XcdBarrier xcd_barrier_post(unsigned* bar, volatile LAS unsigned* st) {
    XcdBarrier b; b.bar = bar; b.x = xb_xcc_id(); b.st = st;
    if (threadIdx.x == 0) (void)xb_add(&bar[XB_XCNT(b.x)], 1u);
    return b;
}
__device__ __forceinline__ void xcd_barrier_complete(unsigned* bar, unsigned x, unsigned& nloc, unsigned& nx) {
    const unsigned G = gridDim.x * gridDim.y * gridDim.z;
    unsigned sum, cnt, mine, sp = 0u;
    for (;;) {
        sum = 0u; cnt = 0u; mine = 0u;
#pragma unroll
        for (unsigned j = 0; j < 16; ++j) { const unsigned c = xb_ld(&bar[XB_XCNT(j)]); sum += c; cnt += (c > 0u) ? 1u : 0u; mine = (j == x) ? c : mine; }
        if (sum == G) break;
        __builtin_amdgcn_s_sleep(1);
        if ((++sp & 255u) == 0u) { if (xb_ld(&bar[XB_TMO])) break; if (sp > XB_SPIN_CAP) { atomicAdd(&bar[XB_TMO], 1u); break; } }
    }
    nloc = mine > 0u ? mine : 1u; nx = cnt > 0u ? cnt : 1u;
}
__device__ __forceinline__ void xcd_barrier(const XcdBarrier& b) {
    asm volatile("s_waitcnt vmcnt(0)" ::: "memory");
    __syncthreads();
    if (threadIdx.x == 0) {
        unsigned* bar = b.bar;
        __builtin_amdgcn_s_waitcnt(0);
        unsigned nloc = b.st[0], nx = b.st[1];
        if (nloc == 0u) { xcd_barrier_complete(bar, b.x, nloc, nx); b.st[0] = nloc; b.st[1] = nx; }
        const unsigned old = xb_add(&bar[XB_XSUB(b.x)], 1u);
        const unsigned gen = old / nloc;
        if (old + 1u == (gen + 1u) * nloc) {
            __builtin_amdgcn_fence(__ATOMIC_RELEASE, "agent");
            asm volatile("s_waitcnt vmcnt(0)" ::: "memory");
            const unsigned og = xb_add(&bar[XB_TOP], 1u);
            const unsigned tg = og / nx;
            if (og + 1u == (tg + 1u) * nx) xb_add(&bar[XB_TOPGEN], 1u);
            else XB_SPIN(xb_ld(&bar[XB_TOPGEN]) == tg, bar);
            __builtin_amdgcn_fence(__ATOMIC_ACQUIRE, "agent");
            xb_add(&bar[XB_XGEN(b.x)], 1u);
            asm volatile("s_waitcnt vmcnt(0)" ::: "memory");
        } else {
            XB_SPIN(xb_ld(&bar[XB_XGEN(b.x)]) == gen, bar);
            __builtin_amdgcn_fence(__ATOMIC_ACQUIRE, "agent");
            asm volatile("s_waitcnt vmcnt(0)" ::: "memory");
        }
    }
    __syncthreads();
}

__host__ __device__ __forceinline__ int lds_byte(int r, int c) { const int st = (r >> 4) * 2 + (c >> 5), rr = r & 15, cc = c & 31, ob = rr * 64 + cc * 2; return st * 1024 + (ob ^ (((ob >> 9) & 1) << 5)); }
__host__ __device__ __forceinline__ void stage_rc(int b, int& R, int& C) { const int st = b / 1024, sb = b % 1024, swz = sb ^ (((sb >> 9) & 1) << 5); R = (st >> 1) * 16 + swz / 64; C = (st & 1) * 32 + (swz % 64) / 2; }
__host__ __device__ __forceinline__ int perm32(int rho) { const int n = rho >> 4, i = rho & 15; return 8 * (i >> 2) + 4 * n + (i & 3); }
__device__ __forceinline__ unsigned cvt_pk_bf16(float lo, float hi) { unsigned r; asm volatile("v_cvt_pk_bf16_f32 %0, %1, %2" : "=v"(r) : "v"(lo), "v"(hi)); return r; }

struct Unit { int pm, pn, e, r0, cnt, k0, nkt, kq, ridx; };
struct Gemm { const bf16_t* A; const bf16_t* Bt; int N, K; size_t bstride; };

struct StaticOrder {
    int nM, nN, nwg, G, c;
    __device__ void init(int M, int N, int G_, int c_) { nM = M / BM; nN = N / BM; nwg = nM * nN; G = G_; c = c_; }
    __device__ bool next(int i, Unit& u) const {
        const long L = (long)i * G + c; if (L >= nwg) return false;
        int wgid = (int)L; { const int q = nwg / NXCD, r = nwg % NXCD, xcd = wgid % NXCD, off = wgid / NXCD; wgid = (xcd < r ? xcd * (q + 1) : r * (q + 1) + (xcd - r) * q) + off; }
        const int nig = WGM * nN, gid = wgid / nig, fm = gid * WGM, gsz = (nM - fm) < WGM ? (nM - fm) : WGM;
        u.pm = fm + ((wgid % nig) % gsz); u.pn = (wgid % nig) / gsz; u.e = 0; u.r0 = 0; u.cnt = 0; u.k0 = 0; u.nkt = 0; u.kq = -1; u.ridx = 0; return true;
    }
    __device__ __forceinline__ int arow(const Unit& u, int lr) const { return u.pm * BM + lr; }
};

typedef int i32x8 __attribute__((ext_vector_type(8)));
typedef int i32x4 __attribute__((ext_vector_type(4)));
template <class Epi, class Sched, int BL, bool GATHER, bool F8 = false>
__device__ __forceinline__ void gemm_phase(LAS unsigned char* lds, const Gemm g, const Sched& S, const Epi& E) {
    const int tid = opaque_tid(), wid = __builtin_amdgcn_readfirstlane(tid >> 6), lane = tid & 63, wr = wid >> 2, wc = wid & 3, fr = lane & 15, fq = lane >> 4;
    constexpr int ESZ = F8 ? 1 : 2;
    const int K = g.K, KB = K * ESZ, nt = KB / 128;
    unsigned voffA[2], voffB[2], CA[2]; int RA[2];
#pragma unroll
    for (int i = 0; i < 2; ++i) { int R, C; stage_rc(tid * 16 + i * 8192, R, C); RA[i] = R; CA[i] = (unsigned)C * 2u;
        int Rb = R; if (BL >= 1) Rb = (R & ~31) + perm32(R & 31); if (BL == 2) Rb = 64 * (Rb >> 5) + (Rb & 31);
        voffA[i] = (unsigned)(R * KB) + (unsigned)C * 2u; voffB[i] = (unsigned)(Rb * 128) + (unsigned)C * 2u; }
    const size_t kstep = 128, kstepB = 256 * 128;
    const size_t hstep = (size_t)HALF * KB;
    const size_t hstepB = (BL == 2) ? (size_t)32 * 128 : (size_t)HALF * 128;
    const size_t tstep = 2 * hstep;
    const unsigned ldsw = (unsigned)wid * 1024u;
    const int aoff = F8 ? lds_byte(wr * 64 + fr, fq * 16) : lds_byte(wr * 64 + fr, fq * 8), boff = F8 ? lds_byte(wc * 32 + fr, fq * 16) : lds_byte(wc * 32 + fr, fq * 8);
#define PG8_SA(b, h) (((b) * 2 + (h)) * HTB)
#define PG8_SB(b, h) ((4 + (b) * 2 + (h)) * HTB)
#define PG8_STAGE(bufoff, gbase, voff) do { _Pragma("unroll") for (int _i = 0; _i < 2; ++_i) \
        __builtin_amdgcn_global_load_lds((const unsigned*)((const char*)(gbase) + (voff)[_i]), (LAS unsigned*)(lds + (bufoff) + ldsw + _i * 8192), 16, 0, 0); } while (0)
#define PG8_LDA(b, h) do { if constexpr (F8) { _Pragma("unroll") for (int m = 0; m < 4; ++m) { const i32x4 lo_ = *(const LAS i32x4*)(lds + PG8_SA(b, h) + aoff + m * 2048), hi_ = *(const LAS i32x4*)(lds + PG8_SA(b, h) + aoff + m * 2048 + 16); \
            At8[m] = (i32x8){lo_[0], lo_[1], lo_[2], lo_[3], hi_[0], hi_[1], hi_[2], hi_[3]}; } } \
        else { _Pragma("unroll") for (int m = 0; m < 4; ++m) _Pragma("unroll") for (int k = 0; k < 2; ++k) At[m][k] = *(const LAS bf16x8*)(lds + PG8_SA(b, h) + aoff + m * 2048 + k * 1024); } } while (0)
#define PG8_LDB(w, b, h) do { if constexpr (F8) { _Pragma("unroll") for (int n = 0; n < 2; ++n) { const i32x4 lo_ = *(const LAS i32x4*)(lds + PG8_SB(b, h) + boff + n * 2048), hi_ = *(const LAS i32x4*)(lds + PG8_SB(b, h) + boff + n * 2048 + 16); \
            Bq8[w][n] = (i32x8){lo_[0], lo_[1], lo_[2], lo_[3], hi_[0], hi_[1], hi_[2], hi_[3]}; } } \
        else { _Pragma("unroll") for (int n = 0; n < 2; ++n) _Pragma("unroll") for (int k = 0; k < 2; ++k) Bq[w][n][k] = *(const LAS bf16x8*)(lds + PG8_SB(b, h) + boff + n * 2048 + k * 1024); } } while (0)
#define PG8_MMA(ai, bj) do { __builtin_amdgcn_s_setprio(1); if constexpr (F8) { _Pragma("unroll") for (int m = 0; m < 4; ++m) _Pragma("unroll") for (int n = 0; n < 2; ++n) \
            asm volatile("v_mfma_scale_f32_16x16x128_f8f6f4 %0, %1, %2, %0, %3, %3 op_sel_hi:[0,0,0]" : "+v"(acc[ai][bj][m][n]) : "v"(Bq8[bj][n]), "v"(At8[m]), "v"(sc8)); } \
        else { _Pragma("unroll") for (int m = 0; m < 4; ++m) _Pragma("unroll") for (int n = 0; n < 2; ++n) _Pragma("unroll") for (int k = 0; k < 2; ++k) \
            acc[ai][bj][m][n] = __builtin_amdgcn_mfma_f32_16x16x32_bf16(Bq[bj][n][k], At[m][k], acc[ai][bj][m][n], 0, 0, 0); } __builtin_amdgcn_s_setprio(0); } while (0)
#define PG8_WAIT_V(n) asm volatile("s_waitcnt vmcnt(" #n ")" ::: "memory")
#define PG8_WAIT_L(n) asm volatile("s_waitcnt lgkmcnt(" #n ")" ::: "memory")
#define PG8_BAR __builtin_amdgcn_s_barrier()
#define PG8_SCHED __builtin_amdgcn_sched_barrier(0)
    Unit cur, nxt; int ui = 0;
    if (!S.next(0, cur)) return;
    f32x4 acc[2][2][4][2];
#pragma unroll
    for (int a = 0; a < 2; ++a)
#pragma unroll
        for (int b = 0; b < 2; ++b)
#pragma unroll
            for (int m = 0; m < 4; ++m)
#pragma unroll
                for (int n = 0; n < 2; ++n) acc[a][b][m][n] = (f32x4){0.f, 0.f, 0.f, 0.f};
    bf16x8 At[4][2], Bq[2][2][2]; i32x8 At8[4], Bq8[2][2]; const int sc8 = 0x7f7f7f7f;
    unsigned oA0[2], oA1[2], nA0[2], nA1[2];
    const char* cA; const char* cB = (const char*)g.Bt + ((size_t)cur.e * g.bstride + (size_t)cur.pn * BM * K) * ESZ + (size_t)cur.k0 * kstepB;
    if constexpr (GATHER) { cA = (const char*)g.A + (size_t)cur.k0 * 128;
#pragma unroll
        for (int i = 0; i < 2; ++i) { oA0[i] = (unsigned)S.arow(cur, RA[i]) * (unsigned)KB + CA[i]; oA1[i] = (unsigned)S.arow(cur, HALF + RA[i]) * (unsigned)KB + CA[i]; }
    } else { cA = (const char*)g.A + (size_t)cur.pm * tstep + (size_t)cur.k0 * 128;
#pragma unroll
        for (int i = 0; i < 2; ++i) { oA0[i] = voffA[i]; oA1[i] = voffA[i] + (unsigned)hstep; } }
#pragma unroll
    for (int i = 0; i < 2; ++i) { nA0[i] = oA0[i]; nA1[i] = oA1[i]; }
    PG8_STAGE(PG8_SB(0, 0), cB, voffB); PG8_STAGE(PG8_SB(0, 1), cB + hstepB, voffB); PG8_STAGE(PG8_SA(0, 0), cA, oA0); PG8_STAGE(PG8_SA(0, 1), cA, oA1);
    if (wr == 1) PG8_BAR;
    PG8_WAIT_V(2); PG8_BAR;
    PG8_STAGE(PG8_SB(1, 0), cB + kstepB, voffB); PG8_STAGE(PG8_SA(1, 0), cA + kstep, oA0); PG8_STAGE(PG8_SB(1, 1), cB + hstepB + kstepB, voffB);
    PG8_WAIT_V(6); PG8_BAR;
    for (;;) {
        const bool has_next = S.next(ui + 1, nxt);
        const char* nA; const char* nB = has_next ? (const char*)g.Bt + ((size_t)nxt.e * g.bstride + (size_t)nxt.pn * BM * K) * ESZ + (size_t)nxt.k0 * kstepB : cB;
        const int ntu = cur.nkt ? cur.nkt : nt;
        if constexpr (GATHER) { nA = has_next ? (const char*)g.A + (size_t)nxt.k0 * 128 : cA;
            if (has_next) {
#pragma unroll
                for (int i = 0; i < 2; ++i) { nA0[i] = (unsigned)S.arow(nxt, RA[i]) * (unsigned)KB + CA[i]; nA1[i] = (unsigned)S.arow(nxt, HALF + RA[i]) * (unsigned)KB + CA[i]; } }
        } else { nA = has_next ? (const char*)g.A + (size_t)nxt.pm * tstep + (size_t)nxt.k0 * 128 : cA; }
        for (int t = 0; t < ntu; t += 2) {
            const bool last = (t == ntu - 2);
            const char* a1 = cA + (size_t)(t + 1) * kstep;
            const char* a2 = last ? nA : cA + (size_t)(t + 2) * kstep; const char* b2 = last ? nB : cB + (size_t)(t + 2) * kstepB;
            const char* a3 = a2 + kstep; const char* b3 = b2 + kstepB;
            unsigned xA0[2], xA1[2];
#pragma unroll
            for (int i = 0; i < 2; ++i) { xA0[i] = (GATHER && last) ? nA0[i] : oA0[i]; xA1[i] = (GATHER && last) ? nA1[i] : oA1[i]; }
            PG8_LDB(0, 0, 0); PG8_LDB(1, 0, 1); PG8_SCHED; PG8_LDA(0, 0); PG8_STAGE(PG8_SA(1, 1), a1, oA1);
            PG8_WAIT_V(8); PG8_WAIT_L(0); PG8_BAR; PG8_MMA(0, 0); PG8_MMA(0, 1); PG8_BAR; PG8_SCHED;
            PG8_LDA(0, 1); PG8_STAGE(PG8_SB(0, 0), b2, voffB); PG8_STAGE(PG8_SB(0, 1), b2 + hstepB, voffB); PG8_STAGE(PG8_SA(0, 0), a2, xA0);
            PG8_WAIT_V(8); PG8_WAIT_L(0); PG8_BAR; PG8_MMA(1, 0); PG8_MMA(1, 1); PG8_BAR; PG8_SCHED;
            PG8_LDB(0, 1, 0); PG8_LDB(1, 1, 1); PG8_SCHED; PG8_LDA(1, 0); PG8_STAGE(PG8_SA(0, 1), a2, xA1);
            PG8_WAIT_V(8); PG8_WAIT_L(0); PG8_BAR; PG8_MMA(0, 0); PG8_MMA(0, 1); PG8_BAR; PG8_SCHED;
            PG8_LDA(1, 1); PG8_STAGE(PG8_SB(1, 0), b3, voffB); PG8_STAGE(PG8_SB(1, 1), b3 + hstepB, voffB); PG8_STAGE(PG8_SA(1, 0), a3, xA0);
            PG8_WAIT_V(8); PG8_WAIT_L(0); PG8_BAR; PG8_MMA(1, 0); PG8_MMA(1, 1); PG8_BAR; PG8_SCHED;
        }
        if (wr == 0) PG8_BAR;
        if constexpr (F8) asm volatile("s_nop 15\n\ts_nop 15" ::: "memory");
        { int efr = fr, efq = fq; asm volatile("" : "+v"(efr), "+v"(efq)); E(acc, cur, wr, wc, efr, efq); }
        if (!has_next) break;
#pragma unroll
        for (int a = 0; a < 2; ++a)
#pragma unroll
            for (int b = 0; b < 2; ++b)
#pragma unroll
                for (int m = 0; m < 4; ++m)
#pragma unroll
                    for (int n = 0; n < 2; ++n) acc[a][b][m][n] = (f32x4){0.f, 0.f, 0.f, 0.f};
        cur = nxt; cA = nA; cB = nB; ++ui;
#pragma unroll
        for (int i = 0; i < 2; ++i) { oA0[i] = nA0[i]; oA1[i] = nA1[i]; }
        if (wr == 1) PG8_BAR;
    }
    PG8_WAIT_V(0);
    PG8_BAR;
#undef PG8_SA
#undef PG8_SB
#undef PG8_STAGE
#undef PG8_LDA
#undef PG8_LDB
#undef PG8_MMA
#undef PG8_WAIT_V
#undef PG8_WAIT_L
#undef PG8_BAR
#undef PG8_SCHED
}

__device__ __forceinline__ float row_rstd(const float* part, int row) { const f32x4 a = *(const f32x4*)(part + (size_t)row * 8), b = *(const f32x4*)(part + (size_t)row * 8 + 4);
    return rsqrtf((((a[0] + a[1]) + (a[2] + a[3])) + ((b[0] + b[1]) + (b[2] + b[3]))) * (1.0f / D) + EPS); }
struct EpiResid {
    const float* Xin; float* Xout; bf16_t* XB; float* part; LAS float* P; unsigned char* X8; float sc;
    __device__ __forceinline__ void operator()(const f32x4 (&acc)[2][2][4][2], const Unit& u, int wr, int wc, int fr, int fq) const {
        const int row0 = u.pm * BM + wr * 64 + fr, col0 = u.pn * BM + wc * 32 + 4 * fq;
#pragma unroll
        for (int ai = 0; ai < 2; ++ai)
#pragma unroll
            for (int m = 0; m < 4; ++m) { const int row = row0 + ai * HALF + m * 16; const size_t ro = (size_t)row * D + col0; float ss = 0.f;
#pragma unroll
                for (int bj = 0; bj < 2; ++bj)
#pragma unroll
                    for (int n = 0; n < 2; ++n) { const f32x4 v = *(const f32x4*)(Xin + ro + bj * HALF + n * 16) + acc[ai][bj][m][n] * sc;
                        *(f32x4*)(Xout + ro + bj * HALF + n * 16) = v; ss += (v[0] * v[0] + v[1] * v[1]) + (v[2] * v[2] + v[3] * v[3]);
                        u32x2 w; w.x = cvt_pk_bf16(v[0], v[1]); w.y = cvt_pk_bf16(v[2], v[3]); *(u32x2*)(XB + ro + bj * HALF + n * 16) = w;
                        if (X8) *(unsigned*)(X8 + ro + bj * HALF + n * 16) = pk4_fp8(v[0], v[1], v[2], v[3]); }
                ss += __shfl_xor(ss, 16); ss += __shfl_xor(ss, 32);
                if (fq == 0) P[(wr * 64 + fr + ai * HALF + m * 16) * 4 + wc] = ss; }
        asm volatile("s_waitcnt lgkmcnt(0)" ::: "memory"); __builtin_amdgcn_s_barrier(); asm volatile("" ::: "memory");
        const int t = threadIdx.x;
        if (t < BM) { const f32x4 p = *(const LAS f32x4*)(P + t * 4); part[(size_t)(u.pm * BM + t) * 8 + u.pn] = (p[0] + p[1]) + (p[2] + p[3]); }
    }
};

__device__ __forceinline__ float fast_silu(float g) { return g * __builtin_amdgcn_rcpf(1.f + __expf(-g)); }
__device__ __forceinline__ float fast_gelu_tanh(float x) { const float u = 1.5957691216057308f * (x + 0.044715f * x * x * x); return x * (1.f - __builtin_amdgcn_rcpf(1.f + __expf(u))); }
struct EpiQkv {
    bf16_t* O; const float* part; const float* rc; const float* rs;
    __device__ __forceinline__ void operator()(const f32x4 (&acc)[2][2][4][2], const Unit& u, int wr, int wc, int fr, int fq) const {
        const int row0 = u.pm * BM + wr * 64 + fr, col0 = u.pn * BM + wc * 64 + 8 * fq; const bool rope = (u.pn >= 12 && u.pn < 20);
#pragma unroll
        for (int ai = 0; ai < 2; ++ai)
#pragma unroll
            for (int m = 0; m < 4; ++m) { const int row = row0 + ai * HALF + m * 16; const float rstd = row_rstd(part, row);
                f32x4 x1a = acc[ai][0][m][0] * rstd, x1b = acc[ai][0][m][1] * rstd, x2a = acc[ai][1][m][0] * rstd, x2b = acc[ai][1][m][1] * rstd;
                if (rope) { const int s = row & (S - 1); const f32x4 ca = *(const f32x4*)(rc + s * 32 + 8 * fq), cb = *(const f32x4*)(rc + s * 32 + 8 * fq + 4), sa = *(const f32x4*)(rs + s * 32 + 8 * fq), sb = *(const f32x4*)(rs + s * 32 + 8 * fq + 4);
                    const f32x4 o1a = x1a * ca - x2a * sa, o1b = x1b * cb - x2b * sb, o2a = x2a * ca + x1a * sa, o2b = x2b * cb + x1b * sb; x1a = o1a; x1b = o1b; x2a = o2a; x2b = o2b; }
                bf16_t* rowp = O + (size_t)row * INC + col0;
                u32x4 w1, w2; w1.x = cvt_pk_bf16(x1a[0], x1a[1]); w1.y = cvt_pk_bf16(x1a[2], x1a[3]); w1.z = cvt_pk_bf16(x1b[0], x1b[1]); w1.w = cvt_pk_bf16(x1b[2], x1b[3]);
                w2.x = cvt_pk_bf16(x2a[0], x2a[1]); w2.y = cvt_pk_bf16(x2a[2], x2a[3]); w2.z = cvt_pk_bf16(x2b[0], x2b[1]); w2.w = cvt_pk_bf16(x2b[2], x2b[3]);
                *(u32x4*)rowp = w1; *(u32x4*)(rowp + 32) = w2; }
    }
};
template <bool MOE, bool F8O = MOE> struct EpiGateUp {
    bf16_t* O; const float* part; const int* list;
    __device__ __forceinline__ void operator()(const f32x4 (&acc)[2][2][4][2], const Unit& u, int wr, int wc, int fr, int fq) const {
        const int lr0 = wr * 64 + fr, col0 = u.pn * HALF + wc * 32 + 8 * fq;
#pragma unroll
        for (int ai = 0; ai < 2; ++ai)
#pragma unroll
            for (int m = 0; m < 4; ++m) { const int lr = lr0 + ai * HALF + m * 16; int srow = u.pm * BM + lr; const int orow = u.pm * BM + lr;
                const float rstd = MOE ? W8_INV : row_rstd(part, srow) * (F8O ? W8_INV : 1.f);
                const f32x4 g0 = acc[ai][0][m][0] * rstd, g1 = acc[ai][0][m][1] * rstd, u0 = acc[ai][1][m][0] * rstd, u1 = acc[ai][1][m][1] * rstd;
                if constexpr (F8O) { u32x2 w8; w8.x = pk4_fp8(fast_silu(g0[0]) * u0[0], fast_silu(g0[1]) * u0[1], fast_silu(g0[2]) * u0[2], fast_silu(g0[3]) * u0[3]);
                    w8.y = pk4_fp8(fast_silu(g1[0]) * u1[0], fast_silu(g1[1]) * u1[1], fast_silu(g1[2]) * u1[2], fast_silu(g1[3]) * u1[3]);
                    *(u32x2*)((unsigned char*)O + (size_t)orow * FF + col0) = w8; continue; }
                u32x4 w; w.x = cvt_pk_bf16(fast_silu(g0[0]) * u0[0], fast_silu(g0[1]) * u0[1]); w.y = cvt_pk_bf16(fast_silu(g0[2]) * u0[2], fast_silu(g0[3]) * u0[3]);
                w.z = cvt_pk_bf16(fast_silu(g1[0]) * u1[0], fast_silu(g1[1]) * u1[1]); w.w = cvt_pk_bf16(fast_silu(g1[2]) * u1[2], fast_silu(g1[3]) * u1[3]);
                *(u32x4*)(O + (size_t)orow * FF + col0) = w; }
    }
};
struct EpiL1In {
    bf16_t* Y; bf16_t* R; const float* part;
    __device__ __forceinline__ void operator()(const f32x4 (&acc)[2][2][4][2], const Unit& u, int wr, int wc, int fr, int fq) const {
        const int row0 = u.pm * BM + wr * 64 + fr, col0 = u.pn * BM + wc * 32 + 8 * fq;
#pragma unroll
        for (int ai = 0; ai < 2; ++ai)
#pragma unroll
            for (int m = 0; m < 4; ++m) { const int row = row0 + ai * HALF + m * 16; const float rstd = row_rstd(part, row);
#pragma unroll
                for (int bj = 0; bj < 2; ++bj) { const f32x4 v0 = acc[ai][bj][m][0] * rstd, v1 = acc[ai][bj][m][1] * rstd; const int col = col0 + bj * HALF;
                    if (u.pn < 8) { u32x4 w; w.x = cvt_pk_bf16(fast_gelu_tanh(v0[0]), fast_gelu_tanh(v0[1])); w.y = cvt_pk_bf16(fast_gelu_tanh(v0[2]), fast_gelu_tanh(v0[3]));
                        w.z = cvt_pk_bf16(fast_gelu_tanh(v1[0]), fast_gelu_tanh(v1[1])); w.w = cvt_pk_bf16(fast_gelu_tanh(v1[2]), fast_gelu_tanh(v1[3])); *(u32x4*)(Y + (size_t)row * D + col) = w; }
                    else { u32x4 w; w.x = cvt_pk_bf16(v0[0], v0[1]); w.y = cvt_pk_bf16(v0[2], v0[3]); w.z = cvt_pk_bf16(v1[0], v1[1]); w.w = cvt_pk_bf16(v1[2], v1[3]); *(u32x4*)(R + ((size_t)(row >> 8) * LB + (u.pn - 8) * 2 + bj) * (256 * LBD) + (size_t)(row & 255) * LBD + wc * 32 + 8 * fq) = w; } } }
    }
};

struct MoeOrder {
    const volatile LAS int* tab; const int* list; int NP, nwg, G, c, KT4;
    __device__ __forceinline__ int tb(int i) const { return __builtin_amdgcn_readfirstlane(tab[i]); }
    __device__ void init(const volatile LAS int* tab_, const int* list_, int NP_, int G_, int c_) { tab = tab_; list = list_; NP = NP_; G = G_; c = c_; nwg = __builtin_amdgcn_readfirstlane(tab_[16]) * NP_; ksplit = 0; KT4 = 0; }
    int ksplit;
    __device__ bool next(int i, Unit& u) const {
        long L = (long)i * G + c; u.k0 = 0; u.nkt = 0; u.kq = -1; u.ridx = 0;
        if (ksplit && i >= 2) { if (i > 2 || c >= 4 * (nwg - 2 * G)) return false; L = 2 * G + (c >> 2); u.kq = c & 3; u.ridx = c >> 2; u.nkt = KT4; u.k0 = u.kq * KT4; }
        if (L >= nwg) return false;
        int wgid = (int)L; { const int q = nwg / NXCD, r = nwg % NXCD, xcd = wgid % NXCD, off = wgid / NXCD; wgid = (xcd < r ? xcd * (q + 1) : r * (q + 1) + (xcd - r) * q) + off; }
        int e = 0;
#pragma unroll
        for (int k = 1; k < NE; ++k) e += (wgid >= tb(8 + k) * NP) ? 1 : 0;
        const int p0 = tb(8 + e), npan = tb(9 + e) - p0, w = wgid - p0 * NP;
        const int pl = w % npan; u.pn = w / npan; u.pm = p0 + pl; u.e = e; u.r0 = pl * BM; u.cnt = tb(e); return true;
    }
    __device__ __forceinline__ int arow(const Unit& u, int lr) const { const int li = u.r0 + lr; return (li < u.cnt) ? (list[u.e * T + li] >> 1) : 0; }
};
struct EpiMoeDown {
    bf16_t* C; const int* list; const float* gatew; float* partk;
    __device__ __forceinline__ void operator()(const f32x4 (&acc)[2][2][4][2], const Unit& u, int wr, int wc, int fr, int fq) const {
        const int lr0 = wr * 64 + fr, col0 = u.pn * BM + wc * 32 + 4 * fq;
        if (u.kq >= 0) {
            float* pt = partk + ((size_t)(u.ridx * 4 + u.kq) << 16) + wc * 32 + 4 * fq;
#pragma unroll
            for (int ai = 0; ai < 2; ++ai)
#pragma unroll
                for (int m = 0; m < 4; ++m) { float* rp = pt + (lr0 + ai * HALF + m * 16) * BM;
#pragma unroll
                    for (int bj = 0; bj < 2; ++bj)
#pragma unroll
                        for (int n = 0; n < 2; ++n) *(f32x4*)(rp + bj * HALF + n * 16) = acc[ai][bj][m][n]; }
            return;
        }
#pragma unroll
        for (int ai = 0; ai < 2; ++ai)
#pragma unroll
            for (int m = 0; m < 4; ++m) { const int li = u.r0 + lr0 + ai * HALF + m * 16;
                if (li < u.cnt) { const int ent = list[u.e * T + li]; const float w = gatew[ent] * W8_INV; bf16_t* rp = C + (size_t)ent * D + col0;
#pragma unroll
                    for (int bj = 0; bj < 2; ++bj)
#pragma unroll
                        for (int n = 0; n < 2; ++n) { const f32x4 v = acc[ai][bj][m][n] * w; u32x2 pk; pk.x = cvt_pk_bf16(v[0], v[1]); pk.y = cvt_pk_bf16(v[2], v[3]); *(u32x2*)(rp + bj * HALF + n * 16) = pk; } } }
    }
};

namespace att {
using f32x16 = __attribute__((ext_vector_type(16))) float;
using s16x4  = __attribute__((ext_vector_type(4))) short;
constexpr int SHM_V = 64 * 128 * 2, SHM_K = 64 * 128 * 2;
constexpr float LOG2E = 1.4426950408889634f;
constexpr float THR2 = 8.f * LOG2E;
#define KSWZ(row, colB) ((row) * 256 + ((colB) ^ (((row) & 7) << 4)))
#define SBAR() __builtin_amdgcn_sched_barrier(0)
__device__ __forceinline__ int crow(int r, int hi) { return (r & 3) + 8 * (r >> 2) + 4 * hi; }
__device__ __forceinline__ unsigned cvtpk(float lo, float hi) { unsigned r; asm volatile("v_cvt_pk_bf16_f32 %0, %1, %2" : "=v"(r) : "v"(lo), "v"(hi)); return r; }
__device__ __forceinline__ int v_st(int k, int c) { const int kk = (k & ~0xC) | ((k & 4) << 1) | ((k & 8) >> 1); return ((kk >> 3) * 4 + (c >> 5)) * 512 + ((kk & 7) * 32 + (c & 31)) * 2; }
__device__ __forceinline__ int v_rd_base(int lane) { return ((lane & 3) << 3) | (((lane >> 2) & 3) << 6) | (((lane >> 4) & 1) << 5) | (((lane >> 5) & 1) << 8); }
constexpr int v_rd_off(int d0, int ks, int half) { return d0 * 512 + ks * 4096 + half * 2048; }
template <int OFF> __device__ __forceinline__ s16x4 tr_read(int vb) { s16x4 r; asm volatile("ds_read_b64_tr_b16 %0, %1 offset:%2" : "=&v"(r) : "v"(vb), "i"(OFF) : "memory"); return r; }
template <int D0> __device__ __forceinline__ void pv_one(f32x16& od, int vb, bf16x8 pa0, bf16x8 pa1, bf16x8 pa2, bf16x8 pa3) {
    const s16x4 l0 = tr_read<v_rd_off(D0, 0, 0)>(vb), h0 = tr_read<v_rd_off(D0, 0, 1)>(vb), l1 = tr_read<v_rd_off(D0, 1, 0)>(vb), h1 = tr_read<v_rd_off(D0, 1, 1)>(vb);
    const s16x4 l2 = tr_read<v_rd_off(D0, 2, 0)>(vb), h2 = tr_read<v_rd_off(D0, 2, 1)>(vb), l3 = tr_read<v_rd_off(D0, 3, 0)>(vb), h3 = tr_read<v_rd_off(D0, 3, 1)>(vb);
    asm volatile("s_waitcnt lgkmcnt(0)" ::: "memory"); SBAR();
#define PK(L, H) (bf16x8){L[0], L[1], L[2], L[3], H[0], H[1], H[2], H[3]}
    od = __builtin_amdgcn_mfma_f32_32x32x16_bf16(pa0, PK(l0, h0), od, 0, 0, 0);
    od = __builtin_amdgcn_mfma_f32_32x32x16_bf16(pa1, PK(l1, h1), od, 0, 0, 0);
    od = __builtin_amdgcn_mfma_f32_32x32x16_bf16(pa2, PK(l2, h2), od, 0, 0, 0);
    od = __builtin_amdgcn_mfma_f32_32x32x16_bf16(pa3, PK(l3, h3), od, 0, 0, 0);
#undef PK
}
__device__ __forceinline__ void pv_d0(f32x16* o, int vb, bf16x8 pa0, bf16x8 pa1, bf16x8 pa2, bf16x8 pa3) {
    pv_one<0>(o[0], vb, pa0, pa1, pa2, pa3); pv_one<1>(o[1], vb, pa0, pa1, pa2, pa3); pv_one<2>(o[2], vb, pa0, pa1, pa2, pa3); pv_one<3>(o[3], vb, pa0, pa1, pa2, pa3);
}
struct NaCtx { const LAS float* bias; int r, rs, qc, cs; };
template <int MODE> __device__ __forceinline__ void partialSM(f32x16& p0, f32x16& p1, float& m_reg, float& mn, float& alpha, const NaCtx& nc, int kr, int hi) {
    float pmax;
    if constexpr (MODE == 0) {
        constexpr float C = 0.125f * LOG2E;
        pmax = p0[0];
#pragma unroll
        for (int r = 1; r < 16; ++r) pmax = fmaxf(pmax, p0[r]);
#pragma unroll
        for (int r = 0; r < 16; ++r) pmax = fmaxf(pmax, p1[r]);
        pmax *= C;
    } else {
        constexpr float C = 0.08838834764831845f * LOG2E;
        const bool rowin = (unsigned)(kr - nc.rs) < 8u;
        const int base = (kr - nc.r + 7) * 31 + 15 - nc.qc;
#pragma unroll
        for (int r = 0; r < 16; ++r) { const int kc0 = crow(r, hi), kc1 = 32 + kc0;
            const bool v0 = rowin && ((unsigned)(kc0 - nc.cs) < 16u), v1 = rowin && ((unsigned)(kc1 - nc.cs) < 16u);
            const float b0 = nc.bias[v0 ? base + kc0 : 0], b1 = nc.bias[v1 ? base + kc1 : 0];
            p0[r] = v0 ? fmaf(p0[r], C, b0) : -1.0e30f; p1[r] = v1 ? fmaf(p1[r], C, b1) : -1.0e30f; }
        pmax = p0[0];
#pragma unroll
        for (int r = 1; r < 16; ++r) pmax = fmaxf(pmax, p0[r]);
#pragma unroll
        for (int r = 0; r < 16; ++r) pmax = fmaxf(pmax, p1[r]);
    }
    { auto rr = __builtin_amdgcn_permlane32_swap(__float_as_uint(pmax), __float_as_uint(pmax), false, false);
      pmax = fmaxf(__uint_as_float(rr[0]), __uint_as_float(rr[1])); }
    if (__builtin_expect(__all(pmax - m_reg <= THR2), 1)) { mn = m_reg; alpha = 1.f; }
    else { mn = fmaxf(m_reg, pmax); alpha = __builtin_amdgcn_exp2f(m_reg - mn); m_reg = mn; }
    if constexpr (MODE == 0) { constexpr float C = 0.125f * LOG2E; const float mnC = -mn;
#pragma unroll
        for (int r = 0; r < 16; ++r) p0[r] = fmaf(p0[r], C, mnC);
#pragma unroll
        for (int r = 0; r < 16; ++r) p1[r] = fmaf(p1[r], C, mnC);
    } else {
#pragma unroll
        for (int r = 0; r < 16; ++r) p0[r] = p0[r] - mn;
#pragma unroll
        for (int r = 0; r < 16; ++r) p1[r] = p1[r] - mn;
    }
#pragma unroll
    for (int r = 0; r < 16; ++r) p0[r] = __builtin_amdgcn_exp2f(p0[r]);
}
__device__ __forceinline__ void finishSM(f32x16& p0, f32x16& p1, float alpha, float& l_reg, bf16x8& pa0, bf16x8& pa1, bf16x8& pa2, bf16x8& pa3) {
#pragma unroll
    for (int r = 0; r < 16; ++r) p1[r] = __builtin_amdgcn_exp2f(p1[r]);
    float ps = 0;
#pragma unroll
    for (int r = 0; r < 16; ++r) ps += p0[r];
#pragma unroll
    for (int r = 0; r < 16; ++r) ps += p1[r];
    { auto rr = __builtin_amdgcn_permlane32_swap(__float_as_uint(ps), __float_as_uint(ps), false, false);
      ps = __uint_as_float(rr[0]) + __uint_as_float(rr[1]); }
    l_reg = l_reg * alpha + ps;
#define PK4(P, BASE, OUT) do { unsigned a0 = cvtpk(P[BASE + 0], P[BASE + 1]), a1 = cvtpk(P[BASE + 2], P[BASE + 3]);   \
    unsigned b0 = cvtpk(P[BASE + 4], P[BASE + 5]), b1 = cvtpk(P[BASE + 6], P[BASE + 7]);                              \
    auto r0 = __builtin_amdgcn_permlane32_swap(a0, b0, false, false); auto r1 = __builtin_amdgcn_permlane32_swap(a1, b1, false, false); \
    u32x4 w = {r0[0], r1[0], r0[1], r1[1]}; OUT = *reinterpret_cast<bf16x8*>(&w); } while (0)
    PK4(p0, 0, pa0); PK4(p0, 8, pa1); PK4(p1, 0, pa2); PK4(p1, 8, pa3);
#undef PK4
}
template <int NKS, bool QLDS> __device__ __forceinline__ void qkt(f32x16& p0, f32x16& p1, const LAS unsigned char* Ks, const bf16x8* qr, const LAS unsigned char* Qs, int kcb, int r32, int hi) {
    p0 = f32x16{}; p1 = f32x16{};
#pragma unroll
    for (int d0 = 0; d0 < NKS; ++d0) { const int cb = kcb + (d0 * 16 + hi * 8) * 2;
        const bf16x8 b0 = *(const LAS bf16x8*)(Ks + KSWZ(r32, cb));
        const bf16x8 b1 = *(const LAS bf16x8*)(Ks + KSWZ(32 + r32, cb));
        bf16x8 q; if constexpr (QLDS) q = *(const LAS bf16x8*)(Qs + KSWZ(r32, (d0 * 16 + hi * 8) * 2)); else q = qr[d0];
        p0 = __builtin_amdgcn_mfma_f32_32x32x16_bf16(b0, q, p0, 0, 0, 0);
        p1 = __builtin_amdgcn_mfma_f32_32x32x16_bf16(b1, q, p1, 0, 0, 0); }
}

template <int MODE>
__device__ __forceinline__ void attn_unit(const bf16_t* __restrict__ QKV, bf16_t* __restrict__ ATT, int b, int h, int blk, LAS unsigned char* lds, const float* __restrict__ subln, float lam, const float* __restrict__ rpb) {
    constexpr int NKS = (MODE == 0) ? 4 : 8;
    const int tid = opaque_tid(), wid = tid >> 6, lane = tid & 63, r32 = lane & 31, hi = lane >> 5;
    LAS unsigned char* V_lds = lds; LAS unsigned char* K_lds = lds + 2 * SHM_V;
    LAS float* wsr = (LAS float*)(lds + MISC_OFF + 1024) + wid * 64; LAS float* li_l = wsr; LAS float* al_l = wsr + 32;
    LAS float* biasL = (LAS float*)(lds + MISC_OFF + 8192);
    int qtok, qcol, kcol, vcol, tok0, NT, ocol; NaCtx nc; nc.bias = biasL; nc.r = 0; nc.rs = 0; nc.qc = 0; nc.cs = 0; int kr0 = 0;
    if constexpr (MODE == 0) { const int map = wid >> 2;
        qtok = b * S + blk * 128 + (wid & 3) * 32 + r32; qcol = 3 * 1024 + h * HD + map * 64; kcol = 4 * 1024 + h * HD; vcol = 5 * 1024 + h * HD; tok0 = b * S; NT = S / 64; ocol = 1024 + h * HD;
    } else { const int r = blk * 4 + (wid >> 1), qc = 32 * (wid & 1) + r32;
        qtok = b * S + r * GW + qc; qcol = h * HD; kcol = 1024 + h * HD; vcol = 2048 + h * HD; ocol = h * HD;
        int rlo = blk * 4 - 4; rlo = rlo < 0 ? 0 : (rlo > GR - KH ? GR - KH : rlo);
        int rhi = blk * 4 + 3 - 4; rhi = rhi < 0 ? 0 : (rhi > GR - KH ? GR - KH : rhi); rhi += KH - 1;
        int cnt = rhi - rlo + 1; if (cnt & 1) { if (rhi + 1 < GR) ++rhi; else --rlo; ++cnt; }
        kr0 = rlo; NT = cnt; tok0 = b * S + rlo * GW;
        nc.r = r; int rs = r - 4; nc.rs = rs < 0 ? 0 : (rs > GR - KH ? GR - KH : rs); nc.qc = qc; int cs = qc - 8; nc.cs = cs < 0 ? 0 : (cs > GW - KW ? GW - KW : cs);
    }
    __syncthreads();
    if constexpr (MODE == 1) { for (int i = tid; i < 15 * 31; i += NTHR) biasL[i] = rpb[h * 15 * 31 + i] * LOG2E; }
    constexpr bool QLDS = (MODE == 1);
    LAS unsigned char* Qs = lds + 65536 + wid * 8192;
    float m_reg = -1e30f, l_reg = 0; f32x16 o[4] = {}; bf16x8 qr[QLDS ? 1 : NKS];
    { const bf16_t* Qw = QKV + (size_t)qtok * INC + qcol + hi * 8;
#pragma unroll
      for (int d0 = 0; d0 < NKS; ++d0) { const bf16x8 qv = *(const bf16x8*)(Qw + d0 * 16);
          if constexpr (QLDS) *(LAS bf16x8*)(Qs + KSWZ(r32, (d0 * 16 + hi * 8) * 2)) = qv; else qr[d0] = qv; } }
    const int kcb = (MODE == 0) ? (wid >> 2) * 128 : 0;
    const int sr = tid >> 4, sc = (tid & 15) * 8, vst0 = v_st(sr, sc), vst1 = v_st(32 + sr, sc);
    const int vb0 = (int)(unsigned)(uintptr_t)V_lds + v_rd_base(lane);
    const bf16_t* Kg = QKV + (size_t)tok0 * INC + kcol + sc; const bf16_t* Vg = QKV + (size_t)tok0 * INC + vcol + sc;
    constexpr int SDEPTH = (MODE == 0) ? 2 : 1;
    struct { bf16x8 vs0, vs1, ks0, ks1; } sr_[SDEPTH];
#define SLOAD(i, k0) do { sr_[i].vs0 = *(const bf16x8*)(Vg + (size_t)((k0) + sr) * INC); sr_[i].vs1 = *(const bf16x8*)(Vg + (size_t)((k0) + 32 + sr) * INC); \
    sr_[i].ks0 = *(const bf16x8*)(Kg + (size_t)((k0) + sr) * INC); sr_[i].ks1 = *(const bf16x8*)(Kg + (size_t)((k0) + 32 + sr) * INC); } while (0)
#define SWRITE(bb, i) do { *(LAS bf16x8*)(V_lds + (bb) * SHM_V + vst0) = sr_[i].vs0; *(LAS bf16x8*)(V_lds + (bb) * SHM_V + vst1) = sr_[i].vs1; const int kc = sc * 2; \
    *(LAS bf16x8*)(K_lds + (bb) * SHM_K + KSWZ(sr, kc)) = sr_[i].ks0; *(LAS bf16x8*)(K_lds + (bb) * SHM_K + KSWZ(32 + sr, kc)) = sr_[i].ks1; } while (0)
#define SWAIT() do { if constexpr (SDEPTH == 2) asm volatile("s_waitcnt vmcnt(4)" ::: "memory"); else asm volatile("s_waitcnt vmcnt(0)" ::: "memory"); } while (0)
#define RESC(a) do { if (__any((a) < 1.f)) { if (hi == 0) al_l[r32] = (a); asm volatile("s_waitcnt lgkmcnt(0)" ::: "memory"); \
    _Pragma("unroll") for (int d = 0; d < 4; ++d) _Pragma("unroll") for (int r = 0; r < 16; ++r) o[d][r] *= al_l[crow(r, hi)]; } } while (0)
    f32x16 pA0, pA1, pB0, pB1; float mnA, mnB, alA, alB; bf16x8 pa0, pa1, pa2, pa3;
    constexpr int SE = 0, SO = SDEPTH - 1;
    if (wid >= 4) __builtin_amdgcn_s_setprio(1);
    SLOAD(SE, 0); asm volatile("s_waitcnt vmcnt(0)" ::: "memory"); SWRITE(0, SE); __syncthreads();
    qkt<NKS, QLDS>(pA0, pA1, K_lds, qr, Qs, kcb, r32, hi); partialSM<MODE>(pA0, pA1, m_reg, mnA, alA, nc, kr0, hi);
    SLOAD(SO, 64); if constexpr (SDEPTH == 2) { if (2 < NT) SLOAD(SE, 2 * 64); }
    SWAIT(); SWRITE(1, SO); __syncthreads();
    for (int j = 1; j + 1 < NT; j += 2) {
        SBAR(); qkt<NKS, QLDS>(pB0, pB1, K_lds + SHM_K, qr, Qs, kcb, r32, hi);
        finishSM(pA0, pA1, alA, l_reg, pa0, pa1, pa2, pa3); SBAR();
        SLOAD(SO, (j + SDEPTH) * 64); SBAR();
        pv_d0(o, vb0, pa0, pa1, pa2, pa3); partialSM<MODE>(pB0, pB1, m_reg, mnB, alB, nc, kr0 + j, hi);
        __syncthreads(); SWAIT(); SWRITE(0, SE);
        RESC(alB); __syncthreads();
        SBAR(); qkt<NKS, QLDS>(pA0, pA1, K_lds, qr, Qs, kcb, r32, hi);
        finishSM(pB0, pB1, alB, l_reg, pa0, pa1, pa2, pa3); SBAR();
        if (SDEPTH == 1 || j + 3 < NT) SLOAD(SE, (j + 1 + SDEPTH) * 64); SBAR();
        pv_d0(o, vb0 + SHM_V, pa0, pa1, pa2, pa3); partialSM<MODE>(pA0, pA1, m_reg, mnA, alA, nc, kr0 + j + 1, hi);
        __syncthreads(); SWAIT(); SWRITE(1, SO);
        RESC(alA); __syncthreads();
    }
    SBAR(); qkt<NKS, QLDS>(pB0, pB1, K_lds + SHM_K, qr, Qs, kcb, r32, hi);
    finishSM(pA0, pA1, alA, l_reg, pa0, pa1, pa2, pa3); SBAR();
    pv_d0(o, vb0, pa0, pa1, pa2, pa3); partialSM<MODE>(pB0, pB1, m_reg, mnB, alB, nc, kr0 + NT - 1, hi);
    __syncthreads(); RESC(alB);
    finishSM(pB0, pB1, alB, l_reg, pa0, pa1, pa2, pa3); SBAR();
    pv_d0(o, vb0 + SHM_V, pa0, pa1, pa2, pa3);
    __builtin_amdgcn_s_setprio(0);
    if (hi == 0) li_l[r32] = l_reg; asm volatile("s_waitcnt lgkmcnt(0)" ::: "memory");
    float rli[16];
#pragma unroll
    for (int r = 0; r < 16; ++r) rli[r] = __builtin_amdgcn_rcpf(li_l[crow(r, hi)]);
    const int tid2 = opaque_tid(), wid2 = tid2 >> 6, lane2 = tid2 & 63, r32b = lane2 & 31, hib = lane2 >> 5;
    LAS bf16_t* OT = (LAS bf16_t*)(lds + 65536 + wid2 * 8192);
    if constexpr (MODE == 0) {
        LAS float* XCH = (LAS float*)lds;
        __syncthreads();
        if (wid2 >= 4) {
#pragma unroll
            for (int d = 0; d < 4; ++d)
#pragma unroll
                for (int r = 0; r < 16; ++r) XCH[((wid2 - 4) * 64 + d * 16 + r) * 64 + lane2] = o[d][r] * rli[r] * lam;
        }
        __syncthreads();
        if (wid2 < 4) {
            float ssr[16];
#pragma unroll
            for (int r = 0; r < 16; ++r) ssr[r] = 0.f;
#pragma unroll
            for (int d = 0; d < 4; ++d)
#pragma unroll
                for (int r = 0; r < 16; ++r) { const float v = o[d][r] * rli[r] - XCH[(wid2 * 64 + d * 16 + r) * 64 + lane2]; o[d][r] = v; ssr[r] += v * v; }
#pragma unroll
            for (int r = 0; r < 16; ++r) { float s_ = ssr[r]; s_ += __shfl_xor(s_, 1); s_ += __shfl_xor(s_, 2); s_ += __shfl_xor(s_, 4); s_ += __shfl_xor(s_, 8); s_ += __shfl_xor(s_, 16);
                ssr[r] = rsqrtf(s_ * (1.0f / 128.0f) + EPS) * 0.8f; }
#pragma unroll
            for (int d = 0; d < 4; ++d) { const float sg = subln[d * 32 + r32b];
#pragma unroll
                for (int r = 0; r < 16; ++r) OT[crow(r, hib) * 128 + d * 32 + r32b] = f2bf(o[d][r] * ssr[r] * sg); }
        }
    } else {
#pragma unroll
        for (int d = 0; d < 4; ++d)
#pragma unroll
            for (int r = 0; r < 16; ++r) OT[crow(r, hib) * 128 + d * 32 + r32b] = f2bf(o[d][r] * rli[r]);
    }
    if (MODE == 1 || wid2 < 4) {
        asm volatile("s_waitcnt lgkmcnt(0)" ::: "memory");
        const int otok0 = (MODE == 0) ? (b * S + blk * 128 + wid2 * 32) : (b * S + (blk * 4 + (wid2 >> 1)) * GW + 32 * (wid2 & 1)); const int ocol2 = (MODE == 0) ? (1024 + h * HD) : (h * HD);
#pragma unroll
        for (int it = 0; it < 8; ++it) { const int row = it * 4 + (lane2 >> 4), cc = (lane2 & 15) * 8;
            *(u32x4*)(ATT + (size_t)(otok0 + row) * D + ocol2 + cc) = *(const LAS u32x4*)(OT + row * 128 + cc); }
    }
#undef SLOAD
#undef SWRITE
#undef SWAIT
#undef RESC
}

__device__ __forceinline__ void na_unit(const bf16_t* __restrict__ QKV, bf16_t* __restrict__ ATT, int b, int h, int blk, LAS unsigned char* lds, const float* __restrict__ rpb) {
    const int tid = opaque_tid(), wid = tid >> 6, lane = tid & 63, r32 = lane & 31, hi = lane >> 5;
    LAS unsigned char* R = lds + wid * 16384;
    LAS float* wsr = (LAS float*)(lds + MISC_OFF + 1024) + wid * 64; LAS float* li_l = wsr; LAS float* al_l = wsr + 32;
    LAS float* biasL = (LAS float*)(lds + MISC_OFF + 8192);
    const int r = blk * 4 + (wid >> 1), qc = 32 * (wid & 1) + r32;
    const int qtok = b * S + r * GW + qc, qcol = h * HD, kcol = 1024 + h * HD, vcol = 2048 + h * HD;
    NaCtx nc; nc.bias = biasL; nc.r = r; { int rs = r - 4; nc.rs = rs < 0 ? 0 : (rs > GR - KH ? GR - KH : rs); } nc.qc = qc; { int cs = qc - 8; nc.cs = cs < 0 ? 0 : (cs > GW - KW ? GW - KW : cs); }
    const int rs_w = __builtin_amdgcn_readfirstlane(nc.rs);
    __syncthreads();
    for (int i = tid; i < 15 * 31; i += NTHR) biasL[i] = rpb[h * 15 * 31 + i] * LOG2E;
    float m_reg = -1e30f, l_reg = 0; f32x16 o[4] = {}; bf16x8 qr[8];
    { const bf16_t* Qw = QKV + (size_t)qtok * INC + qcol + hi * 8;
#pragma unroll
      for (int d0 = 0; d0 < 8; ++d0) qr[d0] = *(const bf16x8*)(Qw + d0 * 16); }
    const int sr = lane >> 4, sc = (lane & 15) * 8;
    const int vb0 = (int)(unsigned)(uintptr_t)R + v_rd_base(lane);
    const bf16_t* Kg = QKV + (size_t)(b * S + rs_w * GW + sr) * INC + kcol + sc; const bf16_t* Vg = QKV + (size_t)(b * S + rs_w * GW + sr) * INC + vcol + sc;
    bf16x8 st[16];
#define WLOAD(gp, j) do { _Pragma("unroll") for (int i = 0; i < 16; ++i) st[i] = *(const bf16x8*)((gp) + (size_t)((j) * 64 + 4 * i) * INC); } while (0)
    WLOAD(Kg, 0);
    __syncthreads();
#pragma unroll 1
    for (int j = 0; j < KH; ++j) {
        const int kr = rs_w + j;
#pragma unroll
        for (int i = 0; i < 16; ++i) *(LAS bf16x8*)(R + KSWZ(sr + 4 * i, sc * 2)) = st[i];
        asm volatile("s_waitcnt lgkmcnt(0)" ::: "memory");
        WLOAD(Vg, j);
        f32x16 p0, p1; float mn, al; bf16x8 pa0, pa1, pa2, pa3;
        qkt<8, false>(p0, p1, R, qr, nullptr, 0, r32, hi);
        partialSM<1>(p0, p1, m_reg, mn, al, nc, kr, hi);
        if (__any(al < 1.f)) { if (hi == 0) al_l[r32] = al; asm volatile("s_waitcnt lgkmcnt(0)" ::: "memory");
#pragma unroll
            for (int d = 0; d < 4; ++d)
#pragma unroll
                for (int rr = 0; rr < 16; ++rr) o[d][rr] *= al_l[crow(rr, hi)]; }
        finishSM(p0, p1, al, l_reg, pa0, pa1, pa2, pa3);
        asm volatile("s_waitcnt lgkmcnt(0)" ::: "memory");
#pragma unroll
        for (int i = 0; i < 16; ++i) *(LAS bf16x8*)(R + v_st(sr + 4 * i, sc)) = st[i];
        asm volatile("s_waitcnt lgkmcnt(0)" ::: "memory");
        if (j + 1 < KH) WLOAD(Kg, j + 1);
        pv_d0(o, vb0, pa0, pa1, pa2, pa3);
    }
#undef WLOAD
    if (hi == 0) li_l[r32] = l_reg; asm volatile("s_waitcnt lgkmcnt(0)" ::: "memory");
    float rli[16];
#pragma unroll
    for (int rr = 0; rr < 16; ++rr) rli[rr] = __builtin_amdgcn_rcpf(li_l[crow(rr, hi)]);
    const int tid2 = opaque_tid(), wid2 = tid2 >> 6, lane2 = tid2 & 63, r32b = lane2 & 31, hib = lane2 >> 5;
    LAS bf16_t* OT = (LAS bf16_t*)(lds + wid2 * 16384);
#pragma unroll
    for (int d = 0; d < 4; ++d)
#pragma unroll
        for (int rr = 0; rr < 16; ++rr) OT[crow(rr, hib) * 128 + d * 32 + r32b] = f2bf(o[d][rr] * rli[rr]);
    asm volatile("s_waitcnt lgkmcnt(0)" ::: "memory");
    const int otok0 = b * S + (blk * 4 + (wid2 >> 1)) * GW + 32 * (wid2 & 1);
#pragma unroll
    for (int it = 0; it < 8; ++it) { const int row = it * 4 + (lane2 >> 4), cc = (lane2 & 15) * 8;
        *(u32x4*)(ATT + (size_t)(otok0 + row) * D + h * HD + cc) = *(const LAS u32x4*)(OT + row * 128 + cc); }
}
#undef KSWZ
#undef SBAR
}

__device__ __forceinline__ unsigned pk2(float lo, float hi) { return (unsigned)f2bf(lo) | ((unsigned)f2bf(hi) << 16); }
struct TDesc { const float* W; bf16_t* WT; const float* gain; size_t ob; int K, N, rbase, k0, n0, f8, mode, rs; };
__device__ __forceinline__ void tfix(TDesc& d) {
    if ((d.N & 255) == 0) { const int ksz = d.f8 ? 128 : 64; d.ob = (size_t)(d.rbase >> 8) * 256 * d.K + (size_t)(d.k0 / ksz) * (256 * ksz) + (size_t)(d.rbase & 255) * ksz; d.rs = ksz; }
    else { d.ob = (size_t)d.rbase * d.K + d.k0; d.rs = d.K; }
}
__device__ __forceinline__ void tmake(TDesc& d, const float* W, int K, int N, bf16_t* WT, int mode, const float* gain, int item, int f8 = 0) {
    d.W = W; d.WT = WT; d.gain = gain; d.K = K; d.N = N; d.f8 = f8; d.mode = mode;
    if (f8) { const int nblk = N / 32, kb = item / nblk, nb = item % nblk; d.k0 = 128 * kb; d.n0 = 32 * nb; }
    else { const int nblk = N / 64, kb = item / nblk, nb = item % nblk; d.k0 = 64 * kb; d.n0 = 64 * nb; }
    d.rbase = (mode == 0) ? d.n0 : (256 * (d.n0 >> 7) + (d.n0 & 127) + (mode == 2 ? 128 : 0)); tfix(d);
}
__device__ __forceinline__ void tload(const TDesc& d, f32x4 (&v)[16], float (&gq)[2], int lane) {
    gq[0] = d.gain ? d.gain[d.k0 + lane] : 1.f; gq[1] = (d.gain && d.f8) ? d.gain[d.k0 + 64 + lane] : 1.f;
    if (d.f8) { const float* p = d.W + (size_t)(d.k0 + (lane >> 3)) * d.N + d.n0 + (lane & 7) * 4;
#pragma unroll
        for (int i = 0; i < 16; ++i) v[i] = __builtin_nontemporal_load((const f32x4*)(p + (size_t)(8 * i) * d.N));
        return; }
    const float* p = d.W + (size_t)(d.k0 + (lane >> 4)) * d.N + d.n0 + (lane & 15) * 4;
#pragma unroll
    for (int i = 0; i < 16; ++i) v[i] = __builtin_nontemporal_load((const f32x4*)(p + (size_t)(4 * i) * d.N));
}
__device__ __forceinline__ void tstore(const TDesc& d, const f32x4 (&v)[16], const float (&gq)[2], LAS unsigned char* scr, int lane) {
    const int g = lane >> 4, l16 = lane & 15, r = l16 >> 2, c = l16 & 3; const unsigned sbase = (unsigned)(uintptr_t)scr;
    u32x2 t[8];
    if (d.f8) {
        const float g0 = gq[0] * W8_SCALE, g1 = gq[1] * W8_SCALE;
#pragma unroll
        for (int i = 0; i < 16; ++i) { const int k = 8 * i + (lane >> 3); const float gg = (i < 8) ? __shfl(g0, k) : __shfl(g1, k - 64); const f32x4 x = v[i] * gg;
            u32x2 pk; pk.x = cvt_pk_bf16(x[0], x[1]); pk.y = cvt_pk_bf16(x[2], x[3]); *(LAS u32x2*)(scr + k * 72 + (lane & 7) * 8) = pk; }
        asm volatile("s_waitcnt lgkmcnt(0)" ::: "memory");
        const unsigned lb = sbase + (unsigned)((16 * g + r) * 72 + 8 * c);
        unsigned char* W8 = (unsigned char*)d.WT;
#pragma unroll
        for (int jh = 0; jh < 2; ++jh) {
            if (jh == 0) { asm volatile("ds_read_b64_tr_b16 %0, %8 offset:0\n\tds_read_b64_tr_b16 %1, %8 offset:288\n\tds_read_b64_tr_b16 %2, %8 offset:576\n\tds_read_b64_tr_b16 %3, %8 offset:864\n\tds_read_b64_tr_b16 %4, %8 offset:4608\n\tds_read_b64_tr_b16 %5, %8 offset:4896\n\tds_read_b64_tr_b16 %6, %8 offset:5184\n\tds_read_b64_tr_b16 %7, %8 offset:5472\n\ts_waitcnt lgkmcnt(0)" : "=&v"(t[0]), "=&v"(t[1]), "=&v"(t[2]), "=&v"(t[3]), "=&v"(t[4]), "=&v"(t[5]), "=&v"(t[6]), "=&v"(t[7]) : "v"(lb) : "memory"); } else { asm volatile("ds_read_b64_tr_b16 %0, %8 offset:32\n\tds_read_b64_tr_b16 %1, %8 offset:320\n\tds_read_b64_tr_b16 %2, %8 offset:608\n\tds_read_b64_tr_b16 %3, %8 offset:896\n\tds_read_b64_tr_b16 %4, %8 offset:4640\n\tds_read_b64_tr_b16 %5, %8 offset:4928\n\tds_read_b64_tr_b16 %6, %8 offset:5216\n\tds_read_b64_tr_b16 %7, %8 offset:5504\n\ts_waitcnt lgkmcnt(0)" : "=&v"(t[0]), "=&v"(t[1]), "=&v"(t[2]), "=&v"(t[3]), "=&v"(t[4]), "=&v"(t[5]), "=&v"(t[6]), "=&v"(t[7]) : "v"(lb) : "memory"); }
#pragma unroll
            for (int jj = 0; jj < 2; ++jj) { const int j = jh * 2 + jj, nb = j >> 1, kc = (j & 1) * 4 + g; u32x4 o;
#pragma unroll
                for (int h = 0; h < 4; ++h) { const u32x2 w = t[jj * 4 + h];
                    o[h] = pk4_fp8(__uint_as_float(w.x << 16), __uint_as_float(w.x & 0xffff0000u), __uint_as_float(w.y << 16), __uint_as_float(w.y & 0xffff0000u)); }
                __builtin_nontemporal_store(o, (u32x4*)(W8 + d.ob + (size_t)(16 * nb + l16) * d.rs + 16 * kc)); } }
        return;
    }
    const float gv = gq[0];
#pragma unroll
    for (int i = 0; i < 16; ++i) { const int k = 4 * i + (lane >> 4); const float gg = __shfl(gv, k); const f32x4 x = v[i] * gg;
        u32x2 pk; pk.x = cvt_pk_bf16(x[0], x[1]); pk.y = cvt_pk_bf16(x[2], x[3]); *(LAS u32x2*)(scr + k * 144 + (lane & 15) * 8) = pk; }
    asm volatile("s_waitcnt lgkmcnt(0)" ::: "memory");
    const unsigned lb = sbase + (unsigned)((8 * g + r) * 144 + 8 * c);
#pragma unroll
    for (int jh = 0; jh < 2; ++jh) {
        if (jh == 0) { asm volatile("ds_read_b64_tr_b16 %0, %8 offset:0\n\tds_read_b64_tr_b16 %1, %8 offset:576\n\tds_read_b64_tr_b16 %2, %8 offset:4608\n\tds_read_b64_tr_b16 %3, %8 offset:5184\n\tds_read_b64_tr_b16 %4, %8 offset:32\n\tds_read_b64_tr_b16 %5, %8 offset:608\n\tds_read_b64_tr_b16 %6, %8 offset:4640\n\tds_read_b64_tr_b16 %7, %8 offset:5216\n\ts_waitcnt lgkmcnt(0)" : "=&v"(t[0]), "=&v"(t[1]), "=&v"(t[2]), "=&v"(t[3]), "=&v"(t[4]), "=&v"(t[5]), "=&v"(t[6]), "=&v"(t[7]) : "v"(lb) : "memory"); } else { asm volatile("ds_read_b64_tr_b16 %0, %8 offset:64\n\tds_read_b64_tr_b16 %1, %8 offset:640\n\tds_read_b64_tr_b16 %2, %8 offset:4672\n\tds_read_b64_tr_b16 %3, %8 offset:5248\n\tds_read_b64_tr_b16 %4, %8 offset:96\n\tds_read_b64_tr_b16 %5, %8 offset:672\n\tds_read_b64_tr_b16 %6, %8 offset:4704\n\tds_read_b64_tr_b16 %7, %8 offset:5280\n\ts_waitcnt lgkmcnt(0)" : "=&v"(t[0]), "=&v"(t[1]), "=&v"(t[2]), "=&v"(t[3]), "=&v"(t[4]), "=&v"(t[5]), "=&v"(t[6]), "=&v"(t[7]) : "v"(lb) : "memory"); }
#pragma unroll
        for (int jj = 0; jj < 4; ++jj) { const int j = jh * 4 + jj, nb = j >> 1, kc = (j & 1) * 4 + g; u32x4 o; o.x = t[2 * jj].x; o.y = t[2 * jj].y; o.z = t[2 * jj + 1].x; o.w = t[2 * jj + 1].y;
            *(u32x4*)(d.WT + d.ob + (size_t)(16 * nb + l16) * d.rs + 8 * kc) = o; } }
}

#ifndef DUP_MASK
#define DUP_MASK 0
#endif
struct MArgs { const float* in[30]; float* out; unsigned char* ws; int ph_lo, ph_hi; };
__global__ void __launch_bounds__(NTHR, 2) mega(MArgs args) {
    extern __shared__ __attribute__((aligned(16))) unsigned char lds_raw[];
    LAS unsigned char* lds = (LAS unsigned char*)lds_raw;
    const int tid = threadIdx.x;
    const int G = gridDim.x;
    unsigned char* ws = args.ws;
    unsigned* ctl = (unsigned*)(ws + WS_CTL);
    bf16_t* WB = (bf16_t*)(ws + WS_WBF);
    float* PART = (float*)(ws + WS_PART);
    LAS float* PL = (LAS float*)(lds + MISC_OFF + 4096);
    volatile LAS unsigned* MISC = (volatile LAS unsigned*)(lds + MISC_OFF);
    if (tid < 64) MISC[tid] = 0u;
    __syncthreads();
    const int lo = args.ph_lo, hi = args.ph_hi;
    const bool multi = (hi - lo) > 1;
    XcdBarrier bar; bar.bar = ctl + CW_BAR; bar.x = 0; bar.st = nullptr;
    if (multi) bar = xcd_barrier_post(ctl + CW_BAR, MISC + 8);
#define IN(k) (lo <= (k) && (k) < hi)
#define REP(k) for (int rep_ = 0; rep_ <= ((DUP_MASK >> (k)) & 1); ++rep_)
#define SEAM(k) do { if (IN(k) && IN((k) + 1)) xcd_barrier(bar); } while (0)
    const int NGW = G * NWAVES;
#define PHASE_IDS() const int ptid = opaque_tid(), lane = ptid & 63, wave = __builtin_amdgcn_readfirstlane(ptid >> 6), gw = blockIdx.x * NWAVES + wave; (void)lane; (void)gw

    constexpr int I_IN0 = (D / 64) * (INC / 64), I_SQ = (D / 64) * (D / 64), I_FF = (D / 64) * (FF / 64), I_DN = (FF / 64) * (D / 64), I_IN1 = (D / 64) * (2 * D / 64), I_LRU = 64 * 4;
    constexpr int NITEMS = I_IN0 + I_SQ + 2 * I_FF + I_DN + I_IN1 + I_SQ + I_LRU + NE * (2 * I_FF + I_DN);
    constexpr int NDENSE = I_IN0 + I_LRU;
    constexpr int QLRU = I_IN0 + I_SQ + 2 * I_FF + I_DN + I_IN1 + I_SQ;
    constexpr int QA = QLRU - I_IN0;
    constexpr int TAIL_ITEMS = 24576, TAILQ = ((NITEMS - I_IN0 - I_LRU) - TAIL_ITEMS) & ~15;
    static_assert(QA % 16 == 0 && (INC / 64) % 16 == 0 && (D / 64) % 16 == 0 && (FF / 64) % 16 == 0 && (2 * D / 64) % 16 == 0 && (FF / 32) % 16 == 0 && (D / 32) % 16 == 0, "a 16-item queue chunk stays inside one (matrix, k-block)");
    REP(0) if (IN(0)) { PHASE_IDS();
        LAS unsigned char* scr = lds + wave * 16384;
#define TDECODE(dd, it_) do { int r = (it_); \
            if (r < I_IN0) { tmake(dd, args.in[2], D, INC, WB + WT_IN0, 0, args.in[1], r); break; } r -= I_IN0; \
            if (r < I_SQ) { tmake(dd, args.in[9], D, D, WB + WT_OUT0, 0, nullptr, r); break; } r -= I_SQ; \
            if (r < I_FF) { tmake(dd, args.in[11], D, FF, WB + WT_GU0, 1, args.in[10], r, FFN8); break; } r -= I_FF; \
            if (r < I_FF) { tmake(dd, args.in[12], D, FF, WB + WT_GU0, 2, args.in[10], r, FFN8); break; } r -= I_FF; \
            if (r < I_DN) { tmake(dd, args.in[13], FF, D, WB + WT_DN0, 0, nullptr, r, FFN8); break; } r -= I_DN; \
            if (r < I_IN1) { tmake(dd, args.in[15], D, 2 * D, WB + WT_IN1, 0, args.in[14], r); break; } r -= I_IN1; \
            if (r < I_SQ) { tmake(dd, args.in[23], D, D, WB + WT_OUT1, 0, nullptr, r); break; } r -= I_SQ; \
            if (r < I_LRU) { const int mat = r >> 2, sub = r & 3; const float* src = (mat < 32 ? args.in[18] : args.in[20]) + (size_t)(mat & 31) * LBD * LBD; \
                tmake(dd, src, LBD, LBD, WB + WT_LRU + (size_t)mat * LBD * LBD, 0, nullptr, sub); break; } r -= I_LRU; \
            { const int per = 2 * I_FF + I_DN, e = r / per; int q = r % per; \
              if (q < I_FF) { tmake(dd, args.in[26] + (size_t)e * D * FF, D, FF, (bf16_t*)((unsigned char*)(WB + WT_MGU) + (size_t)e * 2 * FF * D), 1, args.in[24], q, 1); break; } q -= I_FF; \
              if (q < I_FF) { tmake(dd, args.in[27] + (size_t)e * D * FF, D, FF, (bf16_t*)((unsigned char*)(WB + WT_MGU) + (size_t)e * 2 * FF * D), 2, args.in[24], q, 1); break; } q -= I_FF; \
              tmake(dd, args.in[28] + (size_t)e * FF * D, FF, D, (bf16_t*)((unsigned char*)(WB + WT_MDN) + (size_t)e * FF * D), 0, nullptr, q, 1); } } while (0)
        { TDesc dc, dn; f32x4 cur[16], nxt[16]; float gc[2], gn2[2]; int it = gw;
#define P0_ITEM(i_) ((i_) < I_IN0 ? (i_) : (i_) - I_IN0 + QLRU)
          if (it < NDENSE) { TDECODE(dc, P0_ITEM(it)); tload(dc, cur, gc, lane); }
          for (; it < NDENSE; it += NGW) {
              const int nit = it + NGW; const bool hn = nit < NDENSE;
              if (hn) { TDECODE(dn, P0_ITEM(nit)); tload(dn, nxt, gn2, lane); }
              tstore(dc, cur, gc, scr, lane);
              if (hn) { dc = dn; gc[0] = gn2[0]; gc[1] = gn2[1];
#pragma unroll
                  for (int i = 0; i < 16; ++i) cur[i] = nxt[i]; } }
#undef P0_ITEM
        }
        { float* C8 = (float*)(ws + WS_C8SP);
          for (int i = blockIdx.x * NTHR + tid; i < 2 * D; i += G * NTHR) { const float ap = args.in[22][i]; const float sp = (-ap > 20.f) ? -ap : log1pf(expf(-ap)); C8[i] = -8.0f * sp * 1.4426950408889634f; } }
        { float* RC = (float*)(ws + WS_ROPE); float* RS = RC + S * 32;
          for (int i = blockIdx.x * NTHR + tid; i < S * 32; i += G * NTHR) { const int s = i / 32, j = i % 32; const float inv = 1.0f / powf(10000.0f, (float)(2 * j) / 64.0f); const float ang = (float)s * inv; RC[i] = cosf(ang); RS[i] = sinf(ang); } }
        { bf16_t* XB = (bf16_t*)(ws + WS_XB);
          for (int m = gw; m < T; m += NGW) { const f32x4* xr = (const f32x4*)(args.in[0] + (size_t)m * D) + lane; float ss = 0.f;
#pragma unroll
              for (int j = 0; j < 8; ++j) { const f32x4 v = xr[64 * j]; ss += (v[0] * v[0] + v[1] * v[1]) + (v[2] * v[2] + v[3] * v[3]);
                  u32x2 w; w.x = cvt_pk_bf16(v[0], v[1]); w.y = cvt_pk_bf16(v[2], v[3]); *((u32x2*)(XB + (size_t)m * D) + lane + 64 * j) = w; }
              ss = wave_sum(ss); if (lane < 8) PART[(size_t)m * 8 + lane] = (lane == 0) ? ss : 0.f; } }
    }
    SEAM(0);
    REP(1) if (IN(1)) {
        Gemm g{(const bf16_t*)(ws + WS_XB), WB + WT_IN0, INC, D, 0}; StaticOrder So; So.init(T, INC, G, (int)blockIdx.x);
        EpiQkv E{(bf16_t*)(ws + WS_QKV), PART, (const float*)(ws + WS_ROPE), (const float*)(ws + WS_ROPE) + S * 32};
        gemm_phase<EpiQkv, StaticOrder, 2, false>(lds, g, So, E);
    }
    SEAM(1);
    REP(2) if (IN(2)) { PHASE_IDS();
        const bf16_t* QKV = (const bf16_t*)(ws + WS_QKV); bf16_t* ATT = (bf16_t*)(ws + WS_ATT);
        float s1 = 0.f, s2 = 0.f;
        for (int i = 0; i < 64; ++i) { s1 += args.in[4][i] * args.in[5][i]; s2 += args.in[6][i] * args.in[7][i]; }
        const float lam = expf(s1) - expf(s2) + 0.2f;
        const unsigned myx = xb_xcc_id() & 7u;
        if (tid == 0) MISC[16] = xb_add(ctl + CW_XRANK + 64 * myx, 1u);
        __syncthreads();
        const bool conv_first = (unsigned)__builtin_amdgcn_readfirstlane((int)MISC[16]) < (unsigned)NCV_PER_XCD;
#define P2_NEXT(dd, ok) do { if (crem == 0) { if (!qhave) { cstepn = (qpos >= TAILQ) ? 4 : 16; qnext = 4 * (int)__builtin_amdgcn_readfirstlane((int)(lane == 0 ? xb_add(ctl + CW_CVQ, (unsigned)(cstepn >> 2)) : 0u)); } \
                qpos = qnext; crem = cstepn; cbase = -1; qhave = false; } \
            if (cbase < 0 || (qpos & 15) == 0) { const int item_ = I_IN0 + qpos + (qpos >= QA ? I_LRU : 0); cvalid = item_ < NITEMS; if (cvalid) { TDECODE(cd, item_); } cbase = qpos; } \
            ok = cvalid; if (ok) { dd = cd; dd.n0 = cd.n0 + (qpos - cbase) * (cd.f8 ? 32 : 64); dd.rbase = (cd.mode == 0) ? dd.n0 : (256 * (dd.n0 >> 7) + (dd.n0 & 127) + (cd.mode == 2 ? 128 : 0)); tfix(dd); } \
            ++qpos; --crem; qwant = (crem == 0) && cvalid; } while (0)
#define P2_POST() do { if (qwant) { cstepn = (qpos >= TAILQ) ? 4 : 16; qnext = 4 * (int)__builtin_amdgcn_readfirstlane((int)(lane == 0 ? xb_add(ctl + CW_CVQ, (unsigned)(cstepn >> 2)) : 0u)); qhave = true; qwant = false; } } while (0)
#define P2_CONVERT() do { LAS unsigned char* scr = lds + wave * 16384; TDesc cd, dc, dn; f32x4 cur[16], nxt[16]; float gc[2], gn2[2]; int qpos = 0, crem = 0, cbase = -1, cstepn = 16, qnext = 0; bool cvalid = false, qhave = false, qwant = false, okc, okn; \
            P2_NEXT(dc, okc); if (okc) tload(dc, cur, gc, lane); P2_POST(); \
            while (okc) { \
                P2_NEXT(dn, okn); if (okn) tload(dn, nxt, gn2, lane); P2_POST(); \
                tstore(dc, cur, gc, scr, lane); \
                if (okn) { dc = dn; gc[0] = gn2[0]; gc[1] = gn2[1]; _Pragma("unroll") for (int i = 0; i < 16; ++i) cur[i] = nxt[i]; } \
                okc = okn; } \
            __syncthreads(); } while (0)
#define P2_CONVERT3() do { const int lane = opaque_tid() & 63; LAS unsigned char* scr = lds + wave * 16384; TDesc cd, d0, d1, d2; f32x4 b0[16], b1[16], b2[16]; float g0q[2], g1q[2], g2q[2]; int qpos = 0, crem = 0, cbase = -1, cstepn = 16, qnext = 0; bool cvalid = false, qhave = false, qwant = false, k0, k1, k2; \
            P2_NEXT(d0, k0); if (k0) tload(d0, b0, g0q, lane); P2_POST(); \
            P2_NEXT(d1, k1); if (k1) tload(d1, b1, g1q, lane); P2_POST(); \
            while (k0) { \
                P2_NEXT(d2, k2); if (k2) tload(d2, b2, g2q, lane); P2_POST(); \
                tstore(d0, b0, g0q, scr, lane); \
                if (!k1) break; \
                P2_NEXT(d0, k0); if (k0) tload(d0, b0, g0q, lane); P2_POST(); \
                tstore(d1, b1, g1q, scr, lane); \
                if (!k2) break; \
                P2_NEXT(d1, k1); if (k1) tload(d1, b1, g1q, lane); P2_POST(); \
                tstore(d2, b2, g2q, scr, lane); } \
            } while (0)
        if (conv_first) { P2_CONVERT3(); __syncthreads(); }
#pragma unroll 1
        for (unsigned qx = 0; qx < 8; ++qx) { const unsigned x = (myx + qx) & 7u;
            for (;;) {
                __syncthreads();
                if (tid == 0) MISC[17] = xb_add(ctl + CW_AQ + 64 * x, 1u);
                __syncthreads();
                const unsigned u = MISC[17]; if (u >= 96u) break;
                if (u < 64u) { const int bh = 2 * (int)x + (int)(u >> 5), qb = (int)(u & 31u); att::attn_unit<0>(QKV, ATT, bh >> 3, bh & 7, qb, lds, args.in[8], lam, nullptr); }
                else { const int c = (int)u - 64, bh = 2 * (int)x + (c >> 4), rb = c & 15; att::na_unit(QKV, ATT, bh >> 3, bh & 7, rb, lds, args.in[3]); } } }
        __syncthreads();
        if (!conv_first) { P2_CONVERT3(); __syncthreads(); }
#undef P2_CONVERT
#undef P2_CONVERT3
#undef P2_NEXT
#undef P2_POST
    }
#undef TDECODE
    SEAM(2);
    REP(3) if (IN(3)) {
        Gemm g{(const bf16_t*)(ws + WS_ATT), WB + WT_OUT0, D, D, 0}; StaticOrder So; So.init(T, D, G, (int)blockIdx.x);
        EpiResid E{args.in[0], (float*)(ws + WS_X1), (bf16_t*)(ws + WS_XB), PART + 8 * T, PL, FFN8 ? (unsigned char*)(ws + WS_HA) : nullptr, 1.f};
        gemm_phase<EpiResid, StaticOrder, 0, false>(lds, g, So, E);
    }
    SEAM(3);
    REP(4) if (IN(4)) {
        Gemm g{(const bf16_t*)(ws + (FFN8 ? WS_HA : WS_XB)), WB + WT_GU0, 2 * FF, D, 0}; StaticOrder So; So.init(T, 2 * FF, G, (int)blockIdx.x);
        EpiGateUp<false, FFN8> E{(bf16_t*)(ws + WS_ACT), PART + 8 * T, nullptr};
        gemm_phase<EpiGateUp<false, FFN8>, StaticOrder, 1, false, FFN8>(lds, g, So, E);
    }
    SEAM(4);
    REP(5) if (IN(5)) {
        Gemm g{(const bf16_t*)(ws + WS_ACT), WB + WT_DN0, D, FF, 0}; StaticOrder So; So.init(T, D, G, (int)blockIdx.x);
        EpiResid E{(const float*)(ws + WS_X1), (float*)(ws + WS_X2), (bf16_t*)(ws + WS_XB), PART + 16 * T, PL, nullptr, FFN8 ? W8_INV : 1.f};
        gemm_phase<EpiResid, StaticOrder, 0, false, FFN8>(lds, g, So, E);
    }
    SEAM(5);
    REP(6) if (IN(6)) {
        Gemm g{(const bf16_t*)(ws + WS_XB), WB + WT_IN1, 2 * D, D, 0}; StaticOrder So; So.init(T, 2 * D, G, (int)blockIdx.x);
        EpiL1In E{(bf16_t*)(ws + WS_Y), (bf16_t*)(ws + WS_REC), PART + 16 * T};
        gemm_phase<EpiL1In, StaticOrder, 1, false>(lds, g, So, E);
    }
    SEAM(6);
    REP(7) if (IN(7)) {
        const int ptid = opaque_tid(), wv = __builtin_amdgcn_readfirstlane(ptid >> 6);
        const bf16_t* REC = (const bf16_t*)(ws + WS_REC); bf16_t* AB = (bf16_t*)(ws + WS_AB); const float* C8 = (const float*)(ws + WS_C8SP);
        float* SUMM = (float*)(ws + WS_SUMM);
        LAS unsigned char* Us = lds;
        LAS unsigned char* Ws = lds + 65536;
        LAS float* BL = (LAS float*)(lds + MISC_OFF + 8192);
        LAS unsigned char* TB = Us + wv * 8192;
#define SWZ(row, colB) ((row) * 256 + ((colB) ^ (((row) & 7) << 4)))
        constexpr float L2E = 1.4426950408889634f;
        for (int unit = blockIdx.x; unit < (T / 256) * LB; unit += G) {
            const int nb_ = unit % LB, tt = unit / LB, t0 = tt * 256, c0 = nb_ * LBD;
            {
              const int ctid = opaque_tid(); const int cg = ctid & 15, tr = ctid >> 4, cc = c0 + cg * 8; const int tb = t0 & ~(S - 1);
              float w8[4][8], b8[8];
              { const f32x4 b0 = *(const f32x4*)(args.in[17] + cc), b1 = *(const f32x4*)(args.in[17] + cc + 4);
#pragma unroll
                for (int i = 0; i < 4; ++i) { b8[i] = b0[i]; b8[4 + i] = b1[i]; } }
#pragma unroll
              for (int j = 0; j < 4; ++j) { const f32x4 x0 = *(const f32x4*)(args.in[16] + j * D + cc), x1 = *(const f32x4*)(args.in[16] + j * D + cc + 4);
#pragma unroll
                  for (int i = 0; i < 4; ++i) { w8[j][i] = x0[i]; w8[j][4 + i] = x1[i]; } }
              u32x4 rv[11];
#pragma unroll
              for (int q = 0; q < 11; ++q) { const int t = t0 + tr * 8 + q - 1; const bool ok = (t >= tb) && (t < tb + S);
                  rv[q] = ok ? *(const u32x4*)(REC + ((size_t)(t >> 8) * LB + nb_) * (256 * LBD) + (size_t)(t & 255) * LBD + cg * 8) : (u32x4){0u, 0u, 0u, 0u}; }
#pragma unroll
              for (int q = 0; q < 8; ++q) { float uo[8];
#pragma unroll
                  for (int i = 0; i < 8; ++i) { float acc_ = b8[i];
#pragma unroll
                      for (int j = 0; j < 4; ++j) { const unsigned w = rv[q + j][i >> 1]; acc_ += w8[j][i] * __uint_as_float((i & 1) ? (w & 0xffff0000u) : (w << 16)); }
                      uo[i] = acc_; }
                  u32x4 pk; pk.x = cvt_pk_bf16(uo[0], uo[1]); pk.y = cvt_pk_bf16(uo[2], uo[3]); pk.z = cvt_pk_bf16(uo[4], uo[5]); pk.w = cvt_pk_bf16(uo[6], uo[7]);
                  *(LAS u32x4*)(Us + SWZ(tr * 8 + q, cg * 16)) = pk; } }
            asm volatile("s_waitcnt lgkmcnt(0)" ::: "memory");
            bf16x8 uf[2][4]; const int ul = opaque_tid();
#pragma unroll
            for (int tg = 0; tg < 2; ++tg)
#pragma unroll
                for (int ks = 0; ks < 4; ++ks) uf[tg][ks] = *(const LAS bf16x8*)(Us + SWZ((ul >> 6) * 32 + tg * 16 + (ul & 15), 64 * ((ul >> 4) & 3) + 16 * ks));
#pragma unroll 1
            for (int dir = 0; dir < 2; ++dir) {
                __syncthreads();
                { const int stid = opaque_tid();
                  const bf16_t* wa = WB + WT_LRU + (size_t)(0 * 32 + dir * 16 + nb_) * LBD * LBD; const bf16_t* wx = WB + WT_LRU + (size_t)(1 * 32 + dir * 16 + nb_) * LBD * LBD;
#pragma unroll
                  for (int q = 0; q < 4; ++q) { const int idx = stid + q * NTHR, slot = idx >> 4, ch = idx & 15, row = 32 * ((slot & 15) >> 2) + 4 * (slot >> 4) + (slot & 3);
                      *(LAS u32x4*)(Ws + SWZ(slot, ch * 16)) = *(const u32x4*)(wa + row * LBD + ch * 8);
                      *(LAS u32x4*)(Ws + 32768 + SWZ(slot, ch * 16)) = *(const u32x4*)(wx + row * LBD + ch * 8); }
                  if (dir == 0) { for (int i = stid; i < 768; i += NTHR) { const int d_ = i / 384, k_ = (i >> 7) % 3, c_ = i & 127;
                      BL[i] = (k_ == 0) ? -L2E * args.in[19][d_ * D + c0 + c_] : (k_ == 1) ? -L2E * args.in[21][d_ * D + c0 + c_] : C8[d_ * D + c0 + c_]; } } }
                __syncthreads();
                f32x4 aa[2][8], ax[2][8]; const int ml = opaque_tid() & 63, mfr = ml & 15, mfq = ml >> 4;
#pragma unroll
                for (int nb = 0; nb < 8; ++nb) { aa[0][nb] = (f32x4){0.f, 0.f, 0.f, 0.f}; ax[0][nb] = aa[0][nb]; aa[1][nb] = aa[0][nb]; ax[1][nb] = aa[0][nb]; }
#pragma unroll
                for (int ks = 0; ks < 4; ++ks)
#pragma unroll
                    for (int nb = 0; nb < 8; ++nb) { const bf16x8 wfa = *(const LAS bf16x8*)(Ws + SWZ(nb * 16 + mfr, 64 * mfq + 16 * ks)), wfx = *(const LAS bf16x8*)(Ws + 32768 + SWZ(nb * 16 + mfr, 64 * mfq + 16 * ks));
                        aa[0][nb] = __builtin_amdgcn_mfma_f32_16x16x32_bf16(wfa, uf[0][ks], aa[0][nb], 0, 0, 0); ax[0][nb] = __builtin_amdgcn_mfma_f32_16x16x32_bf16(wfx, uf[0][ks], ax[0][nb], 0, 0, 0);
                        aa[1][nb] = __builtin_amdgcn_mfma_f32_16x16x32_bf16(wfa, uf[1][ks], aa[1][nb], 0, 0, 0); ax[1][nb] = __builtin_amdgcn_mfma_f32_16x16x32_bf16(wfx, uf[1][ks], ax[1][nb], 0, 0, 0); }
                const int l2 = opaque_tid() & 63, fr2 = l2 & 15, fq2 = l2 >> 4;
                const LAS float* blp = BL + dir * 384 + 32 * fq2;
                float sml[2][2], smh[2][2];
#pragma unroll
                for (int tg = 0; tg < 2; ++tg) {
#pragma unroll
                    for (int nb = 0; nb < 8; ++nb) {
                        const f32x4 ba = *(const LAS f32x4*)(blp + 4 * nb), bx = *(const LAS f32x4*)(blp + 128 + 4 * nb), c8 = *(const LAS f32x4*)(blp + 256 + 4 * nb);
                        const unsigned w0 = (unsigned)(unsigned short)uf[tg][nb >> 1][(nb & 1) * 4 + 0] | ((unsigned)(unsigned short)uf[tg][nb >> 1][(nb & 1) * 4 + 1] << 16);
                        const unsigned w1 = (unsigned)(unsigned short)uf[tg][nb >> 1][(nb & 1) * 4 + 2] | ((unsigned)(unsigned short)uf[tg][nb >> 1][(nb & 1) * 4 + 3] << 16);
                        const float uvv[4] = {__uint_as_float(w0 << 16), __uint_as_float(w0 & 0xffff0000u), __uint_as_float(w1 << 16), __uint_as_float(w1 & 0xffff0000u)};
                        float av[4], bv[4];
#pragma unroll
                        for (int i = 0; i < 4; ++i) { const float ga = __builtin_amdgcn_rcpf(1.f + __builtin_amdgcn_exp2f(fmaf(aa[tg][nb][i], -L2E, ba[i]))), gx = __builtin_amdgcn_rcpf(1.f + __builtin_amdgcn_exp2f(fmaf(ax[tg][nb][i], -L2E, bx[i])));
                            const float la2 = c8[i] * ga; const float a = __builtin_amdgcn_exp2f(la2);
                            av[i] = la2; bv[i] = __builtin_amdgcn_sqrtf(fmaxf(fmaf(-a, a, 1.f), 0.f)) * gx * uvv[i]; }
                        u32x2 pa, pb; pa.x = cvt_pk_bf16(av[0], av[1]); pa.y = cvt_pk_bf16(av[2], av[3]); pb.x = cvt_pk_bf16(bv[0], bv[1]); pb.y = cvt_pk_bf16(bv[2], bv[3]);
                        const int off = fr2 * 256 + (((4 * fq2 + (nb >> 1)) ^ fr2) << 4) + (nb & 1) * 8;
                        *(LAS u32x2*)(TB + off) = pa; *(LAS u32x2*)(TB + 4096 + off) = pb; }
                    asm volatile("s_waitcnt lgkmcnt(0)" ::: "memory");
#pragma unroll
                    for (int q = 0; q < 4; ++q) { const int row = 4 * q + fq2, chunk = fr2; const size_t go = (size_t)(wv * 32 + tg * 16 + row) * LBD + 8 * chunk;
                        const u32x4 va = *(const LAS u32x4*)(TB + row * 256 + ((chunk ^ row) << 4)), vb = *(const LAS u32x4*)(TB + 4096 + row * 256 + ((chunk ^ row) << 4));
                        *(u32x4*)(AB + (size_t)(unit * 4 + dir * 2 + 0) * (256 * LBD) + go) = va; *(u32x4*)(AB + (size_t)(unit * 4 + dir * 2 + 1) * (256 * LBD) + go) = vb; }
                    { float sl0 = 0.f, sl1 = 0.f, h0 = 0.f, h1 = 0.f; const int cc16 = (l2 >> 2) << 4, cin = (l2 & 3) * 4;
#pragma unroll
                      for (int i = 0; i < 16; ++i) { const int ri = dir ? 15 - i : i; const int ad = ri * 256 + (cc16 ^ (ri << 4)) + cin;
                          const unsigned wa_ = *(const LAS unsigned*)(TB + ad), wb_ = *(const LAS unsigned*)(TB + 4096 + ad);
                          const float la0 = __uint_as_float(wa_ << 16), la1 = __uint_as_float(wa_ & 0xffff0000u);
                          h0 = fmaf(__builtin_amdgcn_exp2f(la0), h0, __uint_as_float(wb_ << 16)); h1 = fmaf(__builtin_amdgcn_exp2f(la1), h1, __uint_as_float(wb_ & 0xffff0000u));
                          sl0 += la0; sl1 += la1; }
                      sml[tg][0] = sl0; sml[tg][1] = sl1; smh[tg][0] = h0; smh[tg][1] = h1; }
                }
                {
                  const int c = c0 + 2 * l2, b_ = t0 / S, chk = ((t0 & (S - 1)) >> 5) + wv;
                  f32x2 Pv, Hv;
#pragma unroll
                  for (int j = 0; j < 2; ++j) { const float A0 = __builtin_amdgcn_exp2f(sml[0][j]), A1 = __builtin_amdgcn_exp2f(sml[1][j]);
                      Pv[j] = __builtin_amdgcn_exp2f(sml[0][j] + sml[1][j]); Hv[j] = dir ? fmaf(A0, smh[1][j], smh[0][j]) : fmaf(A1, smh[0][j], smh[1][j]); }
                  float* sp = SUMM + ((size_t)((b_ * 2 + dir) * 128 + chk) * D) * 2 + (size_t)(c >> 2) * 8 + (c & 3);
                  *(f32x2*)sp = Pv; *(f32x2*)(sp + 4) = Hv; }
            }
        }
#undef SWZ
        __syncthreads();
    }
    SEAM(7);
    REP(9) if (IN(9)) {
        const int ptid = opaque_tid();
        const float* SUMM = (const float*)(ws + WS_SUMM); float* CARRY = (float*)(ws + WS_CARRY);
        for (int it = blockIdx.x * NTHR + ptid; it < NB * 2 * (D / 4) * 16; it += G * NTHR) {
            const int seg = it & 15, c4 = (it >> 4) % (D / 4), dir = ((it >> 4) / (D / 4)) % 2, b = (it >> 4) / (D / 4) / 2;
            f32x4 P[8], H[8];
#pragma unroll
            for (int j = 0; j < 8; ++j) { const int k = seg * 8 + j, ch = dir ? 127 - k : k; const size_t base = (size_t)((b * 2 + dir) * 128 + ch) * D + c4 * 4;
                P[j] = *(const f32x4*)(SUMM + base * 2); H[j] = *(const f32x4*)(SUMM + base * 2 + 4); }
            f32x4 A = P[0], Bv = H[0];
#pragma unroll
            for (int j = 1; j < 8; ++j) { Bv = P[j] * Bv + H[j]; A = A * P[j]; }
#pragma unroll
            for (int off = 1; off < 16; off <<= 1) { f32x4 Ap, Bp;
#pragma unroll
                for (int q = 0; q < 4; ++q) { Ap[q] = __shfl_up(A[q], off, 16); Bp[q] = __shfl_up(Bv[q], off, 16); }
                if (seg >= off) { Bv = A * Bp + Bv; A = A * Ap; } }
            f32x4 h;
#pragma unroll
            for (int q = 0; q < 4; ++q) h[q] = __shfl_up(Bv[q], 1, 16);
            if (seg == 0) h = (f32x4){0.f, 0.f, 0.f, 0.f};
#pragma unroll
            for (int j = 0; j < 8; ++j) { const int k = seg * 8 + j, ch = dir ? 127 - k : k; const size_t base = (size_t)((b * 2 + dir) * 128 + ch) * D + c4 * 4;
                *(f32x4*)(CARRY + base) = h; h = P[j] * h + H[j]; }
        }
    }
    SEAM(9);
    REP(10) if (IN(10)) {
        const int ptid = opaque_tid();
        const bf16_t* AB = (const bf16_t*)(ws + WS_AB); const float* CARRY = (const float*)(ws + WS_CARRY); const bf16_t* Y = (const bf16_t*)(ws + WS_Y); bf16_t* Z = (bf16_t*)(ws + WS_Z);
        for (int it = blockIdx.x * NTHR + ptid; it < NB * 128 * (D / 2); it += G * NTHR) {
            const int c2 = it % (D / 2), ch = (it / (D / 2)) % 128, b = it / (D / 2) / 128; const int c = c2 * 2;
            const bf16_t* af = AB + (size_t)((c >> 7) * 4) * (256 * LBD) + (c & 127); const bf16_t* bf = af + 256 * LBD; const bf16_t* ab = af + 2 * 256 * LBD; const bf16_t* bb = af + 3 * 256 * LBD;
#define LD2(p) ({ const unsigned _w = *(const unsigned*)(p); (f32x2){__uint_as_float(_w << 16), __uint_as_float(_w & 0xffff0000u)}; })
#define EXP2V(v) ((f32x2){__builtin_amdgcn_exp2f((v)[0]), __builtin_amdgcn_exp2f((v)[1])})
            f32x2 h = *(const f32x2*)(CARRY + (size_t)((b * 2 + 0) * 128 + ch) * D + c);
            LAS f32x2* hf = (LAS f32x2*)lds + ptid;
            const size_t o0 = (size_t)(b * S + ch * 32) * D; const int tk0 = b * S + ch * 32; const size_t q0 = (size_t)(tk0 >> 8) * (LB * 4 * 256 * LBD) + (size_t)(tk0 & 255) * LBD;
#pragma unroll 8
            for (int i = 0; i < 32; ++i) { const size_t o = q0 + (size_t)i * LBD; const f32x2 la = LD2(af + o); h = EXP2V(la) * h + LD2(bf + o); hf[i * NTHR] = h; }
            h = *(const f32x2*)(CARRY + (size_t)((b * 2 + 1) * 128 + ch) * D + c);
#pragma unroll 8
            for (int i = 31; i >= 0; --i) { const size_t o = o0 + (size_t)i * D, q = q0 + (size_t)i * LBD; const f32x2 la = LD2(ab + q); h = EXP2V(la) * h + LD2(bb + q);
                const unsigned yv = *(const unsigned*)(Y + o + c); const float y0 = __uint_as_float(yv << 16), y1 = __uint_as_float(yv & 0xffff0000u);
                const f32x2 hv = hf[i * NTHR];
                *(unsigned*)(Z + o + c) = cvt_pk_bf16(y0 * (hv[0] + h[0]), y1 * (hv[1] + h[1])); }
#undef LD2
#undef EXP2V
        }
    }
    SEAM(10);
    REP(11) if (IN(11)) {
        Gemm g{(const bf16_t*)(ws + WS_Z), WB + WT_OUT1, D, D, 0}; StaticOrder So; So.init(T, D, G, (int)blockIdx.x);
        EpiResid E{(const float*)(ws + WS_X2), (float*)(ws + WS_X1), (bf16_t*)(ws + WS_XB), PART + 24 * T, PL, nullptr, 1.f};
        gemm_phase<EpiResid, StaticOrder, 0, false>(lds, g, So, E);
    }
    SEAM(11);
    REP(12) if (IN(12)) { PHASE_IDS();
        const float* X3 = (const float*)(ws + WS_X1); const float* P3 = PART + 24 * T; const float* gn = args.in[24]; const float* rw = args.in[25];
        int* LIST = (int*)(ws + WS_LIST); int* INV = (int*)(ws + WS_INV); float* GATEW = (float*)(ws + WS_GATEW); unsigned* CNT = ctl + CW_CNT;
        volatile LAS int* sel = (volatile LAS int*)(lds + MISC_OFF + 8192);
        unsigned char* XN8 = (unsigned char*)(ws + WS_HA);
        LAS float* RT = (LAS float*)lds;
        f32x4 xr[8], xq[8];
        if ((int)blockIdx.x * 32 < T) {
#pragma unroll
            for (int j = 0; j < 8; ++j) xr[j] = *(const f32x4*)(X3 + (size_t)(blockIdx.x * 32 + wave * 4) * D + lane * 4 + 256 * j); }
        __syncthreads();
        for (int idx = tid; idx < D * 2; idx += NTHR) { const int c = idx >> 1, hf = idx & 1, slot = ((c >> 8) * 4 + (c & 3)) * 64 + ((c & 255) >> 2);
            *(LAS f32x4*)(RT + slot * 8 + hf * 4) = *(const f32x4*)(rw + (size_t)c * NE + hf * 4) * gn[c]; }
        __syncthreads();
        for (int t0 = blockIdx.x * 32; t0 < T; t0 += G * 32) {
            if (t0 != (int)blockIdx.x * 32) {
#pragma unroll
                for (int j = 0; j < 8; ++j) xr[j] = *(const f32x4*)(X3 + (size_t)(t0 + wave * 4) * D + lane * 4 + 256 * j); }
#pragma unroll 1
            for (int q = 0; q < 4; ++q) { const int tl = wave * 4 + q, t = t0 + tl;
                if (q < 3) {
#pragma unroll
                    for (int j = 0; j < 8; ++j) xq[j] = *(const f32x4*)(X3 + (size_t)(t + 1) * D + lane * 4 + 256 * j); }
                const float rstd = row_rstd(P3, t); float lg[NE];
#pragma unroll
                for (int e = 0; e < NE; ++e) lg[e] = 0.f;
#pragma unroll
                for (int j = 0; j < 8; ++j) { const int c0 = lane * 4 + 256 * j; const f32x4 xv = xr[j] * rstd;
                    *(unsigned*)(XN8 + (size_t)t * D + c0) = pk4_fp8(xv[0], xv[1], xv[2], xv[3]);
#pragma unroll
                    for (int i = 0; i < 4; ++i) { const float hv = xv[i]; const LAS float* rp = RT + ((j * 4 + i) * 64 + lane) * 8; const f32x4 r0 = *(const LAS f32x4*)rp, r1 = *(const LAS f32x4*)(rp + 4);
                        lg[0] += hv * r0[0]; lg[1] += hv * r0[1]; lg[2] += hv * r0[2]; lg[3] += hv * r0[3]; lg[4] += hv * r1[0]; lg[5] += hv * r1[1]; lg[6] += hv * r1[2]; lg[7] += hv * r1[3]; } }
#pragma unroll
                for (int e = 0; e < NE; ++e) lg[e] = wave_sum(lg[e]);
                int i1 = 0; float v1 = lg[0];
#pragma unroll
                for (int e = 1; e < NE; ++e) if (lg[e] > v1) { v1 = lg[e]; i1 = e; }
                int i2 = -1; float v2 = -3.0e38f;
#pragma unroll
                for (int e = 0; e < NE; ++e) if (e != i1 && lg[e] > v2) { v2 = lg[e]; i2 = e; }
                const float e2 = __expf(v2 - v1), g1 = 1.f / (1.f + e2), g2 = e2 / (1.f + e2);
                if (lane == 0) { sel[2 * tl] = i1; sel[2 * tl + 1] = i2; GATEW[2 * t] = g1; GATEW[2 * t + 1] = g2; }
#pragma unroll
                for (int j = 0; j < 8; ++j) xr[j] = xq[j];
            }
            __syncthreads();
            if (tid < NE) { int n = 0; for (int a = 0; a < 64; ++a) n += (sel[a] == tid) ? 1 : 0;
                sel[64 + tid] = n ? (int)__hip_atomic_fetch_add(CNT + tid, (unsigned)n, __ATOMIC_RELAXED, __HIP_MEMORY_SCOPE_AGENT) : 0; }
            __syncthreads();
            if (tid < 64) { const int e = sel[tid]; int rank = 0; for (int a = 0; a < tid; ++a) rank += (sel[a] == e) ? 1 : 0;
                const int ent = 2 * (t0 + (tid >> 1)) + (tid & 1), pos = sel[64 + e] + rank; LIST[e * T + pos] = ent; INV[ent] = e * T + pos; }
            __syncthreads();
        }
    }
    SEAM(12);
    if (IN(13) || IN(14)) {
        volatile LAS int* tab = (volatile LAS int*)(lds + MISC_OFF + 12288);
        if (tid < NE) tab[tid] = (int)__hip_atomic_load(ctl + CW_CNT + tid, __ATOMIC_RELAXED, __HIP_MEMORY_SCOPE_AGENT);
        __syncthreads();
        if (tid == 0) { int p = 0; for (int e = 0; e < NE; ++e) { tab[8 + e] = p; p += (tab[e] + BM - 1) / BM; } tab[16] = p; }
        __syncthreads();
        REP(13) if (IN(13)) {
            Gemm g{(const bf16_t*)(ws + WS_HA), WB + WT_MGU, 2 * FF, D, (size_t)2 * FF * D}; MoeOrder Mo; Mo.init(tab, (const int*)(ws + WS_LIST), 2 * FF / BM, G, (int)blockIdx.x);
            EpiGateUp<true> E{(bf16_t*)(ws + WS_MACT), PART + 24 * T, (const int*)(ws + WS_LIST)};
            gemm_phase<EpiGateUp<true>, MoeOrder, 1, true, true>(lds, g, Mo, E);
        }
        SEAM(13);
        REP(14) if (IN(14)) {
            Gemm g{(const bf16_t*)(ws + WS_MACT), WB + WT_MDN, D, FF, (size_t)FF * D}; MoeOrder Mo; Mo.init(tab, (const int*)(ws + WS_LIST), D / BM, G, (int)blockIdx.x); Mo.ksplit = (G == 256 && Mo.nwg >= 2 * G) ? 1 : 0; Mo.KT4 = FF / 128 / 4;
            EpiMoeDown E{(bf16_t*)(ws + WS_CONTRIB), (const int*)(ws + WS_LIST), (const float*)(ws + WS_GATEW), (float*)(ws + WS_PARTK)};
            gemm_phase<EpiMoeDown, MoeOrder, 0, false, true>(lds, g, Mo, E);
        }
    }
    SEAM(14);
    REP(15) if (IN(15)) { PHASE_IDS();
        const float* X3 = (const float*)(ws + WS_X1); const bf16_t* C = (const bf16_t*)(ws + WS_CONTRIB); const float* gn = args.in[29];
        const int* INV = (const int*)(ws + WS_INV); const float* GATEW = (const float*)(ws + WS_GATEW); const float* PARTK = (const float*)(ws + WS_PARTK);
        volatile LAS int* tab = (volatile LAS int*)(lds + MISC_OFF + 12288);
        __syncthreads();
        if (tid < NE) tab[tid] = (int)__hip_atomic_load(ctl + CW_CNT + tid, __ATOMIC_RELAXED, __HIP_MEMORY_SCOPE_AGENT);
        __syncthreads();
        if (tid == 0) { int p = 0; for (int e = 0; e < NE; ++e) { tab[8 + e] = p; p += (tab[e] + BM - 1) / BM; } tab[16] = p; }
        __syncthreads();
        const int nwg = __builtin_amdgcn_readfirstlane(tab[16]) * (D / BM); const bool ksplit = (G == 256 && nwg >= 2 * G);
        const int cq = nwg / NXCD, cr = nwg % NXCD, cb_ = cr * (cq + 1);
        for (int t = gw; t < T; t += NGW) { f32x4 v[8]; float ss = 0.f;
            u32x2 ca[2][8];
#pragma unroll
            for (int j = 0; j < 8; ++j) { v[j] = *(const f32x4*)(X3 + (size_t)t * D + lane * 4 + 256 * j);
                ca[0][j] = *(const u32x2*)(C + (size_t)(2 * t) * D + lane * 4 + 256 * j); ca[1][j] = *(const u32x2*)(C + (size_t)(2 * t + 1) * D + lane * 4 + 256 * j); }
            unsigned smask = 0u;
            int ridx_[2][8]; int lr_[2] = {0, 0}; float gw8_[2] = {0.f, 0.f};
            if (ksplit) {
#pragma unroll
                for (int k = 0; k < 2; ++k) { const int ent = 2 * t + k; const int inv = __builtin_amdgcn_readfirstlane(INV[ent]); const int e = inv >> 13, li = inv & (T - 1);
                    const int p0 = __builtin_amdgcn_readfirstlane(tab[8 + e]), npan = __builtin_amdgcn_readfirstlane(tab[9 + e]) - p0, pl = li >> 8; lr_[k] = li & 255; gw8_[k] = GATEW[ent] * W8_INV;
#pragma unroll
                    for (int j = 0; j < 8; ++j) { const int wg = p0 * (D / BM) + j * npan + pl; int x, off;
                        if (wg < cb_) { x = wg / (cq + 1); off = wg - x * (cq + 1); } else { const int w2 = wg - cb_; x = w2 / cq; off = w2 - x * cq; x += cr; }
                        ridx_[k][j] = (off - 2 * G / NXCD) * NXCD + x; if (off >= 2 * G / NXCD) smask |= 1u << (k * 8 + j); } } }
#pragma unroll
            for (int k = 0; k < 2; ++k)
#pragma unroll
                for (int j = 0; j < 8; ++j) { const u32x2 c2 = ca[k][j];
                    const f32x4 cv = {__uint_as_float(c2.x << 16), __uint_as_float(c2.x & 0xffff0000u), __uint_as_float(c2.y << 16), __uint_as_float(c2.y & 0xffff0000u)};
                    if (!((smask >> (k * 8 + j)) & 1u)) v[j] = v[j] + cv; }
            if (smask) {
#pragma unroll
                for (int k = 0; k < 2; ++k)
#pragma unroll
                    for (int j = 0; j < 8; ++j) if ((smask >> (k * 8 + j)) & 1u) { const float* pp = PARTK + ((size_t)(ridx_[k][j] * 4) << 16) + lr_[k] * BM + lane * 4;
                        const f32x4 sm = (*(const f32x4*)pp + *(const f32x4*)(pp + 65536)) + (*(const f32x4*)(pp + 2 * 65536) + *(const f32x4*)(pp + 3 * 65536));
                        v[j] = v[j] + sm * gw8_[k]; } }
#pragma unroll
            for (int j = 0; j < 8; ++j) ss += (v[j][0] * v[j][0] + v[j][1] * v[j][1]) + (v[j][2] * v[j][2] + v[j][3] * v[j][3]);
            ss = wave_sum(ss); const float rs = rsqrtf(ss * (1.0f / D) + EPS);
#pragma unroll
            for (int j = 0; j < 8; ++j) { const int c0 = lane * 4 + 256 * j; *(f32x4*)(args.out + (size_t)t * D + c0) = v[j] * rs * *(const f32x4*)(gn + c0); } }
    }
#undef IN
#undef SEAM
}

static int g_grid = 0;
static void mega_launch(hipStream_t st, const float* const* in, float* out, unsigned char* ws, int lo, int hi) {
    MArgs a{};
    for (int i = 0; i < 30; ++i) a.in[i] = in[i];
    a.out = out; a.ws = ws; a.ph_lo = lo; a.ph_hi = hi;
    hipLaunchKernelGGL(mega, dim3(g_grid), dim3(NTHR), LDS_BYTES, st, a);
}

extern "C" void kernel_launch(void* const* d_in, const int* in_sizes, int n_in, void* d_out, int out_size, void* d_ws, size_t ws_size, hipStream_t stream) {
    if (n_in != 30 || out_size != T * D || ws_size < WS_END2) { fprintf(stderr, "kernel_launch: unexpected shapes n_in %d out %d ws %zu (need %zu)\n", n_in, out_size, ws_size, (size_t)WS_END); return; }
    const float* const* in = (const float* const*)d_in;
    unsigned char* ws = (unsigned char*)d_ws;
    if (g_grid == 0) {
        int dev = 0, cus = 0;
        if (hipGetDevice(&dev) != hipSuccess || hipDeviceGetAttribute(&cus, hipDeviceAttributeMultiprocessorCount, dev) != hipSuccess) { fprintf(stderr, "kernel_launch: device query failed\n"); return; }
        if (hipFuncSetAttribute((const void*)mega, hipFuncAttributeMaxDynamicSharedMemorySize, LDS_BYTES) != hipSuccess) { fprintf(stderr, "kernel_launch: hipFuncSetAttribute failed\n"); return; }
        int per_cu = 0;
        if (hipOccupancyMaxActiveBlocksPerMultiprocessor(&per_cu, (const void*)mega, NTHR, LDS_BYTES) != hipSuccess || per_cu < 1) { fprintf(stderr, "kernel_launch: occupancy query says %d\n", per_cu); (void)hipGetLastError(); }
        g_grid = cus;
    }
    (void)hipMemsetAsync(ws + WS_CTL, 0, CTL_BYTES, stream);
    mega_launch(stream, in, (float*)d_out, ws, 0, 16);
}
```

```cpp
#include <hip/hip_runtime.h>
#include <stdint.h>
#include <stdio.h>

typedef unsigned short bf16_t;
typedef short bf16x8 __attribute__((ext_vector_type(8)));
typedef float f32x4 __attribute__((ext_vector_type(4)));

constexpr int NB = 2, S = 4096, T = NB * S, D = 2048;
constexpr int HD = 128, NAH = 8, DAH = 8, DQ = 64;
constexpr int GW = 64, GR = S / GW, KH = 8, KW = 16;
constexpr int INC = 6144, FF = 7168, NE = 8;
constexpr int LB = 16, LBD = 128;
constexpr float EPS = 1e-6f;

constexpr size_t MiB = 1048576;
constexpr size_t WS_WBF = 0;
constexpr size_t WS_X1 = 816 * MiB;
constexpr size_t WS_X2 = WS_X1 + 64 * MiB;
constexpr size_t WS_HA = WS_X2 + 64 * MiB;
constexpr size_t WS_HB = WS_HA + 32 * MiB;
constexpr size_t WS_R1 = WS_HB + 32 * MiB;
constexpr size_t WS_QKV = WS_R1;
constexpr size_t WS_ATT = WS_R1 + 96 * MiB;
constexpr size_t WS_ACT = WS_R1 + 128 * MiB;
constexpr size_t WS_AB = WS_R1;
constexpr size_t WS_R2 = WS_R1 + 256 * MiB;
constexpr size_t WS_Y = WS_R2;
constexpr size_t WS_REC = WS_R2 + 32 * MiB;
constexpr size_t WS_U = WS_R2 + 96 * MiB;
constexpr size_t WS_Z = WS_R2 + 160 * MiB;
constexpr size_t WS_R3 = WS_R2 + 192 * MiB;
constexpr size_t WS_HF = WS_R3;
constexpr size_t WS_HBW = WS_R3 + 64 * MiB;
constexpr size_t WS_MISC = WS_R3 + 128 * MiB;
constexpr size_t WS_ROPE = WS_MISC;
constexpr size_t WS_COMB = WS_MISC + 1 * MiB;
constexpr size_t WS_C8SP = WS_COMB + 768 * 1024;
constexpr size_t WS_LIST = WS_COMB + 256 * 1024;
constexpr size_t WS_GATEW = WS_COMB + 512 * 1024;
constexpr size_t WS_MACT = WS_R1;
constexpr size_t WS_PARTK = WS_R1 + 128 * MiB;
constexpr size_t WS_INV = WS_COMB + 576 * 1024;
constexpr size_t WS_CONTRIB = WS_R2;
constexpr size_t WS_END = WS_MISC + 2 * MiB;

__device__ __forceinline__ bf16_t f2bf(float f) { unsigned u = __float_as_uint(f); u += 0x7FFFu + ((u >> 16) & 1u); return (bf16_t)(u >> 16); }
__device__ __forceinline__ float bf2f(bf16_t b) { return __uint_as_float(((unsigned)b) << 16); }
__device__ __forceinline__ float wave_sum(float v) {
#pragma unroll
    for (int o = 1; o < 64; o <<= 1) v += __shfl_xor(v, o);
    return v;
}
__device__ __forceinline__ float wave_max(float v) {
#pragma unroll
    for (int o = 1; o < 64; o <<= 1) v = fmaxf(v, __shfl_xor(v, o));
    return v;
}
__device__ __forceinline__ float sigmoidf_(float x) { return 1.f / (1.f + expf(-x)); }
__device__ __forceinline__ float siluf_(float x) { return x / (1.f + expf(-x)); }
__device__ __forceinline__ float gelu_tanh(float x) { const float u = 0.7978845608028654f * (x + 0.044715f * x * x * x); return 0.5f * x * (1.f + tanhf(u)); }

#define LAS __attribute__((address_space(3)))
#define GAS __attribute__((address_space(1)))
typedef unsigned u32x4 __attribute__((ext_vector_type(4)));
typedef unsigned u32x2 __attribute__((ext_vector_type(2)));
typedef float f32x2 __attribute__((ext_vector_type(2)));
constexpr int NWAVES = 8, NTHR = 512;
constexpr int BM = 256, BK = 64, HALF = 128, HTB = HALF * BK * 2, STAGE_BYTES = 8 * HTB, NXCD = 8, WGM = 8;
constexpr int MISC_OFF = STAGE_BYTES, LDS_BYTES = STAGE_BYTES + 16384;
constexpr size_t WT_IN0 = 0;
constexpr size_t WT_OUT0 = WT_IN0 + (size_t)INC * D;
constexpr size_t WT_GU0 = WT_OUT0 + (size_t)D * D;
constexpr size_t WT_DN0 = WT_GU0 + (size_t)2 * FF * D;
constexpr size_t WT_IN1 = WT_DN0 + (size_t)FF * D;
constexpr size_t WT_OUT1 = WT_IN1 + (size_t)2 * D * D;
constexpr size_t WT_LRU = WT_OUT1 + (size_t)D * D;
constexpr size_t WT_MGU = WT_LRU + (size_t)2 * 2 * LB * LBD * LBD;
constexpr size_t WT_MDN = WT_MGU + (size_t)NE * 2 * FF * D;
constexpr size_t WT_END = WT_MDN + (size_t)NE * FF * D;
static_assert(WT_END * 2 <= 816 * MiB, "weights region");
constexpr size_t WS_CTL = WS_END;
constexpr size_t CTL_BYTES = 256 * 1024;
constexpr int CW_BAR = 0;
constexpr int CW_CNT = 4096;
constexpr int CW_XRANK = 8192;
constexpr int CW_AQ = 8192 + 1024;
#define CW_CVQ (8192 + 2048)
#ifndef NCV_PER_XCD
#define NCV_PER_XCD 16
#endif
constexpr size_t WS_XB = WS_CTL + CTL_BYTES;
constexpr size_t WS_PART = WS_XB + 32 * MiB;
constexpr size_t WS_SUMM = WS_PART + 1 * MiB;
constexpr size_t WS_CARRY = WS_SUMM + 8 * MiB;
constexpr size_t WS_END2 = WS_CARRY + 4 * MiB;

__device__ __forceinline__ int opaque_tid() { int t = threadIdx.x; asm volatile("" : "+v"(t)); return t; }
__device__ __forceinline__ float sat8(float x) { return __builtin_amdgcn_fmed3f(x, -448.f, 448.f); }
__device__ __forceinline__ unsigned pk4_fp8(float a, float b, float c, float d) { unsigned w = 0; w = __builtin_amdgcn_cvt_pk_fp8_f32(sat8(a), sat8(b), w, false); w = __builtin_amdgcn_cvt_pk_fp8_f32(sat8(c), sat8(d), w, true); return w; }
constexpr float W8_SCALE = 64.f, W8_INV = 1.f / 64.f;
#ifndef FFN_GU8
#define FFN_GU8 1
#endif
#ifndef FFN_DN8
#define FFN_DN8 0
#endif
constexpr bool FFNGU8 = FFN_GU8, FFNDN8 = FFN_DN8;
#define XB_TMO      128
#define XB_XCNT(j)  (256  + 64 * (j))
#define XB_XSUB(j)  (1280 + 64 * (j))
#define XB_XGEN(j)  (2304 + 64 * (j))
#define XB_TOP      3328
#define XB_TOPGEN   3392
#define XCD_BAR_WORDS 3456
#define XB_SPIN_CAP (1u << 18)
__device__ __forceinline__ unsigned xb_ld(unsigned* p)              { return __hip_atomic_load(p, __ATOMIC_RELAXED, __HIP_MEMORY_SCOPE_AGENT); }
__device__ __forceinline__ unsigned xb_add(unsigned* p, unsigned v) { return __hip_atomic_fetch_add(p, v, __ATOMIC_RELAXED, __HIP_MEMORY_SCOPE_AGENT); }
__device__ __forceinline__ unsigned xb_xcc_id() { return (unsigned)__builtin_amdgcn_s_getreg((3 << 11) | 20) & 0xFu; }
#define XB_SPIN(cond, bar) do { unsigned _sp = 0; while (cond) { __builtin_amdgcn_s_sleep(1); \
    if ((++_sp & 255u) == 0u) { if (xb_ld(&(bar)[XB_TMO])) break; if (_sp > XB_SPIN_CAP) { atomicAdd(&(bar)[XB_TMO], 1u); break; } } } } while (0)
struct XcdBarrier { unsigned* bar; unsigned x; volatile LAS unsigned* st; };
__device__ __forceinline__ XcdBarrier xcd_barrier_post(unsigned* bar, volatile LAS unsigned* st) {
    XcdBarrier b; b.bar = bar; b.x = xb_xcc_id(); b.st = st;
    if (threadIdx.x == 0) (void)xb_add(&bar[XB_XCNT(b.x)], 1u);
    return b;
}
__device__ __forceinline__ void xcd_barrier_complete(unsigned* bar, unsigned x, unsigned& nloc, unsigned& nx) {
    const unsigned G = gridDim.x * gridDim.y * gridDim.z;
    unsigned sum, cnt, mine, sp = 0u;
    for (;;) {
        sum = 0u; cnt = 0u; mine = 0u;
#pragma unroll
        for (unsigned j = 0; j < 16; ++j) { const unsigned c = xb_ld(&bar[XB_XCNT(j)]); sum += c; cnt += (c > 0u) ? 1u : 0u; mine = (j == x) ? c : mine; }
        if (sum == G) break;
        __builtin_amdgcn_s_sleep(1);
        if ((++sp & 255u) == 0u) { if (xb_ld(&bar[XB_TMO])) break; if (sp > XB_SPIN_CAP) { atomicAdd(&bar[XB_TMO], 1u); break; } }
    }
    nloc = mine > 0u ? mine : 1u; nx = cnt > 0u ? cnt : 1u;
}
__device__ __forceinline__ void xcd_barrier(const XcdBarrier& b) {
    asm volatile("s_waitcnt vmcnt(0)" ::: "memory");
    __syncthreads();
    if (threadIdx.x == 0) {
        unsigned* bar = b.bar;
        __builtin_amdgcn_s_waitcnt(0);
        unsigned nloc = b.st[0], nx = b.st[1];
        if (nloc == 0u) { xcd_barrier_complete(bar, b.x, nloc, nx); b.st[0] = nloc; b.st[1] = nx; }
        const unsigned old = xb_add(&bar[XB_XSUB(b.x)], 1u);
        const unsigned gen = old / nloc;
        if (old + 1u == (gen + 1u) * nloc) {
            __builtin_amdgcn_fence(__ATOMIC_RELEASE, "agent");
            asm volatile("s_waitcnt vmcnt(0)" ::: "memory");
            const unsigned og = xb_add(&bar[XB_TOP], 1u);
            const unsigned tg = og / nx;
            if (og + 1u == (tg + 1u) * nx) xb_add(&bar[XB_TOPGEN], 1u);
            else XB_SPIN(xb_ld(&bar[XB_TOPGEN]) == tg, bar);
            __builtin_amdgcn_fence(__ATOMIC_ACQUIRE, "agent");
            xb_add(&bar[XB_XGEN(b.x)], 1u);
            asm volatile("s_waitcnt vmcnt(0)" ::: "memory");
        } else {
            XB_SPIN(xb_ld(&bar[XB_XGEN(b.x)]) == gen, bar);
            __builtin_amdgcn_fence(__ATOMIC_ACQUIRE, "agent");
            asm volatile("s_waitcnt vmcnt(0)" ::: "memory");
        }
    }
    __syncthreads();
}

__host__ __device__ __forceinline__ int lds_byte(int r, int c) { const int st = (r >> 4) * 2 + (c >> 5), rr = r & 15, cc = c & 31, ob = rr * 64 + cc * 2; return st * 1024 + (ob ^ (((ob >> 9) & 1) << 5)); }
__host__ __device__ __forceinline__ void stage_rc(int b, int& R, int& C) { const int st = b / 1024, sb = b % 1024, swz = sb ^ (((sb >> 9) & 1) << 5); R = (st >> 1) * 16 + swz / 64; C = (st & 1) * 32 + (swz % 64) / 2; }
__host__ __device__ __forceinline__ int perm32(int rho) { const int n = rho >> 4, i = rho & 15; return 8 * (i >> 2) + 4 * n + (i & 3); }
__device__ __forceinline__ unsigned cvt_pk_bf16(float lo, float hi) { unsigned r; asm volatile("v_cvt_pk_bf16_f32 %0, %1, %2" : "=v"(r) : "v"(lo), "v"(hi)); return r; }

struct Unit { int pm, pn, e, r0, cnt, k0, nkt, kq, ridx; };
struct Gemm { const bf16_t* A; const bf16_t* Bt; int N, K; size_t bstride; };

struct StaticOrder {
    int nM, nN, nwg, G, c;
    __device__ void init(int M, int N, int G_, int c_) { nM = M / BM; nN = N / BM; nwg = nM * nN; G = G_; c = c_; }
    __device__ bool next(int i, Unit& u) const {
        const long L = (long)i * G + c; if (L >= nwg) return false;
        int wgid = (int)L; { const int q = nwg / NXCD, r = nwg % NXCD, xcd = wgid % NXCD, off = wgid / NXCD; wgid = (xcd < r ? xcd * (q + 1) : r * (q + 1) + (xcd - r) * q) + off; }
        const int nig = WGM * nN, gid = wgid / nig, fm = gid * WGM, gsz = (nM - fm) < WGM ? (nM - fm) : WGM;
        u.pm = fm + ((wgid % nig) % gsz); u.pn = (wgid % nig) / gsz; u.e = 0; u.r0 = 0; u.cnt = 0; u.k0 = 0; u.nkt = 0; u.kq = -1; u.ridx = 0; return true;
    }
    __device__ __forceinline__ int arow(const Unit& u, int lr) const { return u.pm * BM + lr; }
};

typedef int i32x8 __attribute__((ext_vector_type(8)));
typedef int i32x4 __attribute__((ext_vector_type(4)));
template <class Epi, class Sched, int BL, bool GATHER, bool F8 = false>
__device__ __forceinline__ void gemm_phase(LAS unsigned char* lds, const Gemm g, const Sched& S, const Epi& E) {
    const int tid = opaque_tid(), wid = __builtin_amdgcn_readfirstlane(tid >> 6), lane = tid & 63, wr = wid >> 2, wc = wid & 3, fr = lane & 15, fq = lane >> 4;
    constexpr int ESZ = F8 ? 1 : 2;
    const int K = g.K, KB = K * ESZ, nt = KB / 128;
    unsigned voffA[2], voffB[2], CA[2]; int RA[2];
#pragma unroll
    for (int i = 0; i < 2; ++i) { int R, C; stage_rc(tid * 16 + i * 8192, R, C); RA[i] = R; CA[i] = (unsigned)C * 2u;
        int Rb = R; if (BL >= 1) Rb = (R & ~31) + perm32(R & 31); if (BL == 2) Rb = 64 * (Rb >> 5) + (Rb & 31);
        voffA[i] = (unsigned)(R * KB) + (unsigned)C * 2u; voffB[i] = (unsigned)(Rb * 128) + (unsigned)C * 2u; }
    const size_t kstep = 128, kstepB = 256 * 128;
    const size_t hstep = (size_t)HALF * KB;
    const size_t hstepB = (BL == 2) ? (size_t)32 * 128 : (size_t)HALF * 128;
    const size_t tstep = 2 * hstep;
    const unsigned ldsw = (unsigned)wid * 1024u;
    const int aoff = F8 ? lds_byte(wr * 64 + fr, fq * 16) : lds_byte(wr * 64 + fr, fq * 8), boff = F8 ? lds_byte(wc * 32 + fr, fq * 16) : lds_byte(wc * 32 + fr, fq * 8);
#define PG8_SA(b, h) (((b) * 2 + (h)) * HTB)
#define PG8_SB(b, h) ((4 + (b) * 2 + (h)) * HTB)
#define PG8_STAGE(bufoff, gbase, voff) do { _Pragma("unroll") for (int _i = 0; _i < 2; ++_i) \
        __builtin_amdgcn_global_load_lds((const unsigned*)((const char*)(gbase) + (voff)[_i]), (LAS unsigned*)(lds + (bufoff) + ldsw + _i * 8192), 16, 0, 0); } while (0)
#define PG8_LDA(b, h) do { if constexpr (F8) { _Pragma("unroll") for (int m = 0; m < 4; ++m) { const i32x4 lo_ = *(const LAS i32x4*)(lds + PG8_SA(b, h) + aoff + m * 2048), hi_ = *(const LAS i32x4*)(lds + PG8_SA(b, h) + aoff + m * 2048 + 16); \
            At8[m] = (i32x8){lo_[0], lo_[1], lo_[2], lo_[3], hi_[0], hi_[1], hi_[2], hi_[3]}; } } \
        else { _Pragma("unroll") for (int m = 0; m < 4; ++m) _Pragma("unroll") for (int k = 0; k < 2; ++k) At[m][k] = *(const LAS bf16x8*)(lds + PG8_SA(b, h) + aoff + m * 2048 + k * 1024); } } while (0)
#define PG8_LDB(w, b, h) do { if constexpr (F8) { _Pragma("unroll") for (int n = 0; n < 2; ++n) { const i32x4 lo_ = *(const LAS i32x4*)(lds + PG8_SB(b, h) + boff + n * 2048), hi_ = *(const LAS i32x4*)(lds + PG8_SB(b, h) + boff + n * 2048 + 16); \
            Bq8[w][n] = (i32x8){lo_[0], lo_[1], lo_[2], lo_[3], hi_[0], hi_[1], hi_[2], hi_[3]}; } } \
        else { _Pragma("unroll") for (int n = 0; n < 2; ++n) _Pragma("unroll") for (int k = 0; k < 2; ++k) Bq[w][n][k] = *(const LAS bf16x8*)(lds + PG8_SB(b, h) + boff + n * 2048 + k * 1024); } } while (0)
#define PG8_MMA(ai, bj) do { __builtin_amdgcn_s_setprio(1); if constexpr (F8) { _Pragma("unroll") for (int m = 0; m < 4; ++m) _Pragma("unroll") for (int n = 0; n < 2; ++n) \
            asm volatile("v_mfma_scale_f32_16x16x128_f8f6f4 %0, %1, %2, %0, %3, %3 op_sel_hi:[0,0,0]" : "+v"(acc[ai][bj][m][n]) : "v"(Bq8[bj][n]), "v"(At8[m]), "v"(sc8)); } \
        else { _Pragma("unroll") for (int m = 0; m < 4; ++m) _Pragma("unroll") for (int n = 0; n < 2; ++n) _Pragma("unroll") for (int k = 0; k < 2; ++k) \
            acc[ai][bj][m][n] = __builtin_amdgcn_mfma_f32_16x16x32_bf16(Bq[bj][n][k], At[m][k], acc[ai][bj][m][n], 0, 0, 0); } __builtin_amdgcn_s_setprio(0); } while (0)
#define PG8_WAIT_V(n) asm volatile("s_waitcnt vmcnt(" #n ")" ::: "memory")
#define PG8_WAIT_L(n) asm volatile("s_waitcnt lgkmcnt(" #n ")" ::: "memory")
#define PG8_BAR __builtin_amdgcn_s_barrier()
#define PG8_SCHED __builtin_amdgcn_sched_barrier(0)
    Unit cur, nxt; int ui = 0;
    if (!S.next(0, cur)) return;
    f32x4 acc[2][2][4][2];
#pragma unroll
    for (int a = 0; a < 2; ++a)
#pragma unroll
        for (int b = 0; b < 2; ++b)
#pragma unroll
            for (int m = 0; m < 4; ++m)
#pragma unroll
                for (int n = 0; n < 2; ++n) acc[a][b][m][n] = (f32x4){0.f, 0.f, 0.f, 0.f};
    bf16x8 At[4][2], Bq[2][2][2]; i32x8 At8[4], Bq8[2][2]; const int sc8 = 0x7f7f7f7f;
    unsigned oA0[2], oA1[2], nA0[2], nA1[2];
    const char* cA; const char* cB = (const char*)g.Bt + ((size_t)cur.e * g.bstride + (size_t)cur.pn * BM * K) * ESZ + (size_t)cur.k0 * kstepB;
    if constexpr (GATHER) { cA = (const char*)g.A + (size_t)cur.k0 * 128;
#pragma unroll
        for (int i = 0; i < 2; ++i) { oA0[i] = (unsigned)S.arow(cur, RA[i]) * (unsigned)KB + CA[i]; oA1[i] = (unsigned)S.arow(cur, HALF + RA[i]) * (unsigned)KB + CA[i]; }
    } else { cA = (const char*)g.A + (size_t)cur.pm * tstep + (size_t)cur.k0 * 128;
#pragma unroll
        for (int i = 0; i < 2; ++i) { oA0[i] = voffA[i]; oA1[i] = voffA[i] + (unsigned)hstep; } }
#pragma unroll
    for (int i = 0; i < 2; ++i) { nA0[i] = oA0[i]; nA1[i] = oA1[i]; }
    PG8_STAGE(PG8_SB(0, 0), cB, voffB); PG8_STAGE(PG8_SB(0, 1), cB + hstepB, voffB); PG8_STAGE(PG8_SA(0, 0), cA, oA0); PG8_STAGE(PG8_SA(0, 1), cA, oA1);
    if (wr == 1) PG8_BAR;
    PG8_WAIT_V(2); PG8_BAR;
    PG8_STAGE(PG8_SB(1, 0), cB + kstepB, voffB); PG8_STAGE(PG8_SA(1, 0), cA + kstep, oA0); PG8_STAGE(PG8_SB(1, 1), cB + hstepB + kstepB, voffB);
    PG8_WAIT_V(6); PG8_BAR;
    for (;;) {
        const bool has_next = S.next(ui + 1, nxt);
        const char* nA; const char* nB = has_next ? (const char*)g.Bt + ((size_t)nxt.e * g.bstride + (size_t)nxt.pn * BM * K) * ESZ + (size_t)nxt.k0 * kstepB : cB;
        const int ntu = cur.nkt ? cur.nkt : nt;
        if constexpr (GATHER) { nA = has_next ? (const char*)g.A + (size_t)nxt.k0 * 128 : cA;
            if (has_next) {
#pragma unroll
                for (int i = 0; i < 2; ++i) { nA0[i] = (unsigned)S.arow(nxt, RA[i]) * (unsigned)KB + CA[i]; nA1[i] = (unsigned)S.arow(nxt, HALF + RA[i]) * (unsigned)KB + CA[i]; } }
        } else { nA = has_next ? (const char*)g.A + (size_t)nxt.pm * tstep + (size_t)nxt.k0 * 128 : cA; }
        for (int t = 0; t < ntu; t += 2) {
            const bool last = (t == ntu - 2);
            const char* a1 = cA + (size_t)(t + 1) * kstep;
            const char* a2 = last ? nA : cA + (size_t)(t + 2) * kstep; const char* b2 = last ? nB : cB + (size_t)(t + 2) * kstepB;
            const char* a3 = a2 + kstep; const char* b3 = b2 + kstepB;
            unsigned xA0[2], xA1[2];
#pragma unroll
            for (int i = 0; i < 2; ++i) { xA0[i] = (GATHER && last) ? nA0[i] : oA0[i]; xA1[i] = (GATHER && last) ? nA1[i] : oA1[i]; }
            PG8_LDB(0, 0, 0); PG8_LDB(1, 0, 1); PG8_SCHED; PG8_LDA(0, 0); PG8_STAGE(PG8_SA(1, 1), a1, oA1);
            PG8_WAIT_V(8); PG8_WAIT_L(0); PG8_BAR; PG8_MMA(0, 0); PG8_MMA(0, 1); PG8_BAR; PG8_SCHED;
            PG8_LDA(0, 1); PG8_STAGE(PG8_SB(0, 0), b2, voffB); PG8_STAGE(PG8_SB(0, 1), b2 + hstepB, voffB); PG8_STAGE(PG8_SA(0, 0), a2, xA0);
            PG8_WAIT_V(8); PG8_WAIT_L(0); PG8_BAR; PG8_MMA(1, 0); PG8_MMA(1, 1); PG8_BAR; PG8_SCHED;
            PG8_LDB(0, 1, 0); PG8_LDB(1, 1, 1); PG8_SCHED; PG8_LDA(1, 0); PG8_STAGE(PG8_SA(0, 1), a2, xA1);
            PG8_WAIT_V(8); PG8_WAIT_L(0); PG8_BAR; PG8_MMA(0, 0); PG8_MMA(0, 1); PG8_BAR; PG8_SCHED;
            PG8_LDA(1, 1); PG8_STAGE(PG8_SB(1, 0), b3, voffB); PG8_STAGE(PG8_SB(1, 1), b3 + hstepB, voffB); PG8_STAGE(PG8_SA(1, 0), a3, xA0);
            PG8_WAIT_V(8); PG8_WAIT_L(0); PG8_BAR; PG8_MMA(1, 0); PG8_MMA(1, 1); PG8_BAR; PG8_SCHED;
        }
        if (wr == 0) PG8_BAR;
        if constexpr (F8) asm volatile("s_nop 15\n\ts_nop 15" ::: "memory");
        { int efr = fr, efq = fq; asm volatile("" : "+v"(efr), "+v"(efq)); E(acc, cur, wr, wc, efr, efq); }
        if (!has_next) break;
#pragma unroll
        for (int a = 0; a < 2; ++a)
#pragma unroll
            for (int b = 0; b < 2; ++b)
#pragma unroll
                for (int m = 0; m < 4; ++m)
#pragma unroll
                    for (int n = 0; n < 2; ++n) acc[a][b][m][n] = (f32x4){0.f, 0.f, 0.f, 0.f};
        cur = nxt; cA = nA; cB = nB; ++ui;
#pragma unroll
        for (int i = 0; i < 2; ++i) { oA0[i] = nA0[i]; oA1[i] = nA1[i]; }
        if (wr == 1) PG8_BAR;
    }
    PG8_WAIT_V(0);
    PG8_BAR;
#undef PG8_SA
#undef PG8_SB
#undef PG8_STAGE
#undef PG8_LDA
#undef PG8_LDB
#undef PG8_MMA
#undef PG8_WAIT_V
#undef PG8_WAIT_L
#undef PG8_BAR
#undef PG8_SCHED
}

__device__ __forceinline__ float row_rstd(const float* part, int row) { const f32x4 a = *(const f32x4*)(part + (size_t)row * 8), b = *(const f32x4*)(part + (size_t)row * 8 + 4);
    return rsqrtf((((a[0] + a[1]) + (a[2] + a[3])) + ((b[0] + b[1]) + (b[2] + b[3]))) * (1.0f / D) + EPS); }
struct EpiResid {
    const float* Xin; float* Xout; bf16_t* XB; float* part; LAS float* P; unsigned char* X8; float sc;
    __device__ __forceinline__ void operator()(const f32x4 (&acc)[2][2][4][2], const Unit& u, int wr, int wc, int fr, int fq) const {
        const int row0 = u.pm * BM + wr * 64 + fr, col0 = u.pn * BM + wc * 32 + 4 * fq;
#pragma unroll
        for (int ai = 0; ai < 2; ++ai)
#pragma unroll
            for (int m = 0; m < 4; ++m) { const int row = row0 + ai * HALF + m * 16; const size_t ro = (size_t)row * D + col0; float ss = 0.f;
#pragma unroll
                for (int bj = 0; bj < 2; ++bj)
#pragma unroll
                    for (int n = 0; n < 2; ++n) { const f32x4 v = *(const f32x4*)(Xin + ro + bj * HALF + n * 16) + acc[ai][bj][m][n] * sc;
                        *(f32x4*)(Xout + ro + bj * HALF + n * 16) = v; ss += (v[0] * v[0] + v[1] * v[1]) + (v[2] * v[2] + v[3] * v[3]);
                        u32x2 w; w.x = cvt_pk_bf16(v[0], v[1]); w.y = cvt_pk_bf16(v[2], v[3]); *(u32x2*)(XB + ro + bj * HALF + n * 16) = w;
                        if (X8) *(unsigned*)(X8 + ro + bj * HALF + n * 16) = pk4_fp8(v[0], v[1], v[2], v[3]); }
                ss += __shfl_xor(ss, 16); ss += __shfl_xor(ss, 32);
                if (fq == 0) P[(wr * 64 + fr + ai * HALF + m * 16) * 4 + wc] = ss; }
        asm volatile("s_waitcnt lgkmcnt(0)" ::: "memory"); __builtin_amdgcn_s_barrier(); asm volatile("" ::: "memory");
        const int t = threadIdx.x;
        if (t < BM) { const f32x4 p = *(const LAS f32x4*)(P + t * 4); part[(size_t)(u.pm * BM + t) * 8 + u.pn] = (p[0] + p[1]) + (p[2] + p[3]); }
    }
};

__device__ __forceinline__ float fast_silu(float g) { return g * __builtin_amdgcn_rcpf(1.f + __expf(-g)); }
__device__ __forceinline__ float fast_gelu_tanh(float x) { const float u = 1.5957691216057308f * (x + 0.044715f * x * x * x); return x * (1.f - __builtin_amdgcn_rcpf(1.f + __expf(u))); }
struct EpiQkv {
    bf16_t* O; const float* part; const float* rc; const float* rs;
    __device__ __forceinline__ void operator()(const f32x4 (&acc)[2][2][4][2], const Unit& u, int wr, int wc, int fr, int fq) const {
        const int row0 = u.pm * BM + wr * 64 + fr, col0 = u.pn * BM + wc * 64 + 8 * fq; const bool rope = (u.pn >= 12 && u.pn < 20);
#pragma unroll
        for (int ai = 0; ai < 2; ++ai)
#pragma unroll
            for (int m = 0; m < 4; ++m) { const int row = row0 + ai * HALF + m * 16; const float rstd = row_rstd(part, row);
                f32x4 x1a = acc[ai][0][m][0] * rstd, x1b = acc[ai][0][m][1] * rstd, x2a = acc[ai][1][m][0] * rstd, x2b = acc[ai][1][m][1] * rstd;
                if (rope) { const int s = row & (S - 1); const f32x4 ca = *(const f32x4*)(rc + s * 32 + 8 * fq), cb = *(const f32x4*)(rc + s * 32 + 8 * fq + 4), sa = *(const f32x4*)(rs + s * 32 + 8 * fq), sb = *(const f32x4*)(rs + s * 32 + 8 * fq + 4);
                    const f32x4 o1a = x1a * ca - x2a * sa, o1b = x1b * cb - x2b * sb, o2a = x2a * ca + x1a * sa, o2b = x2b * cb + x1b * sb; x1a = o1a; x1b = o1b; x2a = o2a; x2b = o2b; }
                bf16_t* rowp = O + (size_t)row * INC + col0;
                u32x4 w1, w2; w1.x = cvt_pk_bf16(x1a[0], x1a[1]); w1.y = cvt_pk_bf16(x1a[2], x1a[3]); w1.z = cvt_pk_bf16(x1b[0], x1b[1]); w1.w = cvt_pk_bf16(x1b[2], x1b[3]);
                w2.x = cvt_pk_bf16(x2a[0], x2a[1]); w2.y = cvt_pk_bf16(x2a[2], x2a[3]); w2.z = cvt_pk_bf16(x2b[0], x2b[1]); w2.w = cvt_pk_bf16(x2b[2], x2b[3]);
                *(u32x4*)rowp = w1; *(u32x4*)(rowp + 32) = w2; }
    }
};
template <bool MOE, bool F8O = MOE, bool F8I = F8O> struct EpiGateUp {
    bf16_t* O; const float* part; const int* list;
    __device__ __forceinline__ void operator()(const f32x4 (&acc)[2][2][4][2], const Unit& u, int wr, int wc, int fr, int fq) const {
        const int lr0 = wr * 64 + fr, col0 = u.pn * HALF + wc * 32 + 8 * fq;
#pragma unroll
        for (int ai = 0; ai < 2; ++ai)
#pragma unroll
            for (int m = 0; m < 4; ++m) { const int lr = lr0 + ai * HALF + m * 16; int srow = u.pm * BM + lr; const int orow = u.pm * BM + lr;
                const float rstd = MOE ? W8_INV : row_rstd(part, srow) * (F8I ? W8_INV : 1.f);
                const f32x4 g0 = acc[ai][0][m][0] * rstd, g1 = acc[ai][0][m][1] * rstd, u0 = acc[ai][1][m][0] * rstd, u1 = acc[ai][1][m][1] * rstd;
                if constexpr (F8O) { u32x2 w8; w8.x = pk4_fp8(fast_silu(g0[0]) * u0[0], fast_silu(g0[1]) * u0[1], fast_silu(g0[2]) * u0[2], fast_silu(g0[3]) * u0[3]);
                    w8.y = pk4_fp8(fast_silu(g1[0]) * u1[0], fast_silu(g1[1]) * u1[1], fast_silu(g1[2]) * u1[2], fast_silu(g1[3]) * u1[3]);
                    *(u32x2*)((unsigned char*)O + (size_t)orow * FF + col0) = w8; continue; }
                u32x4 w; w.x = cvt_pk_bf16(fast_silu(g0[0]) * u0[0], fast_silu(g0[1]) * u0[1]); w.y = cvt_pk_bf16(fast_silu(g0[2]) * u0[2], fast_silu(g0[3]) * u0[3]);
                w.z = cvt_pk_bf16(fast_silu(g1[0]) * u1[0], fast_silu(g1[1]) * u1[1]); w.w = cvt_pk_bf16(fast_silu(g1[2]) * u1[2], fast_silu(g1[3]) * u1[3]);
                *(u32x4*)(O + (size_t)orow * FF + col0) = w; }
    }
};
struct EpiL1In {
    bf16_t* Y; bf16_t* R; const float* part;
    __device__ __forceinline__ void operator()(const f32x4 (&acc)[2][2][4][2], const Unit& u, int wr, int wc, int fr, int fq) const {
        const int row0 = u.pm * BM + wr * 64 + fr, col0 = u.pn * BM + wc * 32 + 8 * fq;
#pragma unroll
        for (int ai = 0; ai < 2; ++ai)
#pragma unroll
            for (int m = 0; m < 4; ++m) { const int row = row0 + ai * HALF + m * 16; const float rstd = row_rstd(part, row);
#pragma unroll
                for (int bj = 0; bj < 2; ++bj) { const f32x4 v0 = acc[ai][bj][m][0] * rstd, v1 = acc[ai][bj][m][1] * rstd; const int col = col0 + bj * HALF;
                    if (u.pn < 8) { u32x4 w; w.x = cvt_pk_bf16(fast_gelu_tanh(v0[0]), fast_gelu_tanh(v0[1])); w.y = cvt_pk_bf16(fast_gelu_tanh(v0[2]), fast_gelu_tanh(v0[3]));
                        w.z = cvt_pk_bf16(fast_gelu_tanh(v1[0]), fast_gelu_tanh(v1[1])); w.w = cvt_pk_bf16(fast_gelu_tanh(v1[2]), fast_gelu_tanh(v1[3])); *(u32x4*)(Y + (size_t)row * D + col) = w; }
                    else { u32x4 w; w.x = cvt_pk_bf16(v0[0], v0[1]); w.y = cvt_pk_bf16(v0[2], v0[3]); w.z = cvt_pk_bf16(v1[0], v1[1]); w.w = cvt_pk_bf16(v1[2], v1[3]); *(u32x4*)(R + ((size_t)(row >> 8) * LB + (u.pn - 8) * 2 + bj) * (256 * LBD) + (size_t)(row & 255) * LBD + wc * 32 + 8 * fq) = w; } } }
    }
};

struct MoeOrder {
    const volatile LAS int* tab; const int* list; int NP, nwg, G, c, KT4;
    __device__ __forceinline__ int tb(int i) const { return __builtin_amdgcn_readfirstlane(tab[i]); }
    __device__ void init(const volatile LAS int* tab_, const int* list_, int NP_, int G_, int c_) { tab = tab_; list = list_; NP = NP_; G = G_; c = c_; nwg = __builtin_amdgcn_readfirstlane(tab_[16]) * NP_; ksplit = 0; KT4 = 0; }
    int ksplit;
    __device__ bool next(int i, Unit& u) const {
        long L = (long)i * G + c; u.k0 = 0; u.nkt = 0; u.kq = -1; u.ridx = 0;
        if (ksplit && i >= 2) { if (i > 2 || c >= 4 * (nwg - 2 * G)) return false; L = 2 * G + (c >> 2); u.kq = c & 3; u.ridx = c >> 2; u.nkt = KT4; u.k0 = u.kq * KT4; }
        if (L >= nwg) return false;
        int wgid = (int)L; { const int q = nwg / NXCD, r = nwg % NXCD, xcd = wgid % NXCD, off = wgid / NXCD; wgid = (xcd < r ? xcd * (q + 1) : r * (q + 1) + (xcd - r) * q) + off; }
        int e = 0;
#pragma unroll
        for (int k = 1; k < NE; ++k) e += (wgid >= tb(8 + k) * NP) ? 1 : 0;
        const int p0 = tb(8 + e), npan = tb(9 + e) - p0, w = wgid - p0 * NP;
        const int pl = w % npan; u.pn = w / npan; u.pm = p0 + pl; u.e = e; u.r0 = pl * BM; u.cnt = tb(e); return true;
    }
    __device__ __forceinline__ int arow(const Unit& u, int lr) const { const int li = u.r0 + lr; return (li < u.cnt) ? (list[u.e * T + li] >> 1) : 0; }
};
struct EpiMoeDown {
    bf16_t* C; const int* list; const float* gatew; float* partk;
    __device__ __forceinline__ void operator()(const f32x4 (&acc)[2][2][4][2], const Unit& u, int wr, int wc, int fr, int fq) const {
        const int lr0 = wr * 64 + fr, col0 = u.pn * BM + wc * 32 + 4 * fq;
        if (u.kq >= 0) {
            float* pt = partk + ((size_t)(u.ridx * 4 + u.kq) << 16) + wc * 32 + 4 * fq;
#pragma unroll
            for (int ai = 0; ai < 2; ++ai)
#pragma unroll
                for (int m = 0; m < 4; ++m) { float* rp = pt + (lr0 + ai * HALF + m * 16) * BM;
#pragma unroll
                    for (int bj = 0; bj < 2; ++bj)
#pragma unroll
                        for (int n = 0; n < 2; ++n) *(f32x4*)(rp + bj * HALF + n * 16) = acc[ai][bj][m][n]; }
            return;
        }
#pragma unroll
        for (int ai = 0; ai < 2; ++ai)
#pragma unroll
            for (int m = 0; m < 4; ++m) { const int li = u.r0 + lr0 + ai * HALF + m * 16;
                if (li < u.cnt) { const int ent = list[u.e * T + li]; const float w = gatew[ent] * W8_INV; bf16_t* rp = C + (size_t)ent * D + col0;
#pragma unroll
                    for (int bj = 0; bj < 2; ++bj)
#pragma unroll
                        for (int n = 0; n < 2; ++n) { const f32x4 v = acc[ai][bj][m][n] * w; u32x2 pk; pk.x = cvt_pk_bf16(v[0], v[1]); pk.y = cvt_pk_bf16(v[2], v[3]); *(u32x2*)(rp + bj * HALF + n * 16) = pk; } } }
    }
};

namespace att {
using f32x16 = __attribute__((ext_vector_type(16))) float;
using s16x4  = __attribute__((ext_vector_type(4))) short;
constexpr int SHM_V = 64 * 128 * 2, SHM_K = 64 * 128 * 2;
constexpr float LOG2E = 1.4426950408889634f;
constexpr float THR2 = 8.f * LOG2E;
#define KSWZ(row, colB) ((row) * 256 + ((colB) ^ (((row) & 7) << 4)))
#define SBAR() __builtin_amdgcn_sched_barrier(0)
__device__ __forceinline__ int crow(int r, int hi) { return (r & 3) + 8 * (r >> 2) + 4 * hi; }
__device__ __forceinline__ unsigned cvtpk(float lo, float hi) { unsigned r; asm volatile("v_cvt_pk_bf16_f32 %0, %1, %2" : "=v"(r) : "v"(lo), "v"(hi)); return r; }
__device__ __forceinline__ int v_st(int k, int c) { const int kk = (k & ~0xC) | ((k & 4) << 1) | ((k & 8) >> 1); return ((kk >> 3) * 4 + (c >> 5)) * 512 + ((kk & 7) * 32 + (c & 31)) * 2; }
__device__ __forceinline__ int v_rd_base(int lane) { return ((lane & 3) << 3) | (((lane >> 2) & 3) << 6) | (((lane >> 4) & 1) << 5) | (((lane >> 5) & 1) << 8); }
constexpr int v_rd_off(int d0, int ks, int half) { return d0 * 512 + ks * 4096 + half * 2048; }
template <int OFF> __device__ __forceinline__ s16x4 tr_read(int vb) { s16x4 r; asm volatile("ds_read_b64_tr_b16 %0, %1 offset:%2" : "=&v"(r) : "v"(vb), "i"(OFF) : "memory"); return r; }
template <int D0> __device__ __forceinline__ void pv_one(f32x16& od, int vb, bf16x8 pa0, bf16x8 pa1, bf16x8 pa2, bf16x8 pa3) {
    const s16x4 l0 = tr_read<v_rd_off(D0, 0, 0)>(vb), h0 = tr_read<v_rd_off(D0, 0, 1)>(vb), l1 = tr_read<v_rd_off(D0, 1, 0)>(vb), h1 = tr_read<v_rd_off(D0, 1, 1)>(vb);
    const s16x4 l2 = tr_read<v_rd_off(D0, 2, 0)>(vb), h2 = tr_read<v_rd_off(D0, 2, 1)>(vb), l3 = tr_read<v_rd_off(D0, 3, 0)>(vb), h3 = tr_read<v_rd_off(D0, 3, 1)>(vb);
    asm volatile("s_waitcnt lgkmcnt(0)" ::: "memory"); SBAR();
#define PK(L, H) (bf16x8){L[0], L[1], L[2], L[3], H[0], H[1], H[2], H[3]}
    od = __builtin_amdgcn_mfma_f32_32x32x16_bf16(pa0, PK(l0, h0), od, 0, 0, 0);
    od = __builtin_amdgcn_mfma_f32_32x32x16_bf16(pa1, PK(l1, h1), od, 0, 0, 0);
    od = __builtin_amdgcn_mfma_f32_32x32x16_bf16(pa2, PK(l2, h2), od, 0, 0, 0);
    od = __builtin_amdgcn_mfma_f32_32x32x16_bf16(pa3, PK(l3, h3), od, 0, 0, 0);
#undef PK
}
__device__ __forceinline__ void pv_d0(f32x16* o, int vb, bf16x8 pa0, bf16x8 pa1, bf16x8 pa2, bf16x8 pa3) {
    pv_one<0>(o[0], vb, pa0, pa1, pa2, pa3); pv_one<1>(o[1], vb, pa0, pa1, pa2, pa3); pv_one<2>(o[2], vb, pa0, pa1, pa2, pa3); pv_one<3>(o[3], vb, pa0, pa1, pa2, pa3);
}
struct NaCtx { const LAS float* bias; int r, rs, qc, cs; };
template <int MODE> __device__ __forceinline__ void partialSM(f32x16& p0, f32x16& p1, float& m_reg, float& mn, float& alpha, const NaCtx& nc, int kr, int hi) {
    float pmax;
    if constexpr (MODE == 0) {
        constexpr float C = 0.125f * LOG2E;
        pmax = p0[0];
#pragma unroll
        for (int r = 1; r < 16; ++r) pmax = fmaxf(pmax, p0[r]);
#pragma unroll
        for (int r = 0; r < 16; ++r) pmax = fmaxf(pmax, p1[r]);
        pmax *= C;
    } else {
        constexpr float C = 0.08838834764831845f * LOG2E;
        const bool rowin = (unsigned)(kr - nc.rs) < 8u;
        const int base = (kr - nc.r + 7) * 31 + 15 - nc.qc;
#pragma unroll
        for (int r = 0; r < 16; ++r) { const int kc0 = crow(r, hi), kc1 = 32 + kc0;
            const bool v0 = rowin && ((unsigned)(kc0 - nc.cs) < 16u), v1 = rowin && ((unsigned)(kc1 - nc.cs) < 16u);
            const float b0 = nc.bias[v0 ? base + kc0 : 0], b1 = nc.bias[v1 ? base + kc1 : 0];
            p0[r] = v0 ? fmaf(p0[r], C, b0) : -1.0e30f; p1[r] = v1 ? fmaf(p1[r], C, b1) : -1.0e30f; }
        pmax = p0[0];
#pragma unroll
        for (int r = 1; r < 16; ++r) pmax = fmaxf(pmax, p0[r]);
#pragma unroll
        for (int r = 0; r < 16; ++r) pmax = fmaxf(pmax, p1[r]);
    }
    { auto rr = __builtin_amdgcn_permlane32_swap(__float_as_uint(pmax), __float_as_uint(pmax), false, false);
      pmax = fmaxf(__uint_as_float(rr[0]), __uint_as_float(rr[1])); }
    if (__builtin_expect(__all(pmax - m_reg <= THR2), 1)) { mn = m_reg; alpha = 1.f; }
    else { mn = fmaxf(m_reg, pmax); alpha = __builtin_amdgcn_exp2f(m_reg - mn); m_reg = mn; }
    if constexpr (MODE == 0) { constexpr float C = 0.125f * LOG2E; const float mnC = -mn;
#pragma unroll
        for (int r = 0; r < 16; ++r) p0[r] = fmaf(p0[r], C, mnC);
#pragma unroll
        for (int r = 0; r < 16; ++r) p1[r] = fmaf(p1[r], C, mnC);
    } else {
#pragma unroll
        for (int r = 0; r < 16; ++r) p0[r] = p0[r] - mn;
#pragma unroll
        for (int r = 0; r < 16; ++r) p1[r] = p1[r] - mn;
    }
#pragma unroll
    for (int r = 0; r < 16; ++r) p0[r] = __builtin_amdgcn_exp2f(p0[r]);
}
__device__ __forceinline__ void finishSM(f32x16& p0, f32x16& p1, float alpha, float& l_reg, bf16x8& pa0, bf16x8& pa1, bf16x8& pa2, bf16x8& pa3) {
#pragma unroll
    for (int r = 0; r < 16; ++r) p1[r] = __builtin_amdgcn_exp2f(p1[r]);
    float ps = 0;
#pragma unroll
    for (int r = 0; r < 16; ++r) ps += p0[r];
#pragma unroll
    for (int r = 0; r < 16; ++r) ps += p1[r];
    { auto rr = __builtin_amdgcn_permlane32_swap(__float_as_uint(ps), __float_as_uint(ps), false, false);
      ps = __uint_as_float(rr[0]) + __uint_as_float(rr[1]); }
    l_reg = l_reg * alpha + ps;
#define PK4(P, BASE, OUT) do { unsigned a0 = cvtpk(P[BASE + 0], P[BASE + 1]), a1 = cvtpk(P[BASE + 2], P[BASE + 3]);   \
    unsigned b0 = cvtpk(P[BASE + 4], P[BASE + 5]), b1 = cvtpk(P[BASE + 6], P[BASE + 7]);                              \
    auto r0 = __builtin_amdgcn_permlane32_swap(a0, b0, false, false); auto r1 = __builtin_amdgcn_permlane32_swap(a1, b1, false, false); \
    u32x4 w = {r0[0], r1[0], r0[1], r1[1]}; OUT = *reinterpret_cast<bf16x8*>(&w); } while (0)
    PK4(p0, 0, pa0); PK4(p0, 8, pa1); PK4(p1, 0, pa2); PK4(p1, 8, pa3);
#undef PK4
}
template <int NKS, bool QLDS> __device__ __forceinline__ void qkt(f32x16& p0, f32x16& p1, const LAS unsigned char* Ks, const bf16x8* qr, const LAS unsigned char* Qs, int kcb, int r32, int hi) {
    p0 = f32x16{}; p1 = f32x16{};
#pragma unroll
    for (int d0 = 0; d0 < NKS; ++d0) { const int cb = kcb + (d0 * 16 + hi * 8) * 2;
        const bf16x8 b0 = *(const LAS bf16x8*)(Ks + KSWZ(r32, cb));
        const bf16x8 b1 = *(const LAS bf16x8*)(Ks + KSWZ(32 + r32, cb));
        bf16x8 q; if constexpr (QLDS) q = *(const LAS bf16x8*)(Qs + KSWZ(r32, (d0 * 16 + hi * 8) * 2)); else q = qr[d0];
        p0 = __builtin_amdgcn_mfma_f32_32x32x16_bf16(b0, q, p0, 0, 0, 0);
        p1 = __builtin_amdgcn_mfma_f32_32x32x16_bf16(b1, q, p1, 0, 0, 0); }
}

template <int MODE>
__device__ __forceinline__ void attn_unit(const bf16_t* __restrict__ QKV, bf16_t* __restrict__ ATT, int b, int h, int blk, LAS unsigned char* lds, const float* __restrict__ subln, float lam, const float* __restrict__ rpb) {
    constexpr int NKS = (MODE == 0) ? 4 : 8;
    const int tid = opaque_tid(), wid = tid >> 6, lane = tid & 63, r32 = lane & 31, hi = lane >> 5;
    LAS unsigned char* V_lds = lds; LAS unsigned char* K_lds = lds + 2 * SHM_V;
    LAS float* wsr = (LAS float*)(lds + MISC_OFF + 1024) + wid * 64; LAS float* li_l = wsr; LAS float* al_l = wsr + 32;
    LAS float* biasL = (LAS float*)(lds + MISC_OFF + 8192);
    int qtok, qcol, kcol, vcol, tok0, NT, ocol; NaCtx nc; nc.bias = biasL; nc.r = 0; nc.rs = 0; nc.qc = 0; nc.cs = 0; int kr0 = 0;
    if constexpr (MODE == 0) { const int map = wid >> 2;
        qtok = b * S + blk * 128 + (wid & 3) * 32 + r32; qcol = 3 * 1024 + h * HD + map * 64; kcol = 4 * 1024 + h * HD; vcol = 5 * 1024 + h * HD; tok0 = b * S; NT = S / 64; ocol = 1024 + h * HD;
    } else { const int r = blk * 4 + (wid >> 1), qc = 32 * (wid & 1) + r32;
        qtok = b * S + r * GW + qc; qcol = h * HD; kcol = 1024 + h * HD; vcol = 2048 + h * HD; ocol = h * HD;
        int rlo = blk * 4 - 4; rlo = rlo < 0 ? 0 : (rlo > GR - KH ? GR - KH : rlo);
        int rhi = blk * 4 + 3 - 4; rhi = rhi < 0 ? 0 : (rhi > GR - KH ? GR - KH : rhi); rhi += KH - 1;
        int cnt = rhi - rlo + 1; if (cnt & 1) { if (rhi + 1 < GR) ++rhi; else --rlo; ++cnt; }
        kr0 = rlo; NT = cnt; tok0 = b * S + rlo * GW;
        nc.r = r; int rs = r - 4; nc.rs = rs < 0 ? 0 : (rs > GR - KH ? GR - KH : rs); nc.qc = qc; int cs = qc - 8; nc.cs = cs < 0 ? 0 : (cs > GW - KW ? GW - KW : cs);
    }
    __syncthreads();
    if constexpr (MODE == 1) { for (int i = tid; i < 15 * 31; i += NTHR) biasL[i] = rpb[h * 15 * 31 + i] * LOG2E; }
    constexpr bool QLDS = (MODE == 1);
    LAS unsigned char* Qs = lds + 65536 + wid * 8192;
    float m_reg = -1e30f, l_reg = 0; f32x16 o[4] = {}; bf16x8 qr[QLDS ? 1 : NKS];
    { const bf16_t* Qw = QKV + (size_t)qtok * INC + qcol + hi * 8;
#pragma unroll
      for (int d0 = 0; d0 < NKS; ++d0) { const bf16x8 qv = *(const bf16x8*)(Qw + d0 * 16);
          if constexpr (QLDS) *(LAS bf16x8*)(Qs + KSWZ(r32, (d0 * 16 + hi * 8) * 2)) = qv; else qr[d0] = qv; } }
    const int kcb = (MODE == 0) ? (wid >> 2) * 128 : 0;
    const int sr = tid >> 4, sc = (tid & 15) * 8, vst0 = v_st(sr, sc), vst1 = v_st(32 + sr, sc);
    const int vb0 = (int)(unsigned)(uintptr_t)V_lds + v_rd_base(lane);
    const bf16_t* Kg = QKV + (size_t)tok0 * INC + kcol + sc; const bf16_t* Vg = QKV + (size_t)tok0 * INC + vcol + sc;
    constexpr int SDEPTH = (MODE == 0) ? 2 : 1;
    struct { bf16x8 vs0, vs1, ks0, ks1; } sr_[SDEPTH];
#define SLOAD(i, k0) do { sr_[i].vs0 = *(const bf16x8*)(Vg + (size_t)((k0) + sr) * INC); sr_[i].vs1 = *(const bf16x8*)(Vg + (size_t)((k0) + 32 + sr) * INC); \
    sr_[i].ks0 = *(const bf16x8*)(Kg + (size_t)((k0) + sr) * INC); sr_[i].ks1 = *(const bf16x8*)(Kg + (size_t)((k0) + 32 + sr) * INC); } while (0)
#define SWRITE(bb, i) do { *(LAS bf16x8*)(V_lds + (bb) * SHM_V + vst0) = sr_[i].vs0; *(LAS bf16x8*)(V_lds + (bb) * SHM_V + vst1) = sr_[i].vs1; const int kc = sc * 2; \
    *(LAS bf16x8*)(K_lds + (bb) * SHM_K + KSWZ(sr, kc)) = sr_[i].ks0; *(LAS bf16x8*)(K_lds + (bb) * SHM_K + KSWZ(32 + sr, kc)) = sr_[i].ks1; } while (0)
#define SWAIT() do { if constexpr (SDEPTH == 2) asm volatile("s_waitcnt vmcnt(4)" ::: "memory"); else asm volatile("s_waitcnt vmcnt(0)" ::: "memory"); } while (0)
#define RESC(a) do { if (__any((a) < 1.f)) { if (hi == 0) al_l[r32] = (a); asm volatile("s_waitcnt lgkmcnt(0)" ::: "memory"); \
    _Pragma("unroll") for (int d = 0; d < 4; ++d) _Pragma("unroll") for (int r = 0; r < 16; ++r) o[d][r] *= al_l[crow(r, hi)]; } } while (0)
    f32x16 pA0, pA1, pB0, pB1; float mnA, mnB, alA, alB; bf16x8 pa0, pa1, pa2, pa3;
    constexpr int SE = 0, SO = SDEPTH - 1;
    if (wid >= 4) __builtin_amdgcn_s_setprio(1);
    SLOAD(SE, 0); asm volatile("s_waitcnt vmcnt(0)" ::: "memory"); SWRITE(0, SE); __syncthreads();
    qkt<NKS, QLDS>(pA0, pA1, K_lds, qr, Qs, kcb, r32, hi); partialSM<MODE>(pA0, pA1, m_reg, mnA, alA, nc, kr0, hi);
    SLOAD(SO, 64); if constexpr (SDEPTH == 2) { if (2 < NT) SLOAD(SE, 2 * 64); }
    SWAIT(); SWRITE(1, SO); __syncthreads();
    for (int j = 1; j + 1 < NT; j += 2) {
        SBAR(); qkt<NKS, QLDS>(pB0, pB1, K_lds + SHM_K, qr, Qs, kcb, r32, hi);
        finishSM(pA0, pA1, alA, l_reg, pa0, pa1, pa2, pa3); SBAR();
        SLOAD(SO, (j + SDEPTH) * 64); SBAR();
        pv_d0(o, vb0, pa0, pa1, pa2, pa3); partialSM<MODE>(pB0, pB1, m_reg, mnB, alB, nc, kr0 + j, hi);
        __syncthreads(); SWAIT(); SWRITE(0, SE);
        RESC(alB); __syncthreads();
        SBAR(); qkt<NKS, QLDS>(pA0, pA1, K_lds, qr, Qs, kcb, r32, hi);
        finishSM(pB0, pB1, alB, l_reg, pa0, pa1, pa2, pa3); SBAR();
        if (SDEPTH == 1 || j + 3 < NT) SLOAD(SE, (j + 1 + SDEPTH) * 64); SBAR();
        pv_d0(o, vb0 + SHM_V, pa0, pa1, pa2, pa3); partialSM<MODE>(pA0, pA1, m_reg, mnA, alA, nc, kr0 + j + 1, hi);
        __syncthreads(); SWAIT(); SWRITE(1, SO);
        RESC(alA); __syncthreads();
    }
    SBAR(); qkt<NKS, QLDS>(pB0, pB1, K_lds + SHM_K, qr, Qs, kcb, r32, hi);
    finishSM(pA0, pA1, alA, l_reg, pa0, pa1, pa2, pa3); SBAR();
    pv_d0(o, vb0, pa0, pa1, pa2, pa3); partialSM<MODE>(pB0, pB1, m_reg, mnB, alB, nc, kr0 + NT - 1, hi);
    __syncthreads(); RESC(alB);
    finishSM(pB0, pB1, alB, l_reg, pa0, pa1, pa2, pa3); SBAR();
    pv_d0(o, vb0 + SHM_V, pa0, pa1, pa2, pa3);
    __builtin_amdgcn_s_setprio(0);
    if (hi == 0) li_l[r32] = l_reg; asm volatile("s_waitcnt lgkmcnt(0)" ::: "memory");
    float rli[16];
#pragma unroll
    for (int r = 0; r < 16; ++r) rli[r] = __builtin_amdgcn_rcpf(li_l[crow(r, hi)]);
    const int tid2 = opaque_tid(), wid2 = tid2 >> 6, lane2 = tid2 & 63, r32b = lane2 & 31, hib = lane2 >> 5;
    LAS bf16_t* OT = (LAS bf16_t*)(lds + 65536 + wid2 * 8192);
    if constexpr (MODE == 0) {
        LAS float* XCH = (LAS float*)lds;
        __syncthreads();
        if (wid2 >= 4) {
#pragma unroll
            for (int d = 0; d < 4; ++d)
#pragma unroll
                for (int r = 0; r < 16; ++r) XCH[((wid2 - 4) * 64 + d * 16 + r) * 64 + lane2] = o[d][r] * rli[r] * lam;
        }
        __syncthreads();
        if (wid2 < 4) {
            float ssr[16];
#pragma unroll
            for (int r = 0; r < 16; ++r) ssr[r] = 0.f;
#pragma unroll
            for (int d = 0; d < 4; ++d)
#pragma unroll
                for (int r = 0; r < 16; ++r) { const float v = o[d][r] * rli[r] - XCH[(wid2 * 64 + d * 16 + r) * 64 + lane2]; o[d][r] = v; ssr[r] += v * v; }
#pragma unroll
            for (int r = 0; r < 16; ++r) { float s_ = ssr[r]; s_ += __shfl_xor(s_, 1); s_ += __shfl_xor(s_, 2); s_ += __shfl_xor(s_, 4); s_ += __shfl_xor(s_, 8); s_ += __shfl_xor(s_, 16);
                ssr[r] = rsqrtf(s_ * (1.0f / 128.0f) + EPS) * 0.8f; }
#pragma unroll
            for (int d = 0; d < 4; ++d) { const float sg = subln[d * 32 + r32b];
#pragma unroll
                for (int r = 0; r < 16; ++r) OT[crow(r, hib) * 128 + d * 32 + r32b] = f2bf(o[d][r] * ssr[r] * sg); }
        }
    } else {
#pragma unroll
        for (int d = 0; d < 4; ++d)
#pragma unroll
            for (int r = 0; r < 16; ++r) OT[crow(r, hib) * 128 + d * 32 + r32b] = f2bf(o[d][r] * rli[r]);
    }
    if (MODE == 1 || wid2 < 4) {
        asm volatile("s_waitcnt lgkmcnt(0)" ::: "memory");
        const int otok0 = (MODE == 0) ? (b * S + blk * 128 + wid2 * 32) : (b * S + (blk * 4 + (wid2 >> 1)) * GW + 32 * (wid2 & 1)); const int ocol2 = (MODE == 0) ? (1024 + h * HD) : (h * HD);
#pragma unroll
        for (int it = 0; it < 8; ++it) { const int row = it * 4 + (lane2 >> 4), cc = (lane2 & 15) * 8;
            *(u32x4*)(ATT + (size_t)(otok0 + row) * D + ocol2 + cc) = *(const LAS u32x4*)(OT + row * 128 + cc); }
    }
#undef SLOAD
#undef SWRITE
#undef SWAIT
#undef RESC
}

__device__ __forceinline__ void na_unit(const bf16_t* __restrict__ QKV, bf16_t* __restrict__ ATT, int b, int h, int blk, LAS unsigned char* lds, const float* __restrict__ rpb) {
    const int tid = opaque_tid(), wid = tid >> 6, lane = tid & 63, r32 = lane & 31, hi = lane >> 5;
    LAS unsigned char* R = lds + wid * 16384;
    LAS float* wsr = (LAS float*)(lds + MISC_OFF + 1024) + wid * 64; LAS float* li_l = wsr; LAS float* al_l = wsr + 32;
    LAS float* biasL = (LAS float*)(lds + MISC_OFF + 8192);
    const int r = blk * 4 + (wid >> 1), qc = 32 * (wid & 1) + r32;
    const int qtok = b * S + r * GW + qc, qcol = h * HD, kcol = 1024 + h * HD, vcol = 2048 + h * HD;
    NaCtx nc; nc.bias = biasL; nc.r = r; { int rs = r - 4; nc.rs = rs < 0 ? 0 : (rs > GR - KH ? GR - KH : rs); } nc.qc = qc; { int cs = qc - 8; nc.cs = cs < 0 ? 0 : (cs > GW - KW ? GW - KW : cs); }
    const int rs_w = __builtin_amdgcn_readfirstlane(nc.rs);
    __syncthreads();
    for (int i = tid; i < 15 * 31; i += NTHR) biasL[i] = rpb[h * 15 * 31 + i] * LOG2E;
    float m_reg = -1e30f, l_reg = 0; f32x16 o[4] = {}; bf16x8 qr[8];
    { const bf16_t* Qw = QKV + (size_t)qtok * INC + qcol + hi * 8;
#pragma unroll
      for (int d0 = 0; d0 < 8; ++d0) qr[d0] = *(const bf16x8*)(Qw + d0 * 16); }
    const int sr = lane >> 4, sc = (lane & 15) * 8;
    const int vb0 = (int)(unsigned)(uintptr_t)R + v_rd_base(lane);
    const bf16_t* Kg = QKV + (size_t)(b * S + rs_w * GW + sr) * INC + kcol + sc; const bf16_t* Vg = QKV + (size_t)(b * S + rs_w * GW + sr) * INC + vcol + sc;
    bf16x8 st[16];
#define WLOAD(gp, j) do { _Pragma("unroll") for (int i = 0; i < 16; ++i) st[i] = *(const bf16x8*)((gp) + (size_t)((j) * 64 + 4 * i) * INC); } while (0)
    WLOAD(Kg, 0);
    __syncthreads();
#pragma unroll 1
    for (int j = 0; j < KH; ++j) {
        const int kr = rs_w + j;
#pragma unroll
        for (int i = 0; i < 16; ++i) *(LAS bf16x8*)(R + KSWZ(sr + 4 * i, sc * 2)) = st[i];
        asm volatile("s_waitcnt lgkmcnt(0)" ::: "memory");
        WLOAD(Vg, j);
        f32x16 p0, p1; float mn, al; bf16x8 pa0, pa1, pa2, pa3;
        qkt<8, false>(p0, p1, R, qr, nullptr, 0, r32, hi);
        partialSM<1>(p0, p1, m_reg, mn, al, nc, kr, hi);
        if (__any(al < 1.f)) { if (hi == 0) al_l[r32] = al; asm volatile("s_waitcnt lgkmcnt(0)" ::: "memory");
#pragma unroll
            for (int d = 0; d < 4; ++d)
#pragma unroll
                for (int rr = 0; rr < 16; ++rr) o[d][rr] *= al_l[crow(rr, hi)]; }
        finishSM(p0, p1, al, l_reg, pa0, pa1, pa2, pa3);
        asm volatile("s_waitcnt lgkmcnt(0)" ::: "memory");
#pragma unroll
        for (int i = 0; i < 16; ++i) *(LAS bf16x8*)(R + v_st(sr + 4 * i, sc)) = st[i];
        asm volatile("s_waitcnt lgkmcnt(0)" ::: "memory");
        if (j + 1 < KH) WLOAD(Kg, j + 1);
        pv_d0(o, vb0, pa0, pa1, pa2, pa3);
    }
#undef WLOAD
    if (hi == 0) li_l[r32] = l_reg; asm volatile("s_waitcnt lgkmcnt(0)" ::: "memory");
    float rli[16];
#pragma unroll
    for (int rr = 0; rr < 16; ++rr) rli[rr] = __builtin_amdgcn_rcpf(li_l[crow(rr, hi)]);
    const int tid2 = opaque_tid(), wid2 = tid2 >> 6, lane2 = tid2 & 63, r32b = lane2 & 31, hib = lane2 >> 5;
    LAS bf16_t* OT = (LAS bf16_t*)(lds + wid2 * 16384);
#pragma unroll
    for (int d = 0; d < 4; ++d)
#pragma unroll
        for (int rr = 0; rr < 16; ++rr) OT[crow(rr, hib) * 128 + d * 32 + r32b] = f2bf(o[d][rr] * rli[rr]);
    asm volatile("s_waitcnt lgkmcnt(0)" ::: "memory");
    const int otok0 = b * S + (blk * 4 + (wid2 >> 1)) * GW + 32 * (wid2 & 1);
#pragma unroll
    for (int it = 0; it < 8; ++it) { const int row = it * 4 + (lane2 >> 4), cc = (lane2 & 15) * 8;
        *(u32x4*)(ATT + (size_t)(otok0 + row) * D + h * HD + cc) = *(const LAS u32x4*)(OT + row * 128 + cc); }
}
#undef KSWZ
#undef SBAR
}

__device__ __forceinline__ unsigned pk2(float lo, float hi) { return (unsigned)f2bf(lo) | ((unsigned)f2bf(hi) << 16); }
struct TDesc { const float* W; bf16_t* WT; const float* gain; size_t ob; int K, N, rbase, k0, n0, f8, mode, rs; };
__device__ __forceinline__ void tfix(TDesc& d) {
    if ((d.N & 255) == 0) { const int ksz = d.f8 ? 128 : 64; d.ob = (size_t)(d.rbase >> 8) * 256 * d.K + (size_t)(d.k0 / ksz) * (256 * ksz) + (size_t)(d.rbase & 255) * ksz; d.rs = ksz; }
    else { d.ob = (size_t)d.rbase * d.K + d.k0; d.rs = d.K; }
}
__device__ __forceinline__ void tmake(TDesc& d, const float* W, int K, int N, bf16_t* WT, int mode, const float* gain, int item, int f8 = 0) {
    d.W = W; d.WT = WT; d.gain = gain; d.K = K; d.N = N; d.f8 = f8; d.mode = mode;
    if (f8) { const int nblk = N / 32, kb = item / nblk, nb = item % nblk; d.k0 = 128 * kb; d.n0 = 32 * nb; }
    else { const int nblk = N / 64, kb = item / nblk, nb = item % nblk; d.k0 = 64 * kb; d.n0 = 64 * nb; }
    d.rbase = (mode == 0) ? d.n0 : (256 * (d.n0 >> 7) + (d.n0 & 127) + (mode == 2 ? 128 : 0)); tfix(d);
}
__device__ __forceinline__ void tload(const TDesc& d, f32x4 (&v)[16], float (&gq)[2], int lane) {
    gq[0] = d.gain ? d.gain[d.k0 + lane] : 1.f; gq[1] = (d.gain && d.f8) ? d.gain[d.k0 + 64 + lane] : 1.f;
    if (d.f8) { const float* p = d.W + (size_t)(d.k0 + (lane >> 3)) * d.N + d.n0 + (lane & 7) * 4;
#pragma unroll
        for (int i = 0; i < 16; ++i) v[i] = __builtin_nontemporal_load((const f32x4*)(p + (size_t)(8 * i) * d.N));
        return; }
    const float* p = d.W + (size_t)(d.k0 + (lane >> 4)) * d.N + d.n0 + (lane & 15) * 4;
#pragma unroll
    for (int i = 0; i < 16; ++i) v[i] = __builtin_nontemporal_load((const f32x4*)(p + (size_t)(4 * i) * d.N));
}
__device__ __forceinline__ void tstore(const TDesc& d, const f32x4 (&v)[16], const float (&gq)[2], LAS unsigned char* scr, int lane) {
    const int g = lane >> 4, l16 = lane & 15, r = l16 >> 2, c = l16 & 3; const unsigned sbase = (unsigned)(uintptr_t)scr;
    u32x2 t[8];
    if (d.f8) {
        const float g0 = gq[0] * W8_SCALE, g1 = gq[1] * W8_SCALE;
#pragma unroll
        for (int i = 0; i < 16; ++i) { const int k = 8 * i + (lane >> 3); const float gg = (i < 8) ? __shfl(g0, k) : __shfl(g1, k - 64); const f32x4 x = v[i] * gg;
            u32x2 pk; pk.x = cvt_pk_bf16(x[0], x[1]); pk.y = cvt_pk_bf16(x[2], x[3]); *(LAS u32x2*)(scr + k * 72 + (lane & 7) * 8) = pk; }
        asm volatile("s_waitcnt lgkmcnt(0)" ::: "memory");
        const unsigned lb = sbase + (unsigned)((16 * g + r) * 72 + 8 * c);
        unsigned char* W8 = (unsigned char*)d.WT;
#pragma unroll
        for (int jh = 0; jh < 2; ++jh) {
            if (jh == 0) { asm volatile("ds_read_b64_tr_b16 %0, %8 offset:0\n\tds_read_b64_tr_b16 %1, %8 offset:288\n\tds_read_b64_tr_b16 %2, %8 offset:576\n\tds_read_b64_tr_b16 %3, %8 offset:864\n\tds_read_b64_tr_b16 %4, %8 offset:4608\n\tds_read_b64_tr_b16 %5, %8 offset:4896\n\tds_read_b64_tr_b16 %6, %8 offset:5184\n\tds_read_b64_tr_b16 %7, %8 offset:5472\n\ts_waitcnt lgkmcnt(0)" : "=&v"(t[0]), "=&v"(t[1]), "=&v"(t[2]), "=&v"(t[3]), "=&v"(t[4]), "=&v"(t[5]), "=&v"(t[6]), "=&v"(t[7]) : "v"(lb) : "memory"); } else { asm volatile("ds_read_b64_tr_b16 %0, %8 offset:32\n\tds_read_b64_tr_b16 %1, %8 offset:320\n\tds_read_b64_tr_b16 %2, %8 offset:608\n\tds_read_b64_tr_b16 %3, %8 offset:896\n\tds_read_b64_tr_b16 %4, %8 offset:4640\n\tds_read_b64_tr_b16 %5, %8 offset:4928\n\tds_read_b64_tr_b16 %6, %8 offset:5216\n\tds_read_b64_tr_b16 %7, %8 offset:5504\n\ts_waitcnt lgkmcnt(0)" : "=&v"(t[0]), "=&v"(t[1]), "=&v"(t[2]), "=&v"(t[3]), "=&v"(t[4]), "=&v"(t[5]), "=&v"(t[6]), "=&v"(t[7]) : "v"(lb) : "memory"); }
#pragma unroll
            for (int jj = 0; jj < 2; ++jj) { const int j = jh * 2 + jj, nb = j >> 1, kc = (j & 1) * 4 + g; u32x4 o;
#pragma unroll
                for (int h = 0; h < 4; ++h) { const u32x2 w = t[jj * 4 + h];
                    o[h] = pk4_fp8(__uint_as_float(w.x << 16), __uint_as_float(w.x & 0xffff0000u), __uint_as_float(w.y << 16), __uint_as_float(w.y & 0xffff0000u)); }
                __builtin_nontemporal_store(o, (u32x4*)(W8 + d.ob + (size_t)(16 * nb + l16) * d.rs + 16 * kc)); } }
        return;
    }
    const float gv = gq[0];
#pragma unroll
    for (int i = 0; i < 16; ++i) { const int k = 4 * i + (lane >> 4); const float gg = __shfl(gv, k); const f32x4 x = v[i] * gg;
        u32x2 pk; pk.x = cvt_pk_bf16(x[0], x[1]); pk.y = cvt_pk_bf16(x[2], x[3]); *(LAS u32x2*)(scr + k * 144 + (lane & 15) * 8) = pk; }
    asm volatile("s_waitcnt lgkmcnt(0)" ::: "memory");
    const unsigned lb = sbase + (unsigned)((8 * g + r) * 144 + 8 * c);
#pragma unroll
    for (int jh = 0; jh < 2; ++jh) {
        if (jh == 0) { asm volatile("ds_read_b64_tr_b16 %0, %8 offset:0\n\tds_read_b64_tr_b16 %1, %8 offset:576\n\tds_read_b64_tr_b16 %2, %8 offset:4608\n\tds_read_b64_tr_b16 %3, %8 offset:5184\n\tds_read_b64_tr_b16 %4, %8 offset:32\n\tds_read_b64_tr_b16 %5, %8 offset:608\n\tds_read_b64_tr_b16 %6, %8 offset:4640\n\tds_read_b64_tr_b16 %7, %8 offset:5216\n\ts_waitcnt lgkmcnt(0)" : "=&v"(t[0]), "=&v"(t[1]), "=&v"(t[2]), "=&v"(t[3]), "=&v"(t[4]), "=&v"(t[5]), "=&v"(t[6]), "=&v"(t[7]) : "v"(lb) : "memory"); } else { asm volatile("ds_read_b64_tr_b16 %0, %8 offset:64\n\tds_read_b64_tr_b16 %1, %8 offset:640\n\tds_read_b64_tr_b16 %2, %8 offset:4672\n\tds_read_b64_tr_b16 %3, %8 offset:5248\n\tds_read_b64_tr_b16 %4, %8 offset:96\n\tds_read_b64_tr_b16 %5, %8 offset:672\n\tds_read_b64_tr_b16 %6, %8 offset:4704\n\tds_read_b64_tr_b16 %7, %8 offset:5280\n\ts_waitcnt lgkmcnt(0)" : "=&v"(t[0]), "=&v"(t[1]), "=&v"(t[2]), "=&v"(t[3]), "=&v"(t[4]), "=&v"(t[5]), "=&v"(t[6]), "=&v"(t[7]) : "v"(lb) : "memory"); }
#pragma unroll
        for (int jj = 0; jj < 4; ++jj) { const int j = jh * 4 + jj, nb = j >> 1, kc = (j & 1) * 4 + g; u32x4 o; o.x = t[2 * jj].x; o.y = t[2 * jj].y; o.z = t[2 * jj + 1].x; o.w = t[2 * jj + 1].y;
            *(u32x4*)(d.WT + d.ob + (size_t)(16 * nb + l16) * d.rs + 8 * kc) = o; } }
}

#ifndef DUP_MASK
#define DUP_MASK 0
#endif
struct MArgs { const float* in[30]; float* out; unsigned char* ws; int ph_lo, ph_hi; };
__global__ void __launch_bounds__(NTHR, 2) mega(MArgs args) {
    extern __shared__ __attribute__((aligned(16))) unsigned char lds_raw[];
    LAS unsigned char* lds = (LAS unsigned char*)lds_raw;
    const int tid = threadIdx.x;
    const int G = gridDim.x;
    unsigned char* ws = args.ws;
    unsigned* ctl = (unsigned*)(ws + WS_CTL);
    bf16_t* WB = (bf16_t*)(ws + WS_WBF);
    float* PART = (float*)(ws + WS_PART);
    LAS float* PL = (LAS float*)(lds + MISC_OFF + 4096);
    volatile LAS unsigned* MISC = (volatile LAS unsigned*)(lds + MISC_OFF);
    if (tid < 64) MISC[tid] = 0u;
    __syncthreads();
    const int lo = args.ph_lo, hi = args.ph_hi;
    const bool multi = (hi - lo) > 1;
    XcdBarrier bar; bar.bar = ctl + CW_BAR; bar.x = 0; bar.st = nullptr;
    if (multi) bar = xcd_barrier_post(ctl + CW_BAR, MISC + 8);
#define IN(k) (lo <= (k) && (k) < hi)
#define REP(k) for (int rep_ = 0; rep_ <= ((DUP_MASK >> (k)) & 1); ++rep_)
#define SEAM(k) do { if (IN(k) && IN((k) + 1)) xcd_barrier(bar); } while (0)
    const int NGW = G * NWAVES;
#define PHASE_IDS() const int ptid = opaque_tid(), lane = ptid & 63, wave = __builtin_amdgcn_readfirstlane(ptid >> 6), gw = blockIdx.x * NWAVES + wave; (void)lane; (void)gw

    constexpr int I_IN0 = (D / 64) * (INC / 64), I_SQ = (D / 64) * (D / 64), I_FF = (D / 64) * (FF / 64), I_DN = (FF / 64) * (D / 64), I_IN1 = (D / 64) * (2 * D / 64), I_LRU = 64 * 4;
    constexpr int NITEMS = I_IN0 + I_SQ + 2 * I_FF + I_DN + I_IN1 + I_SQ + I_LRU + NE * (2 * I_FF + I_DN);
    constexpr int NDENSE = I_IN0 + I_LRU;
    constexpr int QLRU = I_IN0 + I_SQ + 2 * I_FF + I_DN + I_IN1 + I_SQ;
    constexpr int QA = QLRU - I_IN0;
    constexpr int TAIL_ITEMS = 24576, TAILQ = ((NITEMS - I_IN0 - I_LRU) - TAIL_ITEMS) & ~15;
    static_assert(QA % 16 == 0 && (INC / 64) % 16 == 0 && (D / 64) % 16 == 0 && (FF / 64) % 16 == 0 && (2 * D / 64) % 16 == 0 && (FF / 32) % 16 == 0 && (D / 32) % 16 == 0, "a 16-item queue chunk stays inside one (matrix, k-block)");
    REP(0) if (IN(0)) { PHASE_IDS();
        LAS unsigned char* scr = lds + wave * 16384;
#define TDECODE(dd, it_) do { int r = (it_); \
            if (r < I_IN0) { tmake(dd, args.in[2], D, INC, WB + WT_IN0, 0, args.in[1], r); break; } r -= I_IN0; \
            if (r < I_SQ) { tmake(dd, args.in[9], D, D, WB + WT_OUT0, 0, nullptr, r); break; } r -= I_SQ; \
            if (r < I_FF) { tmake(dd, args.in[11], D, FF, WB + WT_GU0, 1, args.in[10], r, FFNGU8); break; } r -= I_FF; \
            if (r < I_FF) { tmake(dd, args.in[12], D, FF, WB + WT_GU0, 2, args.in[10], r, FFNGU8); break; } r -= I_FF; \
            if (r < I_DN) { tmake(dd, args.in[13], FF, D, WB + WT_DN0, 0, nullptr, r, FFNDN8); break; } r -= I_DN; \
            if (r < I_IN1) { tmake(dd, args.in[15], D, 2 * D, WB + WT_IN1, 0, args.in[14], r); break; } r -= I_IN1; \
            if (r < I_SQ) { tmake(dd, args.in[23], D, D, WB + WT_OUT1, 0, nullptr, r); break; } r -= I_SQ; \
            if (r < I_LRU) { const int mat = r >> 2, sub = r & 3; const float* src = (mat < 32 ? args.in[18] : args.in[20]) + (size_t)(mat & 31) * LBD * LBD; \
                tmake(dd, src, LBD, LBD, WB + WT_LRU + (size_t)mat * LBD * LBD, 0, nullptr, sub); break; } r -= I_LRU; \
            { const int per = 2 * I_FF + I_DN, e = r / per; int q = r % per; \
              if (q < I_FF) { tmake(dd, args.in[26] + (size_t)e * D * FF, D, FF, (bf16_t*)((unsigned char*)(WB + WT_MGU) + (size_t)e * 2 * FF * D), 1, args.in[24], q, 1); break; } q -= I_FF; \
              if (q < I_FF) { tmake(dd, args.in[27] + (size_t)e * D * FF, D, FF, (bf16_t*)((unsigned char*)(WB + WT_MGU) + (size_t)e * 2 * FF * D), 2, args.in[24], q, 1); break; } q -= I_FF; \
              tmake(dd, args.in[28] + (size_t)e * FF * D, FF, D, (bf16_t*)((unsigned char*)(WB + WT_MDN) + (size_t)e * FF * D), 0, nullptr, q, 1); } } while (0)
        { TDesc dc, dn; f32x4 cur[16], nxt[16]; float gc[2], gn2[2]; int it = gw;
#define P0_ITEM(i_) ((i_) < I_IN0 ? (i_) : (i_) - I_IN0 + QLRU)
          if (it < NDENSE) { TDECODE(dc, P0_ITEM(it)); tload(dc, cur, gc, lane); }
          for (; it < NDENSE; it += NGW) {
              const int nit = it + NGW; const bool hn = nit < NDENSE;
              if (hn) { TDECODE(dn, P0_ITEM(nit)); tload(dn, nxt, gn2, lane); }
              tstore(dc, cur, gc, scr, lane);
              if (hn) { dc = dn; gc[0] = gn2[0]; gc[1] = gn2[1];
#pragma unroll
                  for (int i = 0; i < 16; ++i) cur[i] = nxt[i]; } }
#undef P0_ITEM
        }
        { float* C8 = (float*)(ws + WS_C8SP);
          for (int i = blockIdx.x * NTHR + tid; i < 2 * D; i += G * NTHR) { const float ap = args.in[22][i]; const float sp = (-ap > 20.f) ? -ap : log1pf(expf(-ap)); C8[i] = -8.0f * sp * 1.4426950408889634f; } }
        { float* RC = (float*)(ws + WS_ROPE); float* RS = RC + S * 32;
          for (int i = blockIdx.x * NTHR + tid; i < S * 32; i += G * NTHR) { const int s = i / 32, j = i % 32; const float inv = 1.0f / powf(10000.0f, (float)(2 * j) / 64.0f); const float ang = (float)s * inv; RC[i] = cosf(ang); RS[i] = sinf(ang); } }
        { bf16_t* XB = (bf16_t*)(ws + WS_XB);
          for (int m = gw; m < T; m += NGW) { const f32x4* xr = (const f32x4*)(args.in[0] + (size_t)m * D) + lane; float ss = 0.f;
#pragma unroll
              for (int j = 0; j < 8; ++j) { const f32x4 v = xr[64 * j]; ss += (v[0] * v[0] + v[1] * v[1]) + (v[2] * v[2] + v[3] * v[3]);
                  u32x2 w; w.x = cvt_pk_bf16(v[0], v[1]); w.y = cvt_pk_bf16(v[2], v[3]); *((u32x2*)(XB + (size_t)m * D) + lane + 64 * j) = w; }
              ss = wave_sum(ss); if (lane < 8) PART[(size_t)m * 8 + lane] = (lane == 0) ? ss : 0.f; } }
    }
    SEAM(0);
    REP(1) if (IN(1)) {
        Gemm g{(const bf16_t*)(ws + WS_XB), WB + WT_IN0, INC, D, 0}; StaticOrder So; So.init(T, INC, G, (int)blockIdx.x);
        EpiQkv E{(bf16_t*)(ws + WS_QKV), PART, (const float*)(ws + WS_ROPE), (const float*)(ws + WS_ROPE) + S * 32};
        gemm_phase<EpiQkv, StaticOrder, 2, false>(lds, g, So, E);
    }
    SEAM(1);
    REP(2) if (IN(2)) { PHASE_IDS();
        const bf16_t* QKV = (const bf16_t*)(ws + WS_QKV); bf16_t* ATT = (bf16_t*)(ws + WS_ATT);
        float s1 = 0.f, s2 = 0.f;
        for (int i = 0; i < 64; ++i) { s1 += args.in[4][i] * args.in[5][i]; s2 += args.in[6][i] * args.in[7][i]; }
        const float lam = expf(s1) - expf(s2) + 0.2f;
        const unsigned myx = xb_xcc_id() & 7u;
        if (tid == 0) MISC[16] = xb_add(ctl + CW_XRANK + 64 * myx, 1u);
        __syncthreads();
        const bool conv_first = (unsigned)__builtin_amdgcn_readfirstlane((int)MISC[16]) < (unsigned)NCV_PER_XCD;
#define P2_NEXT(dd, ok) do { if (crem == 0) { if (!qhave) { cstepn = (qpos >= TAILQ) ? 4 : 16; qnext = 4 * (int)__builtin_amdgcn_readfirstlane((int)(lane == 0 ? xb_add(ctl + CW_CVQ, (unsigned)(cstepn >> 2)) : 0u)); } \
                qpos = qnext; crem = cstepn; cbase = -1; qhave = false; } \
            if (cbase < 0 || (qpos & 15) == 0) { const int item_ = I_IN0 + qpos + (qpos >= QA ? I_LRU : 0); cvalid = item_ < NITEMS; if (cvalid) { TDECODE(cd, item_); } cbase = qpos; } \
            ok = cvalid; if (ok) { dd = cd; dd.n0 = cd.n0 + (qpos - cbase) * (cd.f8 ? 32 : 64); dd.rbase = (cd.mode == 0) ? dd.n0 : (256 * (dd.n0 >> 7) + (dd.n0 & 127) + (cd.mode == 2 ? 128 : 0)); tfix(dd); } \
            ++qpos; --crem; qwant = (crem == 0) && cvalid; } while (0)
#define P2_POST() do { if (qwant) { cstepn = (qpos >= TAILQ) ? 4 : 16; qnext = 4 * (int)__builtin_amdgcn_readfirstlane((int)(lane == 0 ? xb_add(ctl + CW_CVQ, (unsigned)(cstepn >> 2)) : 0u)); qhave = true; qwant = false; } } while (0)
#define P2_CONVERT() do { LAS unsigned char* scr = lds + wave * 16384; TDesc cd, dc, dn; f32x4 cur[16], nxt[16]; float gc[2], gn2[2]; int qpos = 0, crem = 0, cbase = -1, cstepn = 16, qnext = 0; bool cvalid = false, qhave = false, qwant = false, okc, okn; \
            P2_NEXT(dc, okc); if (okc) tload(dc, cur, gc, lane); P2_POST(); \
            while (okc) { \
                P2_NEXT(dn, okn); if (okn) tload(dn, nxt, gn2, lane); P2_POST(); \
                tstore(dc, cur, gc, scr, lane); \
                if (okn) { dc = dn; gc[0] = gn2[0]; gc[1] = gn2[1]; _Pragma("unroll") for (int i = 0; i < 16; ++i) cur[i] = nxt[i]; } \
                okc = okn; } \
            __syncthreads(); } while (0)
#define P2_CONVERT3() do { const int lane = opaque_tid() & 63; LAS unsigned char* scr = lds + wave * 16384; TDesc cd, d0, d1, d2; f32x4 b0[16], b1[16], b2[16]; float g0q[2], g1q[2], g2q[2]; int qpos = 0, crem = 0, cbase = -1, cstepn = 16, qnext = 0; bool cvalid = false, qhave = false, qwant = false, k0, k1, k2; \
            P2_NEXT(d0, k0); if (k0) tload(d0, b0, g0q, lane); P2_POST(); \
            P2_NEXT(d1, k1); if (k1) tload(d1, b1, g1q, lane); P2_POST(); \
            while (k0) { \
                P2_NEXT(d2, k2); if (k2) tload(d2, b2, g2q, lane); P2_POST(); \
                tstore(d0, b0, g0q, scr, lane); \
                if (!k1) break; \
                P2_NEXT(d0, k0); if (k0) tload(d0, b0, g0q, lane); P2_POST(); \
                tstore(d1, b1, g1q, scr, lane); \
                if (!k2) break; \
                P2_NEXT(d1, k1); if (k1) tload(d1, b1, g1q, lane); P2_POST(); \
                tstore(d2, b2, g2q, scr, lane); } \
            } while (0)
        if (conv_first) { P2_CONVERT3(); __syncthreads(); }
#pragma unroll 1
        for (unsigned qx = 0; qx < 8; ++qx) { const unsigned x = (myx + qx) & 7u;
            for (;;) {
                __syncthreads();
                if (tid == 0) MISC[17] = xb_add(ctl + CW_AQ + 64 * x, 1u);
                __syncthreads();
                const unsigned u = MISC[17]; if (u >= 96u) break;
                if (u < 64u) { const int bh = 2 * (int)x + (int)(u >> 5), qb = (int)(u & 31u); att::attn_unit<0>(QKV, ATT, bh >> 3, bh & 7, qb, lds, args.in[8], lam, nullptr); }
                else { const int c = (int)u - 64, bh = 2 * (int)x + (c >> 4), rb = c & 15; att::na_unit(QKV, ATT, bh >> 3, bh & 7, rb, lds, args.in[3]); } } }
        __syncthreads();
        if (!conv_first) { P2_CONVERT3(); __syncthreads(); }
#undef P2_CONVERT
#undef P2_CONVERT3
#undef P2_NEXT
#undef P2_POST
    }
#undef TDECODE
    SEAM(2);
    REP(3) if (IN(3)) {
        Gemm g{(const bf16_t*)(ws + WS_ATT), WB + WT_OUT0, D, D, 0}; StaticOrder So; So.init(T, D, G, (int)blockIdx.x);
        EpiResid E{args.in[0], (float*)(ws + WS_X1), (bf16_t*)(ws + WS_XB), PART + 8 * T, PL, FFNGU8 ? (unsigned char*)(ws + WS_HA) : nullptr, 1.f};
        gemm_phase<EpiResid, StaticOrder, 0, false>(lds, g, So, E);
    }
    SEAM(3);
    REP(4) if (IN(4)) {
        Gemm g{(const bf16_t*)(ws + (FFNGU8 ? WS_HA : WS_XB)), WB + WT_GU0, 2 * FF, D, 0}; StaticOrder So; So.init(T, 2 * FF, G, (int)blockIdx.x);
        EpiGateUp<false, FFNDN8, FFNGU8> E{(bf16_t*)(ws + WS_ACT), PART + 8 * T, nullptr};
        gemm_phase<EpiGateUp<false, FFNDN8, FFNGU8>, StaticOrder, 1, false, FFNGU8>(lds, g, So, E);
    }
    SEAM(4);
    REP(5) if (IN(5)) {
        Gemm g{(const bf16_t*)(ws + WS_ACT), WB + WT_DN0, D, FF, 0}; StaticOrder So; So.init(T, D, G, (int)blockIdx.x);
        EpiResid E{(const float*)(ws + WS_X1), (float*)(ws + WS_X2), (bf16_t*)(ws + WS_XB), PART + 16 * T, PL, nullptr, FFNDN8 ? W8_INV : 1.f};
        gemm_phase<EpiResid, StaticOrder, 0, false, FFNDN8>(lds, g, So, E);
    }
    SEAM(5);
    REP(6) if (IN(6)) {
        Gemm g{(const bf16_t*)(ws + WS_XB), WB + WT_IN1, 2 * D, D, 0}; StaticOrder So; So.init(T, 2 * D, G, (int)blockIdx.x);
        EpiL1In E{(bf16_t*)(ws + WS_Y), (bf16_t*)(ws + WS_REC), PART + 16 * T};
        gemm_phase<EpiL1In, StaticOrder, 1, false>(lds, g, So, E);
    }
    SEAM(6);
    REP(7) if (IN(7)) {
        const int ptid = opaque_tid(), wv = __builtin_amdgcn_readfirstlane(ptid >> 6);
        const bf16_t* REC = (const bf16_t*)(ws + WS_REC); bf16_t* AB = (bf16_t*)(ws + WS_AB); const float* C8 = (const float*)(ws + WS_C8SP);
        float* SUMM = (float*)(ws + WS_SUMM);
        LAS unsigned char* Us = lds;
        LAS unsigned char* Ws = lds + 65536;
        LAS float* BL = (LAS float*)(lds + MISC_OFF + 8192);
        LAS unsigned char* TB = Us + wv * 8192;
#define SWZ(row, colB) ((row) * 256 + ((colB) ^ (((row) & 7) << 4)))
        constexpr float L2E = 1.4426950408889634f;
        for (int unit = blockIdx.x; unit < (T / 256) * LB; unit += G) {
            const int nb_ = unit % LB, tt = unit / LB, t0 = tt * 256, c0 = nb_ * LBD;
            {
              const int ctid = opaque_tid(); const int cg = ctid & 15, tr = ctid >> 4, cc = c0 + cg * 8; const int tb = t0 & ~(S - 1);
              float w8[4][8], b8[8];
              { const f32x4 b0 = *(const f32x4*)(args.in[17] + cc), b1 = *(const f32x4*)(args.in[17] + cc + 4);
#pragma unroll
                for (int i = 0; i < 4; ++i) { b8[i] = b0[i]; b8[4 + i] = b1[i]; } }
#pragma unroll
              for (int j = 0; j < 4; ++j) { const f32x4 x0 = *(const f32x4*)(args.in[16] + j * D + cc), x1 = *(const f32x4*)(args.in[16] + j * D + cc + 4);
#pragma unroll
                  for (int i = 0; i < 4; ++i) { w8[j][i] = x0[i]; w8[j][4 + i] = x1[i]; } }
              u32x4 rv[11];
#pragma unroll
              for (int q = 0; q < 11; ++q) { const int t = t0 + tr * 8 + q - 1; const bool ok = (t >= tb) && (t < tb + S);
                  rv[q] = ok ? *(const u32x4*)(REC + ((size_t)(t >> 8) * LB + nb_) * (256 * LBD) + (size_t)(t & 255) * LBD + cg * 8) : (u32x4){0u, 0u, 0u, 0u}; }
#pragma unroll
              for (int q = 0; q < 8; ++q) { float uo[8];
#pragma unroll
                  for (int i = 0; i < 8; ++i) { float acc_ = b8[i];
#pragma unroll
                      for (int j = 0; j < 4; ++j) { const unsigned w = rv[q + j][i >> 1]; acc_ += w8[j][i] * __uint_as_float((i & 1) ? (w & 0xffff0000u) : (w << 16)); }
                      uo[i] = acc_; }
                  u32x4 pk; pk.x = cvt_pk_bf16(uo[0], uo[1]); pk.y = cvt_pk_bf16(uo[2], uo[3]); pk.z = cvt_pk_bf16(uo[4], uo[5]); pk.w = cvt_pk_bf16(uo[6], uo[7]);
                  *(LAS u32x4*)(Us + SWZ(tr * 8 + q, cg * 16)) = pk; } }
            asm volatile("s_waitcnt lgkmcnt(0)" ::: "memory");
            bf16x8 uf[2][4]; const int ul = opaque_tid();
#pragma unroll
            for (int tg = 0; tg < 2; ++tg)
#pragma unroll
                for (int ks = 0; ks < 4; ++ks) uf[tg][ks] = *(const LAS bf16x8*)(Us + SWZ((ul >> 6) * 32 + tg * 16 + (ul & 15), 64 * ((ul >> 4) & 3) + 16 * ks));
#pragma unroll 1
            for (int dir = 0; dir < 2; ++dir) {
                __syncthreads();
                { const int stid = opaque_tid();
                  const bf16_t* wa = WB + WT_LRU + (size_t)(0 * 32 + dir * 16 + nb_) * LBD * LBD; const bf16_t* wx = WB + WT_LRU + (size_t)(1 * 32 + dir * 16 + nb_) * LBD * LBD;
#pragma unroll
                  for (int q = 0; q < 4; ++q) { const int idx = stid + q * NTHR, slot = idx >> 4, ch = idx & 15, row = 32 * ((slot & 15) >> 2) + 4 * (slot >> 4) + (slot & 3);
                      *(LAS u32x4*)(Ws + SWZ(slot, ch * 16)) = *(const u32x4*)(wa + row * LBD + ch * 8);
                      *(LAS u32x4*)(Ws + 32768 + SWZ(slot, ch * 16)) = *(const u32x4*)(wx + row * LBD + ch * 8); }
                  if (dir == 0) { for (int i = stid; i < 768; i += NTHR) { const int d_ = i / 384, k_ = (i >> 7) % 3, c_ = i & 127;
                      BL[i] = (k_ == 0) ? -L2E * args.in[19][d_ * D + c0 + c_] : (k_ == 1) ? -L2E * args.in[21][d_ * D + c0 + c_] : C8[d_ * D + c0 + c_]; } } }
                __syncthreads();
                f32x4 aa[2][8], ax[2][8]; const int ml = opaque_tid() & 63, mfr = ml & 15, mfq = ml >> 4;
#pragma unroll
                for (int nb = 0; nb < 8; ++nb) { aa[0][nb] = (f32x4){0.f, 0.f, 0.f, 0.f}; ax[0][nb] = aa[0][nb]; aa[1][nb] = aa[0][nb]; ax[1][nb] = aa[0][nb]; }
#pragma unroll
                for (int ks = 0; ks < 4; ++ks)
#pragma unroll
                    for (int nb = 0; nb < 8; ++nb) { const bf16x8 wfa = *(const LAS bf16x8*)(Ws + SWZ(nb * 16 + mfr, 64 * mfq + 16 * ks)), wfx = *(const LAS bf16x8*)(Ws + 32768 + SWZ(nb * 16 + mfr, 64 * mfq + 16 * ks));
                        aa[0][nb] = __builtin_amdgcn_mfma_f32_16x16x32_bf16(wfa, uf[0][ks], aa[0][nb], 0, 0, 0); ax[0][nb] = __builtin_amdgcn_mfma_f32_16x16x32_bf16(wfx, uf[0][ks], ax[0][nb], 0, 0, 0);
                        aa[1][nb] = __builtin_amdgcn_mfma_f32_16x16x32_bf16(wfa, uf[1][ks], aa[1][nb], 0, 0, 0); ax[1][nb] = __builtin_amdgcn_mfma_f32_16x16x32_bf16(wfx, uf[1][ks], ax[1][nb], 0, 0, 0); }
                const int l2 = opaque_tid() & 63, fr2 = l2 & 15, fq2 = l2 >> 4;
                const LAS float* blp = BL + dir * 384 + 32 * fq2;
                float sml[2][2], smh[2][2];
#pragma unroll
                for (int tg = 0; tg < 2; ++tg) {
#pragma unroll
                    for (int nb = 0; nb < 8; ++nb) {
                        const f32x4 ba = *(const LAS f32x4*)(blp + 4 * nb), bx = *(const LAS f32x4*)(blp + 128 + 4 * nb), c8 = *(const LAS f32x4*)(blp + 256 + 4 * nb);
                        const unsigned w0 = (unsigned)(unsigned short)uf[tg][nb >> 1][(nb & 1) * 4 + 0] | ((unsigned)(unsigned short)uf[tg][nb >> 1][(nb & 1) * 4 + 1] << 16);
                        const unsigned w1 = (unsigned)(unsigned short)uf[tg][nb >> 1][(nb & 1) * 4 + 2] | ((unsigned)(unsigned short)uf[tg][nb >> 1][(nb & 1) * 4 + 3] << 16);
                        const float uvv[4] = {__uint_as_float(w0 << 16), __uint_as_float(w0 & 0xffff0000u), __uint_as_float(w1 << 16), __uint_as_float(w1 & 0xffff0000u)};
                        float av[4], bv[4];
#pragma unroll
                        for (int i = 0; i < 4; ++i) { const float ga = __builtin_amdgcn_rcpf(1.f + __builtin_amdgcn_exp2f(fmaf(aa[tg][nb][i], -L2E, ba[i]))), gx = __builtin_amdgcn_rcpf(1.f + __builtin_amdgcn_exp2f(fmaf(ax[tg][nb][i], -L2E, bx[i])));
                            const float la2 = c8[i] * ga; const float a = __builtin_amdgcn_exp2f(la2);
                            av[i] = la2; bv[i] = __builtin_amdgcn_sqrtf(fmaxf(fmaf(-a, a, 1.f), 0.f)) * gx * uvv[i]; }
                        u32x2 pa, pb; pa.x = cvt_pk_bf16(av[0], av[1]); pa.y = cvt_pk_bf16(av[2], av[3]); pb.x = cvt_pk_bf16(bv[0], bv[1]); pb.y = cvt_pk_bf16(bv[2], bv[3]);
                        const int off = fr2 * 256 + (((4 * fq2 + (nb >> 1)) ^ fr2) << 4) + (nb & 1) * 8;
                        *(LAS u32x2*)(TB + off) = pa; *(LAS u32x2*)(TB + 4096 + off) = pb; }
                    asm volatile("s_waitcnt lgkmcnt(0)" ::: "memory");
#pragma unroll
                    for (int q = 0; q < 4; ++q) { const int row = 4 * q + fq2, chunk = fr2; const size_t go = (size_t)(wv * 32 + tg * 16 + row) * LBD + 8 * chunk;
                        const u32x4 va = *(const LAS u32x4*)(TB + row * 256 + ((chunk ^ row) << 4)), vb = *(const LAS u32x4*)(TB + 4096 + row * 256 + ((chunk ^ row) << 4));
                        *(u32x4*)(AB + (size_t)(unit * 4 + dir * 2 + 0) * (256 * LBD) + go) = va; *(u32x4*)(AB + (size_t)(unit * 4 + dir * 2 + 1) * (256 * LBD) + go) = vb; }
                    { float sl0 = 0.f, sl1 = 0.f, h0 = 0.f, h1 = 0.f; const int cc16 = (l2 >> 2) << 4, cin = (l2 & 3) * 4;
#pragma unroll
                      for (int i = 0; i < 16; ++i) { const int ri = dir ? 15 - i : i; const int ad = ri * 256 + (cc16 ^ (ri << 4)) + cin;
                          const unsigned wa_ = *(const LAS unsigned*)(TB + ad), wb_ = *(const LAS unsigned*)(TB + 4096 + ad);
                          const float la0 = __uint_as_float(wa_ << 16), la1 = __uint_as_float(wa_ & 0xffff0000u);
                          h0 = fmaf(__builtin_amdgcn_exp2f(la0), h0, __uint_as_float(wb_ << 16)); h1 = fmaf(__builtin_amdgcn_exp2f(la1), h1, __uint_as_float(wb_ & 0xffff0000u));
                          sl0 += la0; sl1 += la1; }
                      sml[tg][0] = sl0; sml[tg][1] = sl1; smh[tg][0] = h0; smh[tg][1] = h1; }
                }
                {
                  const int c = c0 + 2 * l2, b_ = t0 / S, chk = ((t0 & (S - 1)) >> 5) + wv;
                  f32x2 Pv, Hv;
#pragma unroll
                  for (int j = 0; j < 2; ++j) { const float A0 = __builtin_amdgcn_exp2f(sml[0][j]), A1 = __builtin_amdgcn_exp2f(sml[1][j]);
                      Pv[j] = __builtin_amdgcn_exp2f(sml[0][j] + sml[1][j]); Hv[j] = dir ? fmaf(A0, smh[1][j], smh[0][j]) : fmaf(A1, smh[0][j], smh[1][j]); }
                  float* sp = SUMM + ((size_t)((b_ * 2 + dir) * 128 + chk) * D) * 2 + (size_t)(c >> 2) * 8 + (c & 3);
                  *(f32x2*)sp = Pv; *(f32x2*)(sp + 4) = Hv; }
            }
        }
#undef SWZ
        __syncthreads();
    }
    SEAM(7);
    REP(9) if (IN(9)) {
        const int ptid = opaque_tid();
        const float* SUMM = (const float*)(ws + WS_SUMM); float* CARRY = (float*)(ws + WS_CARRY);
        for (int it = blockIdx.x * NTHR + ptid; it < NB * 2 * (D / 4) * 16; it += G * NTHR) {
            const int seg = it & 15, c4 = (it >> 4) % (D / 4), dir = ((it >> 4) / (D / 4)) % 2, b = (it >> 4) / (D / 4) / 2;
            f32x4 P[8], H[8];
#pragma unroll
            for (int j = 0; j < 8; ++j) { const int k = seg * 8 + j, ch = dir ? 127 - k : k; const size_t base = (size_t)((b * 2 + dir) * 128 + ch) * D + c4 * 4;
                P[j] = *(const f32x4*)(SUMM + base * 2); H[j] = *(const f32x4*)(SUMM + base * 2 + 4); }
            f32x4 A = P[0], Bv = H[0];
#pragma unroll
            for (int j = 1; j < 8; ++j) { Bv = P[j] * Bv + H[j]; A = A * P[j]; }
#pragma unroll
            for (int off = 1; off < 16; off <<= 1) { f32x4 Ap, Bp;
#pragma unroll
                for (int q = 0; q < 4; ++q) { Ap[q] = __shfl_up(A[q], off, 16); Bp[q] = __shfl_up(Bv[q], off, 16); }
                if (seg >= off) { Bv = A * Bp + Bv; A = A * Ap; } }
            f32x4 h;
#pragma unroll
            for (int q = 0; q < 4; ++q) h[q] = __shfl_up(Bv[q], 1, 16);
            if (seg == 0) h = (f32x4){0.f, 0.f, 0.f, 0.f};
#pragma unroll
            for (int j = 0; j < 8; ++j) { const int k = seg * 8 + j, ch = dir ? 127 - k : k; const size_t base = (size_t)((b * 2 + dir) * 128 + ch) * D + c4 * 4;
                *(f32x4*)(CARRY + base) = h; h = P[j] * h + H[j]; }
        }
    }
    SEAM(9);
    REP(10) if (IN(10)) {
        const int ptid = opaque_tid();
        const bf16_t* AB = (const bf16_t*)(ws + WS_AB); const float* CARRY = (const float*)(ws + WS_CARRY); const bf16_t* Y = (const bf16_t*)(ws + WS_Y); bf16_t* Z = (bf16_t*)(ws + WS_Z);
        for (int it = blockIdx.x * NTHR + ptid; it < NB * 128 * (D / 2); it += G * NTHR) {
            const int c2 = it % (D / 2), ch = (it / (D / 2)) % 128, b = it / (D / 2) / 128; const int c = c2 * 2;
            const bf16_t* af = AB + (size_t)((c >> 7) * 4) * (256 * LBD) + (c & 127); const bf16_t* bf = af + 256 * LBD; const bf16_t* ab = af + 2 * 256 * LBD; const bf16_t* bb = af + 3 * 256 * LBD;
#define LD2(p) ({ const unsigned _w = *(const unsigned*)(p); (f32x2){__uint_as_float(_w << 16), __uint_as_float(_w & 0xffff0000u)}; })
#define EXP2V(v) ((f32x2){__builtin_amdgcn_exp2f((v)[0]), __builtin_amdgcn_exp2f((v)[1])})
            f32x2 h = *(const f32x2*)(CARRY + (size_t)((b * 2 + 0) * 128 + ch) * D + c);
            LAS f32x2* hf = (LAS f32x2*)lds + ptid;
            const size_t o0 = (size_t)(b * S + ch * 32) * D; const int tk0 = b * S + ch * 32; const size_t q0 = (size_t)(tk0 >> 8) * (LB * 4 * 256 * LBD) + (size_t)(tk0 & 255) * LBD;
#pragma unroll 8
            for (int i = 0; i < 32; ++i) { const size_t o = q0 + (size_t)i * LBD; const f32x2 la = LD2(af + o); h = EXP2V(la) * h + LD2(bf + o); hf[i * NTHR] = h; }
            h = *(const f32x2*)(CARRY + (size_t)((b * 2 + 1) * 128 + ch) * D + c);
#pragma unroll 8
            for (int i = 31; i >= 0; --i) { const size_t o = o0 + (size_t)i * D, q = q0 + (size_t)i * LBD; const f32x2 la = LD2(ab + q); h = EXP2V(la) * h + LD2(bb + q);
                const unsigned yv = *(const unsigned*)(Y + o + c); const float y0 = __uint_as_float(yv << 16), y1 = __uint_as_float(yv & 0xffff0000u);
                const f32x2 hv = hf[i * NTHR];
                *(unsigned*)(Z + o + c) = cvt_pk_bf16(y0 * (hv[0] + h[0]), y1 * (hv[1] + h[1])); }
#undef LD2
#undef EXP2V
        }
    }
    SEAM(10);
    REP(11) if (IN(11)) {
        Gemm g{(const bf16_t*)(ws + WS_Z), WB + WT_OUT1, D, D, 0}; StaticOrder So; So.init(T, D, G, (int)blockIdx.x);
        EpiResid E{(const float*)(ws + WS_X2), (float*)(ws + WS_X1), (bf16_t*)(ws + WS_XB), PART + 24 * T, PL, nullptr, 1.f};
        gemm_phase<EpiResid, StaticOrder, 0, false>(lds, g, So, E);
    }
    SEAM(11);
    REP(12) if (IN(12)) { PHASE_IDS();
        const float* X3 = (const float*)(ws + WS_X1); const float* P3 = PART + 24 * T; const float* gn = args.in[24]; const float* rw = args.in[25];
        int* LIST = (int*)(ws + WS_LIST); int* INV = (int*)(ws + WS_INV); float* GATEW = (float*)(ws + WS_GATEW); unsigned* CNT = ctl + CW_CNT;
        volatile LAS int* sel = (volatile LAS int*)(lds + MISC_OFF + 8192);
        unsigned char* XN8 = (unsigned char*)(ws + WS_HA);
        LAS float* RT = (LAS float*)lds;
        f32x4 xr[8], xq[8];
        if ((int)blockIdx.x * 32 < T) {
#pragma unroll
            for (int j = 0; j < 8; ++j) xr[j] = *(const f32x4*)(X3 + (size_t)(blockIdx.x * 32 + wave * 4) * D + lane * 4 + 256 * j); }
        __syncthreads();
        for (int idx = tid; idx < D * 2; idx += NTHR) { const int c = idx >> 1, hf = idx & 1, slot = ((c >> 8) * 4 + (c & 3)) * 64 + ((c & 255) >> 2);
            *(LAS f32x4*)(RT + slot * 8 + hf * 4) = *(const f32x4*)(rw + (size_t)c * NE + hf * 4) * gn[c]; }
        __syncthreads();
        for (int t0 = blockIdx.x * 32; t0 < T; t0 += G * 32) {
            if (t0 != (int)blockIdx.x * 32) {
#pragma unroll
                for (int j = 0; j < 8; ++j) xr[j] = *(const f32x4*)(X3 + (size_t)(t0 + wave * 4) * D + lane * 4 + 256 * j); }
#pragma unroll 1
            for (int q = 0; q < 4; ++q) { const int tl = wave * 4 + q, t = t0 + tl;
                if (q < 3) {
#pragma unroll
                    for (int j = 0; j < 8; ++j) xq[j] = *(const f32x4*)(X3 + (size_t)(t + 1) * D + lane * 4 + 256 * j); }
                const float rstd = row_rstd(P3, t); float lg[NE];
#pragma unroll
                for (int e = 0; e < NE; ++e) lg[e] = 0.f;
#pragma unroll
                for (int j = 0; j < 8; ++j) { const int c0 = lane * 4 + 256 * j; const f32x4 xv = xr[j] * rstd;
                    *(unsigned*)(XN8 + (size_t)t * D + c0) = pk4_fp8(xv[0], xv[1], xv[2], xv[3]);
#pragma unroll
                    for (int i = 0; i < 4; ++i) { const float hv = xv[i]; const LAS float* rp = RT + ((j * 4 + i) * 64 + lane) * 8; const f32x4 r0 = *(const LAS f32x4*)rp, r1 = *(const LAS f32x4*)(rp + 4);
                        lg[0] += hv * r0[0]; lg[1] += hv * r0[1]; lg[2] += hv * r0[2]; lg[3] += hv * r0[3]; lg[4] += hv * r1[0]; lg[5] += hv * r1[1]; lg[6] += hv * r1[2]; lg[7] += hv * r1[3]; } }
#pragma unroll
                for (int e = 0; e < NE; ++e) lg[e] = wave_sum(lg[e]);
                int i1 = 0; float v1 = lg[0];
#pragma unroll
                for (int e = 1; e < NE; ++e) if (lg[e] > v1) { v1 = lg[e]; i1 = e; }
                int i2 = -1; float v2 = -3.0e38f;
#pragma unroll
                for (int e = 0; e < NE; ++e) if (e != i1 && lg[e] > v2) { v2 = lg[e]; i2 = e; }
                const float e2 = __expf(v2 - v1), g1 = 1.f / (1.f + e2), g2 = e2 / (1.f + e2);
                if (lane == 0) { sel[2 * tl] = i1; sel[2 * tl + 1] = i2; GATEW[2 * t] = g1; GATEW[2 * t + 1] = g2; }
#pragma unroll
                for (int j = 0; j < 8; ++j) xr[j] = xq[j];
            }
            __syncthreads();
            if (tid < NE) { int n = 0; for (int a = 0; a < 64; ++a) n += (sel[a] == tid) ? 1 : 0;
                sel[64 + tid] = n ? (int)__hip_atomic_fetch_add(CNT + tid, (unsigned)n, __ATOMIC_RELAXED, __HIP_MEMORY_SCOPE_AGENT) : 0; }
            __syncthreads();
            if (tid < 64) { const int e = sel[tid]; int rank = 0; for (int a = 0; a < tid; ++a) rank += (sel[a] == e) ? 1 : 0;
                const int ent = 2 * (t0 + (tid >> 1)) + (tid & 1), pos = sel[64 + e] + rank; LIST[e * T + pos] = ent; INV[ent] = e * T + pos; }
            __syncthreads();
        }
    }
    SEAM(12);
    if (IN(13) || IN(14)) {
        volatile LAS int* tab = (volatile LAS int*)(lds + MISC_OFF + 12288);
        if (tid < NE) tab[tid] = (int)__hip_atomic_load(ctl + CW_CNT + tid, __ATOMIC_RELAXED, __HIP_MEMORY_SCOPE_AGENT);
        __syncthreads();
        if (tid == 0) { int p = 0; for (int e = 0; e < NE; ++e) { tab[8 + e] = p; p += (tab[e] + BM - 1) / BM; } tab[16] = p; }
        __syncthreads();
        REP(13) if (IN(13)) {
            Gemm g{(const bf16_t*)(ws + WS_HA), WB + WT_MGU, 2 * FF, D, (size_t)2 * FF * D}; MoeOrder Mo; Mo.init(tab, (const int*)(ws + WS_LIST), 2 * FF / BM, G, (int)blockIdx.x);
            EpiGateUp<true> E{(bf16_t*)(ws + WS_MACT), PART + 24 * T, (const int*)(ws + WS_LIST)};
            gemm_phase<EpiGateUp<true>, MoeOrder, 1, true, true>(lds, g, Mo, E);
        }
        SEAM(13);
        REP(14) if (IN(14)) {
            Gemm g{(const bf16_t*)(ws + WS_MACT), WB + WT_MDN, D, FF, (size_t)FF * D}; MoeOrder Mo; Mo.init(tab, (const int*)(ws + WS_LIST), D / BM, G, (int)blockIdx.x); Mo.ksplit = (G == 256 && Mo.nwg >= 2 * G) ? 1 : 0; Mo.KT4 = FF / 128 / 4;
            EpiMoeDown E{(bf16_t*)(ws + WS_CONTRIB), (const int*)(ws + WS_LIST), (const float*)(ws + WS_GATEW), (float*)(ws + WS_PARTK)};
            gemm_phase<EpiMoeDown, MoeOrder, 0, false, true>(lds, g, Mo, E);
        }
    }
    SEAM(14);
    REP(15) if (IN(15)) { PHASE_IDS();
        const float* X3 = (const float*)(ws + WS_X1); const bf16_t* C = (const bf16_t*)(ws + WS_CONTRIB); const float* gn = args.in[29];
        const int* INV = (const int*)(ws + WS_INV); const float* GATEW = (const float*)(ws + WS_GATEW); const float* PARTK = (const float*)(ws + WS_PARTK);
        volatile LAS int* tab = (volatile LAS int*)(lds + MISC_OFF + 12288);
        __syncthreads();
        if (tid < NE) tab[tid] = (int)__hip_atomic_load(ctl + CW_CNT + tid, __ATOMIC_RELAXED, __HIP_MEMORY_SCOPE_AGENT);
        __syncthreads();
        if (tid == 0) { int p = 0; for (int e = 0; e < NE; ++e) { tab[8 + e] = p; p += (tab[e] + BM - 1) / BM; } tab[16] = p; }
        __syncthreads();
        const int nwg = __builtin_amdgcn_readfirstlane(tab[16]) * (D / BM); const bool ksplit = (G == 256 && nwg >= 2 * G);
        const int cq = nwg / NXCD, cr = nwg % NXCD, cb_ = cr * (cq + 1);
        for (int t = gw; t < T; t += NGW) { f32x4 v[8]; float ss = 0.f;
            u32x2 ca[2][8];
#pragma unroll
            for (int j = 0; j < 8; ++j) { v[j] = *(const f32x4*)(X3 + (size_t)t * D + lane * 4 + 256 * j);
                ca[0][j] = *(const u32x2*)(C + (size_t)(2 * t) * D + lane * 4 + 256 * j); ca[1][j] = *(const u32x2*)(C + (size_t)(2 * t + 1) * D + lane * 4 + 256 * j); }
            unsigned smask = 0u;
            int ridx_[2][8]; int lr_[2] = {0, 0}; float gw8_[2] = {0.f, 0.f};
            if (ksplit) {
#pragma unroll
                for (int k = 0; k < 2; ++k) { const int ent = 2 * t + k; const int inv = __builtin_amdgcn_readfirstlane(INV[ent]); const int e = inv >> 13, li = inv & (T - 1);
                    const int p0 = __builtin_amdgcn_readfirstlane(tab[8 + e]), npan = __builtin_amdgcn_readfirstlane(tab[9 + e]) - p0, pl = li >> 8; lr_[k] = li & 255; gw8_[k] = GATEW[ent] * W8_INV;
#pragma unroll
                    for (int j = 0; j < 8; ++j) { const int wg = p0 * (D / BM) + j * npan + pl; int x, off;
                        if (wg < cb_) { x = wg / (cq + 1); off = wg - x * (cq + 1); } else { const int w2 = wg - cb_; x = w2 / cq; off = w2 - x * cq; x += cr; }
                        ridx_[k][j] = (off - 2 * G / NXCD) * NXCD + x; if (off >= 2 * G / NXCD) smask |= 1u << (k * 8 + j); } } }
#pragma unroll
            for (int k = 0; k < 2; ++k)
#pragma unroll
                for (int j = 0; j < 8; ++j) { const u32x2 c2 = ca[k][j];
                    const f32x4 cv = {__uint_as_float(c2.x << 16), __uint_as_float(c2.x & 0xffff0000u), __uint_as_float(c2.y << 16), __uint_as_float(c2.y & 0xffff0000u)};
                    if (!((smask >> (k * 8 + j)) & 1u)) v[j] = v[j] + cv; }
            if (smask) {
#pragma unroll
                for (int k = 0; k < 2; ++k)
#pragma unroll
                    for (int j = 0; j < 8; ++j) if ((smask >> (k * 8 + j)) & 1u) { const float* pp = PARTK + ((size_t)(ridx_[k][j] * 4) << 16) + lr_[k] * BM + lane * 4;
                        const f32x4 sm = (*(const f32x4*)pp + *(const f32x4*)(pp + 65536)) + (*(const f32x4*)(pp + 2 * 65536) + *(const f32x4*)(pp + 3 * 65536));
                        v[j] = v[j] + sm * gw8_[k]; } }
#pragma unroll
            for (int j = 0; j < 8; ++j) ss += (v[j][0] * v[j][0] + v[j][1] * v[j][1]) + (v[j][2] * v[j][2] + v[j][3] * v[j][3]);
            ss = wave_sum(ss); const float rs = rsqrtf(ss * (1.0f / D) + EPS);
#pragma unroll
            for (int j = 0; j < 8; ++j) { const int c0 = lane * 4 + 256 * j; *(f32x4*)(args.out + (size_t)t * D + c0) = v[j] * rs * *(const f32x4*)(gn + c0); } }
    }
#undef IN
#undef SEAM
}

static int g_grid = 0;
static void mega_launch(hipStream_t st, const float* const* in, float* out, unsigned char* ws, int lo, int hi) {
    MArgs a{};
    for (int i = 0; i < 30; ++i) a.in[i] = in[i];
    a.out = out; a.ws = ws; a.ph_lo = lo; a.ph_hi = hi;
    hipLaunchKernelGGL(mega, dim3(g_grid), dim3(NTHR), LDS_BYTES, st, a);
}

extern "C" void kernel_launch(void* const* d_in, const int* in_sizes, int n_in, void* d_out, int out_size, void* d_ws, size_t ws_size, hipStream_t stream) {
    if (n_in != 30 || out_size != T * D || ws_size < WS_END2) { fprintf(stderr, "kernel_launch: unexpected shapes n_in %d out %d ws %zu (need %zu)\n", n_in, out_size, ws_size, (size_t)WS_END); return; }
    const float* const* in = (const float* const*)d_in;
    unsigned char* ws = (unsigned char*)d_ws;
    if (g_grid == 0) {
        int dev = 0, cus = 0;
        if (hipGetDevice(&dev) != hipSuccess || hipDeviceGetAttribute(&cus, hipDeviceAttributeMultiprocessorCount, dev) != hipSuccess) { fprintf(stderr, "kernel_launch: device query failed\n"); return; }
        if (hipFuncSetAttribute((const void*)mega, hipFuncAttributeMaxDynamicSharedMemorySize, LDS_BYTES) != hipSuccess) { fprintf(stderr, "kernel_launch: hipFuncSetAttribute failed\n"); return; }
        int per_cu = 0;
        if (hipOccupancyMaxActiveBlocksPerMultiprocessor(&per_cu, (const void*)mega, NTHR, LDS_BYTES) != hipSuccess || per_cu < 1) { fprintf(stderr, "kernel_launch: occupancy query says %d\n", per_cu); (void)hipGetLastError(); }
        g_grid = cus;
    }
    (void)hipMemsetAsync(ws + WS_CTL, 0, CTL_BYTES, stream);
    mega_launch(stream, in, (float*)d_out, ws, 0, 16);
}
```

```cpp
#include <hip/hip_runtime.h>
#include <stdint.h>
#include <stdio.h>

typedef unsigned short bf16_t;
typedef short bf16x8 __attribute__((ext_vector_type(8)));
typedef float f32x4 __attribute__((ext_vector_type(4)));

constexpr int NB = 2, S = 4096, T = NB * S, D = 2048;
constexpr int HD = 128, NAH = 8, DAH = 8, DQ = 64;
constexpr int GW = 64, GR = S / GW, KH = 8, KW = 16;
constexpr int INC = 6144, FF = 7168, NE = 8;
constexpr int LB = 16, LBD = 128;
constexpr float EPS = 1e-6f;

constexpr size_t MiB = 1048576;
constexpr size_t WS_WBF = 0;
constexpr size_t WS_X1 = 816 * MiB;
constexpr size_t WS_X2 = WS_X1 + 64 * MiB;
constexpr size_t WS_HA = WS_X2 + 64 * MiB;
constexpr size_t WS_HB = WS_HA + 32 * MiB;
constexpr size_t WS_R1 = WS_HB + 32 * MiB;
constexpr size_t WS_QKV = WS_R1;
constexpr size_t WS_ATT = WS_R1 + 96 * MiB;
constexpr size_t WS_ACT = WS_R1 + 128 * MiB;
constexpr size_t WS_AB = WS_R1;
constexpr size_t WS_R2 = WS_R1 + 256 * MiB;
constexpr size_t WS_Y = WS_R2;
constexpr size_t WS_REC = WS_R2 + 32 * MiB;
constexpr size_t WS_U = WS_R2 + 96 * MiB;
constexpr size_t WS_Z = WS_R2 + 160 * MiB;
constexpr size_t WS_R3 = WS_R2 + 192 * MiB;
constexpr size_t WS_HF = WS_R3;
constexpr size_t WS_HBW = WS_R3 + 64 * MiB;
constexpr size_t WS_MISC = WS_R3 + 128 * MiB;
constexpr size_t WS_ROPE = WS_MISC;
constexpr size_t WS_COMB = WS_MISC + 1 * MiB;
constexpr size_t WS_C8SP = WS_COMB + 768 * 1024;
constexpr size_t WS_LIST = WS_COMB + 256 * 1024;
constexpr size_t WS_GATEW = WS_COMB + 512 * 1024;
constexpr size_t WS_MACT = WS_R1;
constexpr size_t WS_PARTK = WS_R1 + 128 * MiB;
constexpr size_t WS_INV = WS_COMB + 576 * 1024;
constexpr size_t WS_CONTRIB = WS_R2;
constexpr size_t WS_END = WS_MISC + 2 * MiB;

__device__ __forceinline__ bf16_t f2bf(float f) { unsigned u = __float_as_uint(f); u += 0x7FFFu + ((u >> 16) & 1u); return (bf16_t)(u >> 16); }
__device__ __forceinline__ float bf2f(bf16_t b) { return __uint_as_float(((unsigned)b) << 16); }
__device__ __forceinline__ float wave_sum(float v) {
#pragma unroll
    for (int o = 1; o < 64; o <<= 1) v += __shfl_xor(v, o);
    return v;
}
__device__ __forceinline__ float wave_max(float v) {
#pragma unroll
    for (int o = 1; o < 64; o <<= 1) v = fmaxf(v, __shfl_xor(v, o));
    return v;
}
__device__ __forceinline__ float sigmoidf_(float x) { return 1.f / (1.f + expf(-x)); }
__device__ __forceinline__ float siluf_(float x) { return x / (1.f + expf(-x)); }
__device__ __forceinline__ float gelu_tanh(float x) { const float u = 0.7978845608028654f * (x + 0.044715f * x * x * x); return 0.5f * x * (1.f + tanhf(u)); }

#define LAS __attribute__((address_space(3)))
#define GAS __attribute__((address_space(1)))
typedef unsigned u32x4 __attribute__((ext_vector_type(4)));
typedef unsigned u32x2 __attribute__((ext_vector_type(2)));
typedef float f32x2 __attribute__((ext_vector_type(2)));
constexpr int NWAVES = 8, NTHR = 512;
constexpr int BM = 256, BK = 64, HALF = 128, HTB = HALF * BK * 2, STAGE_BYTES = 8 * HTB, NXCD = 8, WGM = 8;
constexpr int MISC_OFF = STAGE_BYTES, LDS_BYTES = STAGE_BYTES + 16384;
constexpr size_t WT_IN0 = 0;
constexpr size_t WT_OUT0 = WT_IN0 + (size_t)INC * D;
constexpr size_t WT_GU0 = WT_OUT0 + (size_t)D * D;
constexpr size_t WT_DN0 = WT_GU0 + (size_t)2 * FF * D;
constexpr size_t WT_IN1 = WT_DN0 + (size_t)FF * D;
constexpr size_t WT_OUT1 = WT_IN1 + (size_t)2 * D * D;
constexpr size_t WT_LRU = WT_OUT1 + (size_t)D * D;
constexpr size_t WT_MGU = WT_LRU + (size_t)2 * 2 * LB * LBD * LBD;
constexpr size_t WT_MDN = WT_MGU + (size_t)NE * 2 * FF * D;
constexpr size_t WT_END = WT_MDN + (size_t)NE * FF * D;
static_assert(WT_END * 2 <= 816 * MiB, "weights region");
constexpr size_t WS_CTL = WS_END;
constexpr size_t CTL_BYTES = 256 * 1024;
constexpr int CW_BAR = 0;
constexpr int CW_CNT = 4096;
constexpr int CW_XRANK = 8192;
constexpr int CW_AQ = 8192 + 1024;
#define CW_CVQ (8192 + 2048)
#ifndef NCV_PER_XCD
#define NCV_PER_XCD 16
#endif
constexpr size_t WS_XB = WS_CTL + CTL_BYTES;
constexpr size_t WS_PART = WS_XB + 32 * MiB;
constexpr size_t WS_SUMM = WS_PART + 1 * MiB;
constexpr size_t WS_CARRY = WS_SUMM + 8 * MiB;
constexpr size_t WS_END2 = WS_CARRY + 4 * MiB;

__device__ __forceinline__ int opaque_tid() { int t = threadIdx.x; asm volatile("" : "+v"(t)); return t; }
__device__ __forceinline__ float sat8(float x) { return __builtin_amdgcn_fmed3f(x, -448.f, 448.f); }
__device__ __forceinline__ unsigned pk4_fp8(float a, float b, float c, float d) { unsigned w = 0; w = __builtin_amdgcn_cvt_pk_fp8_f32(sat8(a), sat8(b), w, false); w = __builtin_amdgcn_cvt_pk_fp8_f32(sat8(c), sat8(d), w, true); return w; }
constexpr float W8_SCALE = 64.f, W8_INV = 1.f / 64.f;
#ifndef FFN_GU8
#define FFN_GU8 1
#endif
#ifndef FFN_DN8
#define FFN_DN8 1
#endif
constexpr bool FFNGU8 = FFN_GU8, FFNDN8 = FFN_DN8;
#define XB_TMO      128
#define XB_XCNT(j)  (256  + 64 * (j))
#define XB_XSUB(j)  (1280 + 64 * (j))
#define XB_XGEN(j)  (2304 + 64 * (j))
#define XB_TOP      3328
#define XB_TOPGEN   3392
#define XCD_BAR_WORDS 3456
#define XB_SPIN_CAP (1u << 18)
__device__ __forceinline__ unsigned xb_ld(unsigned* p)              { return __hip_atomic_load(p, __ATOMIC_RELAXED, __HIP_MEMORY_SCOPE_AGENT); }
__device__ __forceinline__ unsigned xb_add(unsigned* p, unsigned v) { return __hip_atomic_fetch_add(p, v, __ATOMIC_RELAXED, __HIP_MEMORY_SCOPE_AGENT); }
__device__ __forceinline__ unsigned xb_xcc_id() { return (unsigned)__builtin_amdgcn_s_getreg((3 << 11) | 20) & 0xFu; }
#define XB_SPIN(cond, bar) do { unsigned _sp = 0; while (cond) { __builtin_amdgcn_s_sleep(1); \
    if ((++_sp & 255u) == 0u) { if (xb_ld(&(bar)[XB_TMO])) break; if (_sp > XB_SPIN_CAP) { atomicAdd(&(bar)[XB_TMO], 1u); break; } } } } while (0)
struct XcdBarrier { unsigned* bar; unsigned x; volatile LAS unsigned* st; };
__device__ __forceinline__ XcdBarrier xcd_barrier_post(unsigned* bar, volatile LAS unsigned* st) {
    XcdBarrier b; b.bar = bar; b.x = xb_xcc_id(); b.st = st;
    if (threadIdx.x == 0) (void)xb_add(&bar[XB_XCNT(b.x)], 1u);
    return b;
}
__device__ __forceinline__ void xcd_barrier_complete(unsigned* bar, unsigned x, unsigned& nloc, unsigned& nx) {
    const unsigned G = gridDim.x * gridDim.y * gridDim.z;
    unsigned sum, cnt, mine, sp = 0u;
    for (;;) {
        sum = 0u; cnt = 0u; mine = 0u;
#pragma unroll
        for (unsigned j = 0; j < 16; ++j) { const unsigned c = xb_ld(&bar[XB_XCNT(j)]); sum += c; cnt += (c > 0u) ? 1u : 0u; mine = (j == x) ? c : mine; }
        if (sum == G) break;
        __builtin_amdgcn_s_sleep(1);
        if ((++sp & 255u) == 0u) { if (xb_ld(&bar[XB_TMO])) break; if (sp > XB_SPIN_CAP) { atomicAdd(&bar[XB_TMO], 1u); break; } }
    }
    nloc = mine > 0u ? mine : 1u; nx = cnt > 0u ? cnt : 1u;
}
__device__ __forceinline__ void xcd_barrier(const XcdBarrier& b) {
    asm volatile("s_waitcnt vmcnt(0)" ::: "memory");
    __syncthreads();
    if (threadIdx.x == 0) {
        unsigned* bar = b.bar;
        __builtin_amdgcn_s_waitcnt(0);
        unsigned nloc = b.st[0], nx = b.st[1];
        if (nloc == 0u) { xcd_barrier_complete(bar, b.x, nloc, nx); b.st[0] = nloc; b.st[1] = nx; }
        const unsigned old = xb_add(&bar[XB_XSUB(b.x)], 1u);
        const unsigned gen = old / nloc;
        if (old + 1u == (gen + 1u) * nloc) {
            __builtin_amdgcn_fence(__ATOMIC_RELEASE, "agent");
            asm volatile("s_waitcnt vmcnt(0)" ::: "memory");
            const unsigned og = xb_add(&bar[XB_TOP], 1u);
            const unsigned tg = og / nx;
            if (og + 1u == (tg + 1u) * nx) xb_add(&bar[XB_TOPGEN], 1u);
            else XB_SPIN(xb_ld(&bar[XB_TOPGEN]) == tg, bar);
            __builtin_amdgcn_fence(__ATOMIC_ACQUIRE, "agent");
            xb_add(&bar[XB_XGEN(b.x)], 1u);
            asm volatile("s_waitcnt vmcnt(0)" ::: "memory");
        } else {
            XB_SPIN(xb_ld(&bar[XB_XGEN(b.x)]) == gen, bar);
            __builtin_amdgcn_fence(__ATOMIC_ACQUIRE, "agent");
            asm volatile("s_waitcnt vmcnt(0)" ::: "memory");
        }
    }
    __syncthreads();
}

__host__ __device__ __forceinline__ int lds_byte(int r, int c) { const int st = (r >> 4) * 2 + (c >> 5), rr = r & 15, cc = c & 31, ob = rr * 64 + cc * 2; return st * 1024 + (ob ^ (((ob >> 9) & 1) << 5)); }
__host__ __device__ __forceinline__ void stage_rc(int b, int& R, int& C) { const int st = b / 1024, sb = b % 1024, swz = sb ^ (((sb >> 9) & 1) << 5); R = (st >> 1) * 16 + swz / 64; C = (st & 1) * 32 + (swz % 64) / 2; }
__host__ __device__ __forceinline__ int perm32(int rho) { const int n = rho >> 4, i = rho & 15; return 8 * (i >> 2) + 4 * n + (i & 3); }
__device__ __forceinline__ unsigned cvt_pk_bf16(float lo, float hi) { unsigned r; asm volatile("v_cvt_pk_bf16_f32 %0, %1, %2" : "=v"(r) : "v"(lo), "v"(hi)); return r; }

struct Unit { int pm, pn, e, r0, cnt, k0, nkt, kq, ridx; };
struct Gemm { const bf16_t* A; const bf16_t* Bt; int N, K; size_t bstride; };

struct StaticOrder {
    int nM, nN, nwg, G, c;
    __device__ void init(int M, int N, int G_, int c_) { nM = M / BM; nN = N / BM; nwg = nM * nN; G = G_; c = c_; }
    __device__ bool next(int i, Unit& u) const {
        const long L = (long)i * G + c; if (L >= nwg) return false;
        int wgid = (int)L; { const int q = nwg / NXCD, r = nwg % NXCD, xcd = wgid % NXCD, off = wgid / NXCD; wgid = (xcd < r ? xcd * (q + 1) : r * (q + 1) + (xcd - r) * q) + off; }
        const int nig = WGM * nN, gid = wgid / nig, fm = gid * WGM, gsz = (nM - fm) < WGM ? (nM - fm) : WGM;
        u.pm = fm + ((wgid % nig) % gsz); u.pn = (wgid % nig) / gsz; u.e = 0; u.r0 = 0; u.cnt = 0; u.k0 = 0; u.nkt = 0; u.kq = -1; u.ridx = 0; return true;
    }
    __device__ __forceinline__ int arow(const Unit& u, int lr) const { return u.pm * BM + lr; }
};

typedef int i32x8 __attribute__((ext_vector_type(8)));
typedef int i32x4 __attribute__((ext_vector_type(4)));
template <class Epi, class Sched, int BL, bool GATHER, bool F8 = false>
__device__ __forceinline__ void gemm_phase(LAS unsigned char* lds, const Gemm g, const Sched& S, const Epi& E) {
    const int tid = opaque_tid(), wid = __builtin_amdgcn_readfirstlane(tid >> 6), lane = tid & 63, wr = wid >> 2, wc = wid & 3, fr = lane & 15, fq = lane >> 4;
    constexpr int ESZ = F8 ? 1 : 2;
    const int K = g.K, KB = K * ESZ, nt = KB / 128;
    unsigned voffA[2], voffB[2], CA[2]; int RA[2];
#pragma unroll
    for (int i = 0; i < 2; ++i) { int R, C; stage_rc(tid * 16 + i * 8192, R, C); RA[i] = R; CA[i] = (unsigned)C * 2u;
        int Rb = R; if (BL >= 1) Rb = (R & ~31) + perm32(R & 31); if (BL == 2) Rb = 64 * (Rb >> 5) + (Rb & 31);
        voffA[i] = (unsigned)(R * KB) + (unsigned)C * 2u; voffB[i] = (unsigned)(Rb * 128) + (unsigned)C * 2u; }
    const size_t kstep = 128, kstepB = 256 * 128;
    const size_t hstep = (size_t)HALF * KB;
    const size_t hstepB = (BL == 2) ? (size_t)32 * 128 : (size_t)HALF * 128;
    const size_t tstep = 2 * hstep;
    const unsigned ldsw = (unsigned)wid * 1024u;
    const int aoff = F8 ? lds_byte(wr * 64 + fr, fq * 16) : lds_byte(wr * 64 + fr, fq * 8), boff = F8 ? lds_byte(wc * 32 + fr, fq * 16) : lds_byte(wc * 32 + fr, fq * 8);
#define PG8_SA(b, h) (((b) * 2 + (h)) * HTB)
#define PG8_SB(b, h) ((4 + (b) * 2 + (h)) * HTB)
#define PG8_STAGE(bufoff, gbase, voff) do { _Pragma("unroll") for (int _i = 0; _i < 2; ++_i) \
        __builtin_amdgcn_global_load_lds((const unsigned*)((const char*)(gbase) + (voff)[_i]), (LAS unsigned*)(lds + (bufoff) + ldsw + _i * 8192), 16, 0, 0); } while (0)
#define PG8_LDA(b, h) do { if constexpr (F8) { _Pragma("unroll") for (int m = 0; m < 4; ++m) { const i32x4 lo_ = *(const LAS i32x4*)(lds + PG8_SA(b, h) + aoff + m * 2048), hi_ = *(const LAS i32x4*)(lds + PG8_SA(b, h) + aoff + m * 2048 + 16); \
            At8[m] = (i32x8){lo_[0], lo_[1], lo_[2], lo_[3], hi_[0], hi_[1], hi_[2], hi_[3]}; } } \
        else { _Pragma("unroll") for (int m = 0; m < 4; ++m) _Pragma("unroll") for (int k = 0; k < 2; ++k) At[m][k] = *(const LAS bf16x8*)(lds + PG8_SA(b, h) + aoff + m * 2048 + k * 1024); } } while (0)
#define PG8_LDB(w, b, h) do { if constexpr (F8) { _Pragma("unroll") for (int n = 0; n < 2; ++n) { const i32x4 lo_ = *(const LAS i32x4*)(lds + PG8_SB(b, h) + boff + n * 2048), hi_ = *(const LAS i32x4*)(lds + PG8_SB(b, h) + boff + n * 2048 + 16); \
            Bq8[w][n] = (i32x8){lo_[0], lo_[1], lo_[2], lo_[3], hi_[0], hi_[1], hi_[2], hi_[3]}; } } \
        else { _Pragma("unroll") for (int n = 0; n < 2; ++n) _Pragma("unroll") for (int k = 0; k < 2; ++k) Bq[w][n][k] = *(const LAS bf16x8*)(lds + PG8_SB(b, h) + boff + n * 2048 + k * 1024); } } while (0)
#define PG8_MMA(ai, bj) do { __builtin_amdgcn_s_setprio(1); if constexpr (F8) { _Pragma("unroll") for (int m = 0; m < 4; ++m) _Pragma("unroll") for (int n = 0; n < 2; ++n) \
            asm volatile("v_mfma_scale_f32_16x16x128_f8f6f4 %0, %1, %2, %0, %3, %3 op_sel_hi:[0,0,0]" : "+v"(acc[ai][bj][m][n]) : "v"(Bq8[bj][n]), "v"(At8[m]), "v"(sc8)); } \
        else { _Pragma("unroll") for (int m = 0; m < 4; ++m) _Pragma("unroll") for (int n = 0; n < 2; ++n) _Pragma("unroll") for (int k = 0; k < 2; ++k) \
            acc[ai][bj][m][n] = __builtin_amdgcn_mfma_f32_16x16x32_bf16(Bq[bj][n][k], At[m][k], acc[ai][bj][m][n], 0, 0, 0); } __builtin_amdgcn_s_setprio(0); } while (0)
#define PG8_WAIT_V(n) asm volatile("s_waitcnt vmcnt(" #n ")" ::: "memory")
#define PG8_WAIT_L(n) asm volatile("s_waitcnt lgkmcnt(" #n ")" ::: "memory")
#define PG8_BAR __builtin_amdgcn_s_barrier()
#define PG8_SCHED __builtin_amdgcn_sched_barrier(0)
    Unit cur, nxt; int ui = 0;
    if (!S.next(0, cur)) return;
    f32x4 acc[2][2][4][2];
#pragma unroll
    for (int a = 0; a < 2; ++a)
#pragma unroll
        for (int b = 0; b < 2; ++b)
#pragma unroll
            for (int m = 0; m < 4; ++m)
#pragma unroll
                for (int n = 0; n < 2; ++n) acc[a][b][m][n] = (f32x4){0.f, 0.f, 0.f, 0.f};
    bf16x8 At[4][2], Bq[2][2][2]; i32x8 At8[4], Bq8[2][2]; const int sc8 = 0x7f7f7f7f;
    unsigned oA0[2], oA1[2], nA0[2], nA1[2];
    const char* cA; const char* cB = (const char*)g.Bt + ((size_t)cur.e * g.bstride + (size_t)cur.pn * BM * K) * ESZ + (size_t)cur.k0 * kstepB;
    if constexpr (GATHER) { cA = (const char*)g.A + (size_t)cur.k0 * 128;
#pragma unroll
        for (int i = 0; i < 2; ++i) { oA0[i] = (unsigned)S.arow(cur, RA[i]) * (unsigned)KB + CA[i]; oA1[i] = (unsigned)S.arow(cur, HALF + RA[i]) * (unsigned)KB + CA[i]; }
    } else { cA = (const char*)g.A + (size_t)cur.pm * tstep + (size_t)cur.k0 * 128;
#pragma unroll
        for (int i = 0; i < 2; ++i) { oA0[i] = voffA[i]; oA1[i] = voffA[i] + (unsigned)hstep; } }
#pragma unroll
    for (int i = 0; i < 2; ++i) { nA0[i] = oA0[i]; nA1[i] = oA1[i]; }
    PG8_STAGE(PG8_SB(0, 0), cB, voffB); PG8_STAGE(PG8_SB(0, 1), cB + hstepB, voffB); PG8_STAGE(PG8_SA(0, 0), cA, oA0); PG8_STAGE(PG8_SA(0, 1), cA, oA1);
    if (wr == 1) PG8_BAR;
    PG8_WAIT_V(2); PG8_BAR;
    PG8_STAGE(PG8_SB(1, 0), cB + kstepB, voffB); PG8_STAGE(PG8_SA(1, 0), cA + kstep, oA0); PG8_STAGE(PG8_SB(1, 1), cB + hstepB + kstepB, voffB);
    PG8_WAIT_V(6); PG8_BAR;
    for (;;) {
        const bool has_next = S.next(ui + 1, nxt);
        const char* nA; const char* nB = has_next ? (const char*)g.Bt + ((size_t)nxt.e * g.bstride + (size_t)nxt.pn * BM * K) * ESZ + (size_t)nxt.k0 * kstepB : cB;
        const int ntu = cur.nkt ? cur.nkt : nt;
        if constexpr (GATHER) { nA = has_next ? (const char*)g.A + (size_t)nxt.k0 * 128 : cA;
            if (has_next) {
#pragma unroll
                for (int i = 0; i < 2; ++i) { nA0[i] = (unsigned)S.arow(nxt, RA[i]) * (unsigned)KB + CA[i]; nA1[i] = (unsigned)S.arow(nxt, HALF + RA[i]) * (unsigned)KB + CA[i]; } }
        } else { nA = has_next ? (const char*)g.A + (size_t)nxt.pm * tstep + (size_t)nxt.k0 * 128 : cA; }
        for (int t = 0; t < ntu; t += 2) {
            const bool last = (t == ntu - 2);
            const char* a1 = cA + (size_t)(t + 1) * kstep;
            const char* a2 = last ? nA : cA + (size_t)(t + 2) * kstep; const char* b2 = last ? nB : cB + (size_t)(t + 2) * kstepB;
            const char* a3 = a2 + kstep; const char* b3 = b2 + kstepB;
            unsigned xA0[2], xA1[2];
#pragma unroll
            for (int i = 0; i < 2; ++i) { xA0[i] = (GATHER && last) ? nA0[i] : oA0[i]; xA1[i] = (GATHER && last) ? nA1[i] : oA1[i]; }
            PG8_LDB(0, 0, 0); PG8_LDB(1, 0, 1); PG8_SCHED; PG8_LDA(0, 0); PG8_STAGE(PG8_SA(1, 1), a1, oA1);
            PG8_WAIT_V(8); PG8_WAIT_L(0); PG8_BAR; PG8_MMA(0, 0); PG8_MMA(0, 1); PG8_BAR; PG8_SCHED;
            PG8_LDA(0, 1); PG8_STAGE(PG8_SB(0, 0), b2, voffB); PG8_STAGE(PG8_SB(0, 1), b2 + hstepB, voffB); PG8_STAGE(PG8_SA(0, 0), a2, xA0);
            PG8_WAIT_V(8); PG8_WAIT_L(0); PG8_BAR; PG8_MMA(1, 0); PG8_MMA(1, 1); PG8_BAR; PG8_SCHED;
            PG8_LDB(0, 1, 0); PG8_LDB(1, 1, 1); PG8_SCHED; PG8_LDA(1, 0); PG8_STAGE(PG8_SA(0, 1), a2, xA1);
            PG8_WAIT_V(8); PG8_WAIT_L(0); PG8_BAR; PG8_MMA(0, 0); PG8_MMA(0, 1); PG8_BAR; PG8_SCHED;
            PG8_LDA(1, 1); PG8_STAGE(PG8_SB(1, 0), b3, voffB); PG8_STAGE(PG8_SB(1, 1), b3 + hstepB, voffB); PG8_STAGE(PG8_SA(1, 0), a3, xA0);
            PG8_WAIT_V(8); PG8_WAIT_L(0); PG8_BAR; PG8_MMA(1, 0); PG8_MMA(1, 1); PG8_BAR; PG8_SCHED;
        }
        if (wr == 0) PG8_BAR;
        if constexpr (F8) asm volatile("s_nop 15\n\ts_nop 15" ::: "memory");
        { int efr = fr, efq = fq; asm volatile("" : "+v"(efr), "+v"(efq)); E(acc, cur, wr, wc, efr, efq); }
        if (!has_next) break;
#pragma unroll
        for (int a = 0; a < 2; ++a)
#pragma unroll
            for (int b = 0; b < 2; ++b)
#pragma unroll
                for (int m = 0; m < 4; ++m)
#pragma unroll
                    for (int n = 0; n < 2; ++n) acc[a][b][m][n] = (f32x4){0.f, 0.f, 0.f, 0.f};
        cur = nxt; cA = nA; cB = nB; ++ui;
#pragma unroll
        for (int i = 0; i < 2; ++i) { oA0[i] = nA0[i]; oA1[i] = nA1[i]; }
        if (wr == 1) PG8_BAR;
    }
    PG8_WAIT_V(0);
    PG8_BAR;
#undef PG8_SA
#undef PG8_SB
#undef PG8_STAGE
#undef PG8_LDA
#undef PG8_LDB
#undef PG8_MMA
#undef PG8_WAIT_V
#undef PG8_WAIT_L
#undef PG8_BAR
#undef PG8_SCHED
}

__device__ __forceinline__ float row_rstd(const float* part, int row) { const f32x4 a = *(const f32x4*)(part + (size_t)row * 8), b = *(const f32x4*)(part + (size_t)row * 8 + 4);
    return rsqrtf((((a[0] + a[1]) + (a[2] + a[3])) + ((b[0] + b[1]) + (b[2] + b[3]))) * (1.0f / D) + EPS); }
struct EpiResid {
    const float* Xin; float* Xout; bf16_t* XB; float* part; LAS float* P; unsigned char* X8; float sc;
    __device__ __forceinline__ void operator()(const f32x4 (&acc)[2][2][4][2], const Unit& u, int wr, int wc, int fr, int fq) const {
        const int row0 = u.pm * BM + wr * 64 + fr, col0 = u.pn * BM + wc * 32 + 4 * fq;
#pragma unroll
        for (int ai = 0; ai < 2; ++ai)
#pragma unroll
            for (int m = 0; m < 4; ++m) { const int row = row0 + ai * HALF + m * 16; const size_t ro = (size_t)row * D + col0; float ss = 0.f;
#pragma unroll
                for (int bj = 0; bj < 2; ++bj)
#pragma unroll
                    for (int n = 0; n < 2; ++n) { const f32x4 v = *(const f32x4*)(Xin + ro + bj * HALF + n * 16) + acc[ai][bj][m][n] * sc;
                        *(f32x4*)(Xout + ro + bj * HALF + n * 16) = v; ss += (v[0] * v[0] + v[1] * v[1]) + (v[2] * v[2] + v[3] * v[3]);
                        u32x2 w; w.x = cvt_pk_bf16(v[0], v[1]); w.y = cvt_pk_bf16(v[2], v[3]); *(u32x2*)(XB + ro + bj * HALF + n * 16) = w;
                        if (X8) *(unsigned*)(X8 + ro + bj * HALF + n * 16) = pk4_fp8(v[0], v[1], v[2], v[3]); }
                ss += __shfl_xor(ss, 16); ss += __shfl_xor(ss, 32);
                if (fq == 0) P[(wr * 64 + fr + ai * HALF + m * 16) * 4 + wc] = ss; }
        asm volatile("s_waitcnt lgkmcnt(0)" ::: "memory"); __builtin_amdgcn_s_barrier(); asm volatile("" ::: "memory");
        const int t = threadIdx.x;
        if (t < BM) { const f32x4 p = *(const LAS f32x4*)(P + t * 4); part[(size_t)(u.pm * BM + t) * 8 + u.pn] = (p[0] + p[1]) + (p[2] + p[3]); }
    }
};

__device__ __forceinline__ float fast_silu(float g) { return g * __builtin_amdgcn_rcpf(1.f + __expf(-g)); }
__device__ __forceinline__ float fast_gelu_tanh(float x) { const float u = 1.5957691216057308f * (x + 0.044715f * x * x * x); return x * (1.f - __builtin_amdgcn_rcpf(1.f + __expf(u))); }
struct EpiQkv {
    bf16_t* O; const float* part; const float* rc; const float* rs;
    __device__ __forceinline__ void operator()(const f32x4 (&acc)[2][2][4][2], const Unit& u, int wr, int wc, int fr, int fq) const {
        const int row0 = u.pm * BM + wr * 64 + fr, col0 = u.pn * BM + wc * 64 + 8 * fq; const bool rope = (u.pn >= 12 && u.pn < 20);
#pragma unroll
        for (int ai = 0; ai < 2; ++ai)
#pragma unroll
            for (int m = 0; m < 4; ++m) { const int row = row0 + ai * HALF + m * 16; const float rstd = row_rstd(part, row);
                f32x4 x1a = acc[ai][0][m][0] * rstd, x1b = acc[ai][0][m][1] * rstd, x2a = acc[ai][1][m][0] * rstd, x2b = acc[ai][1][m][1] * rstd;
                if (rope) { const int s = row & (S - 1); const f32x4 ca = *(const f32x4*)(rc + s * 32 + 8 * fq), cb = *(const f32x4*)(rc + s * 32 + 8 * fq + 4), sa = *(const f32x4*)(rs + s * 32 + 8 * fq), sb = *(const f32x4*)(rs + s * 32 + 8 * fq + 4);
                    const f32x4 o1a = x1a * ca - x2a * sa, o1b = x1b * cb - x2b * sb, o2a = x2a * ca + x1a * sa, o2b = x2b * cb + x1b * sb; x1a = o1a; x1b = o1b; x2a = o2a; x2b = o2b; }
                bf16_t* rowp = O + (size_t)row * INC + col0;
                u32x4 w1, w2; w1.x = cvt_pk_bf16(x1a[0], x1a[1]); w1.y = cvt_pk_bf16(x1a[2], x1a[3]); w1.z = cvt_pk_bf16(x1b[0], x1b[1]); w1.w = cvt_pk_bf16(x1b[2], x1b[3]);
                w2.x = cvt_pk_bf16(x2a[0], x2a[1]); w2.y = cvt_pk_bf16(x2a[2], x2a[3]); w2.z = cvt_pk_bf16(x2b[0], x2b[1]); w2.w = cvt_pk_bf16(x2b[2], x2b[3]);
                *(u32x4*)rowp = w1; *(u32x4*)(rowp + 32) = w2; }
    }
};
template <bool MOE, bool F8O = MOE, bool F8I = F8O> struct EpiGateUp {
    bf16_t* O; const float* part; const int* list;
    __device__ __forceinline__ void operator()(const f32x4 (&acc)[2][2][4][2], const Unit& u, int wr, int wc, int fr, int fq) const {
        const int lr0 = wr * 64 + fr, col0 = u.pn * HALF + wc * 32 + 8 * fq;
#pragma unroll
        for (int ai = 0; ai < 2; ++ai)
#pragma unroll
            for (int m = 0; m < 4; ++m) { const int lr = lr0 + ai * HALF + m * 16; int srow = u.pm * BM + lr; const int orow = u.pm * BM + lr;
                const float rstd = MOE ? W8_INV : row_rstd(part, srow) * (F8I ? W8_INV : 1.f);
                const f32x4 g0 = acc[ai][0][m][0] * rstd, g1 = acc[ai][0][m][1] * rstd, u0 = acc[ai][1][m][0] * rstd, u1 = acc[ai][1][m][1] * rstd;
                if constexpr (F8O) { u32x2 w8; w8.x = pk4_fp8(fast_silu(g0[0]) * u0[0], fast_silu(g0[1]) * u0[1], fast_silu(g0[2]) * u0[2], fast_silu(g0[3]) * u0[3]);
                    w8.y = pk4_fp8(fast_silu(g1[0]) * u1[0], fast_silu(g1[1]) * u1[1], fast_silu(g1[2]) * u1[2], fast_silu(g1[3]) * u1[3]);
                    *(u32x2*)((unsigned char*)O + (size_t)orow * FF + col0) = w8; continue; }
                u32x4 w; w.x = cvt_pk_bf16(fast_silu(g0[0]) * u0[0], fast_silu(g0[1]) * u0[1]); w.y = cvt_pk_bf16(fast_silu(g0[2]) * u0[2], fast_silu(g0[3]) * u0[3]);
                w.z = cvt_pk_bf16(fast_silu(g1[0]) * u1[0], fast_silu(g1[1]) * u1[1]); w.w = cvt_pk_bf16(fast_silu(g1[2]) * u1[2], fast_silu(g1[3]) * u1[3]);
                *(u32x4*)(O + (size_t)orow * FF + col0) = w; }
    }
};
struct EpiL1In {
    bf16_t* Y; bf16_t* R; const float* part;
    __device__ __forceinline__ void operator()(const f32x4 (&acc)[2][2][4][2], const Unit& u, int wr, int wc, int fr, int fq) const {
        const int row0 = u.pm * BM + wr * 64 + fr, col0 = u.pn * BM + wc * 32 + 8 * fq;
#pragma unroll
        for (int ai = 0; ai < 2; ++ai)
#pragma unroll
            for (int m = 0; m < 4; ++m) { const int row = row0 + ai * HALF + m * 16; const float rstd = row_rstd(part, row);
#pragma unroll
                for (int bj = 0; bj < 2; ++bj) { const f32x4 v0 = acc[ai][bj][m][0] * rstd, v1 = acc[ai][bj][m][1] * rstd; const int col = col0 + bj * HALF;
                    if (u.pn < 8) { u32x4 w; w.x = cvt_pk_bf16(fast_gelu_tanh(v0[0]), fast_gelu_tanh(v0[1])); w.y = cvt_pk_bf16(fast_gelu_tanh(v0[2]), fast_gelu_tanh(v0[3]));
                        w.z = cvt_pk_bf16(fast_gelu_tanh(v1[0]), fast_gelu_tanh(v1[1])); w.w = cvt_pk_bf16(fast_gelu_tanh(v1[2]), fast_gelu_tanh(v1[3])); *(u32x4*)(Y + (size_t)row * D + col) = w; }
                    else { u32x4 w; w.x = cvt_pk_bf16(v0[0], v0[1]); w.y = cvt_pk_bf16(v0[2], v0[3]); w.z = cvt_pk_bf16(v1[0], v1[1]); w.w = cvt_pk_bf16(v1[2], v1[3]); *(u32x4*)(R + ((size_t)(row >> 8) * LB + (u.pn - 8) * 2 + bj) * (256 * LBD) + (size_t)(row & 255) * LBD + wc * 32 + 8 * fq) = w; } } }
    }
};

struct MoeOrder {
    const volatile LAS int* tab; const int* list; int NP, nwg, G, c, KT4;
    __device__ __forceinline__ int tb(int i) const { return __builtin_amdgcn_readfirstlane(tab[i]); }
    __device__ void init(const volatile LAS int* tab_, const int* list_, int NP_, int G_, int c_) { tab = tab_; list = list_; NP = NP_; G = G_; c = c_; nwg = __builtin_amdgcn_readfirstlane(tab_[16]) * NP_; ksplit = 0; KT4 = 0; }
    int ksplit;
    __device__ bool next(int i, Unit& u) const {
        long L = (long)i * G + c; u.k0 = 0; u.nkt = 0; u.kq = -1; u.ridx = 0;
        if (ksplit && i >= 2) { if (i > 2 || c >= 4 * (nwg - 2 * G)) return false; L = 2 * G + (c >> 2); u.kq = c & 3; u.ridx = c >> 2; u.nkt = KT4; u.k0 = u.kq * KT4; }
        if (L >= nwg) return false;
        int wgid = (int)L; { const int q = nwg / NXCD, r = nwg % NXCD, xcd = wgid % NXCD, off = wgid / NXCD; wgid = (xcd < r ? xcd * (q + 1) : r * (q + 1) + (xcd - r) * q) + off; }
        int e = 0;
#pragma unroll
        for (int k = 1; k < NE; ++k) e += (wgid >= tb(8 + k) * NP) ? 1 : 0;
        const int p0 = tb(8 + e), npan = tb(9 + e) - p0, w = wgid - p0 * NP;
        const int pl = w % npan; u.pn = w / npan; u.pm = p0 + pl; u.e = e; u.r0 = pl * BM; u.cnt = tb(e); return true;
    }
    __device__ __forceinline__ int arow(const Unit& u, int lr) const { const int li = u.r0 + lr; return (li < u.cnt) ? (list[u.e * T + li] >> 1) : 0; }
};
struct EpiMoeDown {
    bf16_t* C; const int* list; const float* gatew; float* partk;
    __device__ __forceinline__ void operator()(const f32x4 (&acc)[2][2][4][2], const Unit& u, int wr, int wc, int fr, int fq) const {
        const int lr0 = wr * 64 + fr, col0 = u.pn * BM + wc * 32 + 4 * fq;
        if (u.kq >= 0) {
            float* pt = partk + ((size_t)(u.ridx * 4 + u.kq) << 16) + wc * 32 + 4 * fq;
#pragma unroll
            for (int ai = 0; ai < 2; ++ai)
#pragma unroll
                for (int m = 0; m < 4; ++m) { float* rp = pt + (lr0 + ai * HALF + m * 16) * BM;
#pragma unroll
                    for (int bj = 0; bj < 2; ++bj)
#pragma unroll
                        for (int n = 0; n < 2; ++n) *(f32x4*)(rp + bj * HALF + n * 16) = acc[ai][bj][m][n]; }
            return;
        }
#pragma unroll
        for (int ai = 0; ai < 2; ++ai)
#pragma unroll
            for (int m = 0; m < 4; ++m) { const int li = u.r0 + lr0 + ai * HALF + m * 16;
                if (li < u.cnt) { const int ent = list[u.e * T + li]; const float w = gatew[ent] * W8_INV; bf16_t* rp = C + (size_t)ent * D + col0;
#pragma unroll
                    for (int bj = 0; bj < 2; ++bj)
#pragma unroll
                        for (int n = 0; n < 2; ++n) { const f32x4 v = acc[ai][bj][m][n] * w; u32x2 pk; pk.x = cvt_pk_bf16(v[0], v[1]); pk.y = cvt_pk_bf16(v[2], v[3]); *(u32x2*)(rp + bj * HALF + n * 16) = pk; } } }
    }
};

namespace att {
using f32x16 = __attribute__((ext_vector_type(16))) float;
using s16x4  = __attribute__((ext_vector_type(4))) short;
constexpr int SHM_V = 64 * 128 * 2, SHM_K = 64 * 128 * 2;
constexpr float LOG2E = 1.4426950408889634f;
constexpr float THR2 = 8.f * LOG2E;
#define KSWZ(row, colB) ((row) * 256 + ((colB) ^ (((row) & 7) << 4)))
#define SBAR() __builtin_amdgcn_sched_barrier(0)
__device__ __forceinline__ int crow(int r, int hi) { return (r & 3) + 8 * (r >> 2) + 4 * hi; }
__device__ __forceinline__ unsigned cvtpk(float lo, float hi) { unsigned r; asm volatile("v_cvt_pk_bf16_f32 %0, %1, %2" : "=v"(r) : "v"(lo), "v"(hi)); return r; }
__device__ __forceinline__ int v_st(int k, int c) { const int kk = (k & ~0xC) | ((k & 4) << 1) | ((k & 8) >> 1); return ((kk >> 3) * 4 + (c >> 5)) * 512 + ((kk & 7) * 32 + (c & 31)) * 2; }
__device__ __forceinline__ int v_rd_base(int lane) { return ((lane & 3) << 3) | (((lane >> 2) & 3) << 6) | (((lane >> 4) & 1) << 5) | (((lane >> 5) & 1) << 8); }
constexpr int v_rd_off(int d0, int ks, int half) { return d0 * 512 + ks * 4096 + half * 2048; }
template <int OFF> __device__ __forceinline__ s16x4 tr_read(int vb) { s16x4 r; asm volatile("ds_read_b64_tr_b16 %0, %1 offset:%2" : "=&v"(r) : "v"(vb), "i"(OFF) : "memory"); return r; }
template <int D0> __device__ __forceinline__ void pv_one(f32x16& od, int vb, bf16x8 pa0, bf16x8 pa1, bf16x8 pa2, bf16x8 pa3) {
    const s16x4 l0 = tr_read<v_rd_off(D0, 0, 0)>(vb), h0 = tr_read<v_rd_off(D0, 0, 1)>(vb), l1 = tr_read<v_rd_off(D0, 1, 0)>(vb), h1 = tr_read<v_rd_off(D0, 1, 1)>(vb);
    const s16x4 l2 = tr_read<v_rd_off(D0, 2, 0)>(vb), h2 = tr_read<v_rd_off(D0, 2, 1)>(vb), l3 = tr_read<v_rd_off(D0, 3, 0)>(vb), h3 = tr_read<v_rd_off(D0, 3, 1)>(vb);
    asm volatile("s_waitcnt lgkmcnt(0)" ::: "memory"); SBAR();
#define PK(L, H) (bf16x8){L[0], L[1], L[2], L[3], H[0], H[1], H[2], H[3]}
    od = __builtin_amdgcn_mfma_f32_32x32x16_bf16(pa0, PK(l0, h0), od, 0, 0, 0);
    od = __builtin_amdgcn_mfma_f32_32x32x16_bf16(pa1, PK(l1, h1), od, 0, 0, 0);
    od = __builtin_amdgcn_mfma_f32_32x32x16_bf16(pa2, PK(l2, h2), od, 0, 0, 0);
    od = __builtin_amdgcn_mfma_f32_32x32x16_bf16(pa3, PK(l3, h3), od, 0, 0, 0);
#undef PK
}
__device__ __forceinline__ void pv_d0(f32x16* o, int vb, bf16x8 pa0, bf16x8 pa1, bf16x8 pa2, bf16x8 pa3) {
    pv_one<0>(o[0], vb, pa0, pa1, pa2, pa3); pv_one<1>(o[1], vb, pa0, pa1, pa2, pa3); pv_one<2>(o[2], vb, pa0, pa1, pa2, pa3); pv_one<3>(o[3], vb, pa0, pa1, pa2, pa3);
}
struct NaCtx { const LAS float* bias; int r, rs, qc, cs; };
template <int MODE> __device__ __forceinline__ void partialSM(f32x16& p0, f32x16& p1, float& m_reg, float& mn, float& alpha, const NaCtx& nc, int kr, int hi) {
    float pmax;
    if constexpr (MODE == 0) {
        constexpr float C = 0.125f * LOG2E;
        pmax = p0[0];
#pragma unroll
        for (int r = 1; r < 16; ++r) pmax = fmaxf(pmax, p0[r]);
#pragma unroll
        for (int r = 0; r < 16; ++r) pmax = fmaxf(pmax, p1[r]);
        pmax *= C;
    } else {
        constexpr float C = 0.08838834764831845f * LOG2E;
        const bool rowin = (unsigned)(kr - nc.rs) < 8u;
        const int base = (kr - nc.r + 7) * 31 + 15 - nc.qc;
#pragma unroll
        for (int r = 0; r < 16; ++r) { const int kc0 = crow(r, hi), kc1 = 32 + kc0;
            const bool v0 = rowin && ((unsigned)(kc0 - nc.cs) < 16u), v1 = rowin && ((unsigned)(kc1 - nc.cs) < 16u);
            const float b0 = nc.bias[v0 ? base + kc0 : 0], b1 = nc.bias[v1 ? base + kc1 : 0];
            p0[r] = v0 ? fmaf(p0[r], C, b0) : -1.0e30f; p1[r] = v1 ? fmaf(p1[r], C, b1) : -1.0e30f; }
        pmax = p0[0];
#pragma unroll
        for (int r = 1; r < 16; ++r) pmax = fmaxf(pmax, p0[r]);
#pragma unroll
        for (int r = 0; r < 16; ++r) pmax = fmaxf(pmax, p1[r]);
    }
    { auto rr = __builtin_amdgcn_permlane32_swap(__float_as_uint(pmax), __float_as_uint(pmax), false, false);
      pmax = fmaxf(__uint_as_float(rr[0]), __uint_as_float(rr[1])); }
    if (__builtin_expect(__all(pmax - m_reg <= THR2), 1)) { mn = m_reg; alpha = 1.f; }
    else { mn = fmaxf(m_reg, pmax); alpha = __builtin_amdgcn_exp2f(m_reg - mn); m_reg = mn; }
    if constexpr (MODE == 0) { constexpr float C = 0.125f * LOG2E; const float mnC = -mn;
#pragma unroll
        for (int r = 0; r < 16; ++r) p0[r] = fmaf(p0[r], C, mnC);
#pragma unroll
        for (int r = 0; r < 16; ++r) p1[r] = fmaf(p1[r], C, mnC);
    } else {
#pragma unroll
        for (int r = 0; r < 16; ++r) p0[r] = p0[r] - mn;
#pragma unroll
        for (int r = 0; r < 16; ++r) p1[r] = p1[r] - mn;
    }
#pragma unroll
    for (int r = 0; r < 16; ++r) p0[r] = __builtin_amdgcn_exp2f(p0[r]);
}
__device__ __forceinline__ void finishSM(f32x16& p0, f32x16& p1, float alpha, float& l_reg, bf16x8& pa0, bf16x8& pa1, bf16x8& pa2, bf16x8& pa3) {
#pragma unroll
    for (int r = 0; r < 16; ++r) p1[r] = __builtin_amdgcn_exp2f(p1[r]);
    float ps = 0;
#pragma unroll
    for (int r = 0; r < 16; ++r) ps += p0[r];
#pragma unroll
    for (int r = 0; r < 16; ++r) ps += p1[r];
    { auto rr = __builtin_amdgcn_permlane32_swap(__float_as_uint(ps), __float_as_uint(ps), false, false);
      ps = __uint_as_float(rr[0]) + __uint_as_float(rr[1]); }
    l_reg = l_reg * alpha + ps;
#define PK4(P, BASE, OUT) do { unsigned a0 = cvtpk(P[BASE + 0], P[BASE + 1]), a1 = cvtpk(P[BASE + 2], P[BASE + 3]);   \
    unsigned b0 = cvtpk(P[BASE + 4], P[BASE + 5]), b1 = cvtpk(P[BASE + 6], P[BASE + 7]);                              \
    auto r0 = __builtin_amdgcn_permlane32_swap(a0, b0, false, false); auto r1 = __builtin_amdgcn_permlane32_swap(a1, b1, false, false); \
    u32x4 w = {r0[0], r1[0], r0[1], r1[1]}; OUT = *reinterpret_cast<bf16x8*>(&w); } while (0)
    PK4(p0, 0, pa0); PK4(p0, 8, pa1); PK4(p1, 0, pa2); PK4(p1, 8, pa3);
#undef PK4
}
template <int NKS, bool QLDS> __device__ __forceinline__ void qkt(f32x16& p0, f32x16& p1, const LAS unsigned char* Ks, const bf16x8* qr, const LAS unsigned char* Qs, int kcb, int r32, int hi) {
    p0 = f32x16{}; p1 = f32x16{};
#pragma unroll
    for (int d0 = 0; d0 < NKS; ++d0) { const int cb = kcb + (d0 * 16 + hi * 8) * 2;
        const bf16x8 b0 = *(const LAS bf16x8*)(Ks + KSWZ(r32, cb));
        const bf16x8 b1 = *(const LAS bf16x8*)(Ks + KSWZ(32 + r32, cb));
        bf16x8 q; if constexpr (QLDS) q = *(const LAS bf16x8*)(Qs + KSWZ(r32, (d0 * 16 + hi * 8) * 2)); else q = qr[d0];
        p0 = __builtin_amdgcn_mfma_f32_32x32x16_bf16(b0, q, p0, 0, 0, 0);
        p1 = __builtin_amdgcn_mfma_f32_32x32x16_bf16(b1, q, p1, 0, 0, 0); }
}

template <int MODE>
__device__ __forceinline__ void attn_unit(const bf16_t* __restrict__ QKV, bf16_t* __restrict__ ATT, int b, int h, int blk, LAS unsigned char* lds, const float* __restrict__ subln, float lam, const float* __restrict__ rpb) {
    constexpr int NKS = (MODE == 0) ? 4 : 8;
    const int tid = opaque_tid(), wid = tid >> 6, lane = tid & 63, r32 = lane & 31, hi = lane >> 5;
    LAS unsigned char* V_lds = lds; LAS unsigned char* K_lds = lds + 2 * SHM_V;
    LAS float* wsr = (LAS float*)(lds + MISC_OFF + 1024) + wid * 64; LAS float* li_l = wsr; LAS float* al_l = wsr + 32;
    LAS float* biasL = (LAS float*)(lds + MISC_OFF + 8192);
    int qtok, qcol, kcol, vcol, tok0, NT, ocol; NaCtx nc; nc.bias = biasL; nc.r = 0; nc.rs = 0; nc.qc = 0; nc.cs = 0; int kr0 = 0;
    if constexpr (MODE == 0) { const int map = wid >> 2;
        qtok = b * S + blk * 128 + (wid & 3) * 32 + r32; qcol = 3 * 1024 + h * HD + map * 64; kcol = 4 * 1024 + h * HD; vcol = 5 * 1024 + h * HD; tok0 = b * S; NT = S / 64; ocol = 1024 + h * HD;
    } else { const int r = blk * 4 + (wid >> 1), qc = 32 * (wid & 1) + r32;
        qtok = b * S + r * GW + qc; qcol = h * HD; kcol = 1024 + h * HD; vcol = 2048 + h * HD; ocol = h * HD;
        int rlo = blk * 4 - 4; rlo = rlo < 0 ? 0 : (rlo > GR - KH ? GR - KH : rlo);
        int rhi = blk * 4 + 3 - 4; rhi = rhi < 0 ? 0 : (rhi > GR - KH ? GR - KH : rhi); rhi += KH - 1;
        int cnt = rhi - rlo + 1; if (cnt & 1) { if (rhi + 1 < GR) ++rhi; else --rlo; ++cnt; }
        kr0 = rlo; NT = cnt; tok0 = b * S + rlo * GW;
        nc.r = r; int rs = r - 4; nc.rs = rs < 0 ? 0 : (rs > GR - KH ? GR - KH : rs); nc.qc = qc; int cs = qc - 8; nc.cs = cs < 0 ? 0 : (cs > GW - KW ? GW - KW : cs);
    }
    __syncthreads();
    if constexpr (MODE == 1) { for (int i = tid; i < 15 * 31; i += NTHR) biasL[i] = rpb[h * 15 * 31 + i] * LOG2E; }
    constexpr bool QLDS = (MODE == 1);
    LAS unsigned char* Qs = lds + 65536 + wid * 8192;
    float m_reg = -1e30f, l_reg = 0; f32x16 o[4] = {}; bf16x8 qr[QLDS ? 1 : NKS];
    { const bf16_t* Qw = QKV + (size_t)qtok * INC + qcol + hi * 8;
#pragma unroll
      for (int d0 = 0; d0 < NKS; ++d0) { const bf16x8 qv = *(const bf16x8*)(Qw + d0 * 16);
          if constexpr (QLDS) *(LAS bf16x8*)(Qs + KSWZ(r32, (d0 * 16 + hi * 8) * 2)) = qv; else qr[d0] = qv; } }
    const int kcb = (MODE == 0) ? (wid >> 2) * 128 : 0;
    const int sr = tid >> 4, sc = (tid & 15) * 8, vst0 = v_st(sr, sc), vst1 = v_st(32 + sr, sc);
    const int vb0 = (int)(unsigned)(uintptr_t)V_lds + v_rd_base(lane);
    const bf16_t* Kg = QKV + (size_t)tok0 * INC + kcol + sc; const bf16_t* Vg = QKV + (size_t)tok0 * INC + vcol + sc;
    constexpr int SDEPTH = (MODE == 0) ? 2 : 1;
    struct { bf16x8 vs0, vs1, ks0, ks1; } sr_[SDEPTH];
#define SLOAD(i, k0) do { sr_[i].vs0 = *(const bf16x8*)(Vg + (size_t)((k0) + sr) * INC); sr_[i].vs1 = *(const bf16x8*)(Vg + (size_t)((k0) + 32 + sr) * INC); \
    sr_[i].ks0 = *(const bf16x8*)(Kg + (size_t)((k0) + sr) * INC); sr_[i].ks1 = *(const bf16x8*)(Kg + (size_t)((k0) + 32 + sr) * INC); } while (0)
#define SWRITE(bb, i) do { *(LAS bf16x8*)(V_lds + (bb) * SHM_V + vst0) = sr_[i].vs0; *(LAS bf16x8*)(V_lds + (bb) * SHM_V + vst1) = sr_[i].vs1; const int kc = sc * 2; \
    *(LAS bf16x8*)(K_lds + (bb) * SHM_K + KSWZ(sr, kc)) = sr_[i].ks0; *(LAS bf16x8*)(K_lds + (bb) * SHM_K + KSWZ(32 + sr, kc)) = sr_[i].ks1; } while (0)
#define SWAIT() do { if constexpr (SDEPTH == 2) asm volatile("s_waitcnt vmcnt(4)" ::: "memory"); else asm volatile("s_waitcnt vmcnt(0)" ::: "memory"); } while (0)
#define RESC(a) do { if (__any((a) < 1.f)) { if (hi == 0) al_l[r32] = (a); asm volatile("s_waitcnt lgkmcnt(0)" ::: "memory"); \
    _Pragma("unroll") for (int d = 0; d < 4; ++d) _Pragma("unroll") for (int r = 0; r < 16; ++r) o[d][r] *= al_l[crow(r, hi)]; } } while (0)
    f32x16 pA0, pA1, pB0, pB1; float mnA, mnB, alA, alB; bf16x8 pa0, pa1, pa2, pa3;
    constexpr int SE = 0, SO = SDEPTH - 1;
    if (wid >= 4) __builtin_amdgcn_s_setprio(1);
    SLOAD(SE, 0); asm volatile("s_waitcnt vmcnt(0)" ::: "memory"); SWRITE(0, SE); __syncthreads();
    qkt<NKS, QLDS>(pA0, pA1, K_lds, qr, Qs, kcb, r32, hi); partialSM<MODE>(pA0, pA1, m_reg, mnA, alA, nc, kr0, hi);
    SLOAD(SO, 64); if constexpr (SDEPTH == 2) { if (2 < NT) SLOAD(SE, 2 * 64); }
    SWAIT(); SWRITE(1, SO); __syncthreads();
    for (int j = 1; j + 1 < NT; j += 2) {
        SBAR(); qkt<NKS, QLDS>(pB0, pB1, K_lds + SHM_K, qr, Qs, kcb, r32, hi);
        finishSM(pA0, pA1, alA, l_reg, pa0, pa1, pa2, pa3); SBAR();
        SLOAD(SO, (j + SDEPTH) * 64); SBAR();
        pv_d0(o, vb0, pa0, pa1, pa2, pa3); partialSM<MODE>(pB0, pB1, m_reg, mnB, alB, nc, kr0 + j, hi);
        __syncthreads(); SWAIT(); SWRITE(0, SE);
        RESC(alB); __syncthreads();
        SBAR(); qkt<NKS, QLDS>(pA0, pA1, K_lds, qr, Qs, kcb, r32, hi);
        finishSM(pB0, pB1, alB, l_reg, pa0, pa1, pa2, pa3); SBAR();
        if (SDEPTH == 1 || j + 3 < NT) SLOAD(SE, (j + 1 + SDEPTH) * 64); SBAR();
        pv_d0(o, vb0 + SHM_V, pa0, pa1, pa2, pa3); partialSM<MODE>(pA0, pA1, m_reg, mnA, alA, nc, kr0 + j + 1, hi);
        __syncthreads(); SWAIT(); SWRITE(1, SO);
        RESC(alA); __syncthreads();
    }
    SBAR(); qkt<NKS, QLDS>(pB0, pB1, K_lds + SHM_K, qr, Qs, kcb, r32, hi);
    finishSM(pA0, pA1, alA, l_reg, pa0, pa1, pa2, pa3); SBAR();
    pv_d0(o, vb0, pa0, pa1, pa2, pa3); partialSM<MODE>(pB0, pB1, m_reg, mnB, alB, nc, kr0 + NT - 1, hi);
    __syncthreads(); RESC(alB);
    finishSM(pB0, pB1, alB, l_reg, pa0, pa1, pa2, pa3); SBAR();
    pv_d0(o, vb0 + SHM_V, pa0, pa1, pa2, pa3);
    __builtin_amdgcn_s_setprio(0);
    if (hi == 0) li_l[r32] = l_reg; asm volatile("s_waitcnt lgkmcnt(0)" ::: "memory");
    float rli[16];
#pragma unroll
    for (int r = 0; r < 16; ++r) rli[r] = __builtin_amdgcn_rcpf(li_l[crow(r, hi)]);
    const int tid2 = opaque_tid(), wid2 = tid2 >> 6, lane2 = tid2 & 63, r32b = lane2 & 31, hib = lane2 >> 5;
    LAS bf16_t* OT = (LAS bf16_t*)(lds + 65536 + wid2 * 8192);
    if constexpr (MODE == 0) {
        LAS float* XCH = (LAS float*)lds;
        __syncthreads();
        if (wid2 >= 4) {
#pragma unroll
            for (int d = 0; d < 4; ++d)
#pragma unroll
                for (int r = 0; r < 16; ++r) XCH[((wid2 - 4) * 64 + d * 16 + r) * 64 + lane2] = o[d][r] * rli[r] * lam;
        }
        __syncthreads();
        if (wid2 < 4) {
            float ssr[16];
#pragma unroll
            for (int r = 0; r < 16; ++r) ssr[r] = 0.f;
#pragma unroll
            for (int d = 0; d < 4; ++d)
#pragma unroll
                for (int r = 0; r < 16; ++r) { const float v = o[d][r] * rli[r] - XCH[(wid2 * 64 + d * 16 + r) * 64 + lane2]; o[d][r] = v; ssr[r] += v * v; }
#pragma unroll
            for (int r = 0; r < 16; ++r) { float s_ = ssr[r]; s_ += __shfl_xor(s_, 1); s_ += __shfl_xor(s_, 2); s_ += __shfl_xor(s_, 4); s_ += __shfl_xor(s_, 8); s_ += __shfl_xor(s_, 16);
                ssr[r] = rsqrtf(s_ * (1.0f / 128.0f) + EPS) * 0.8f; }
#pragma unroll
            for (int d = 0; d < 4; ++d) { const float sg = subln[d * 32 + r32b];
#pragma unroll
                for (int r = 0; r < 16; ++r) OT[crow(r, hib) * 128 + d * 32 + r32b] = f2bf(o[d][r] * ssr[r] * sg); }
        }
    } else {
#pragma unroll
        for (int d = 0; d < 4; ++d)
#pragma unroll
            for (int r = 0; r < 16; ++r) OT[crow(r, hib) * 128 + d * 32 + r32b] = f2bf(o[d][r] * rli[r]);
    }
    if (MODE == 1 || wid2 < 4) {
        asm volatile("s_waitcnt lgkmcnt(0)" ::: "memory");
        const int otok0 = (MODE == 0) ? (b * S + blk * 128 + wid2 * 32) : (b * S + (blk * 4 + (wid2 >> 1)) * GW + 32 * (wid2 & 1)); const int ocol2 = (MODE == 0) ? (1024 + h * HD) : (h * HD);
#pragma unroll
        for (int it = 0; it < 8; ++it) { const int row = it * 4 + (lane2 >> 4), cc = (lane2 & 15) * 8;
            *(u32x4*)(ATT + (size_t)(otok0 + row) * D + ocol2 + cc) = *(const LAS u32x4*)(OT + row * 128 + cc); }
    }
#undef SLOAD
#undef SWRITE
#undef SWAIT
#undef RESC
}

__device__ __forceinline__ void na_unit(const bf16_t* __restrict__ QKV, bf16_t* __restrict__ ATT, int b, int h, int blk, LAS unsigned char* lds, const float* __restrict__ rpb) {
    const int tid = opaque_tid(), wid = tid >> 6, lane = tid & 63, r32 = lane & 31, hi = lane >> 5;
    LAS unsigned char* R = lds + wid * 16384;
    LAS float* wsr = (LAS float*)(lds + MISC_OFF + 1024) + wid * 64; LAS float* li_l = wsr; LAS float* al_l = wsr + 32;
    LAS float* biasL = (LAS float*)(lds + MISC_OFF + 8192);
    const int r = blk * 4 + (wid >> 1), qc = 32 * (wid & 1) + r32;
    const int qtok = b * S + r * GW + qc, qcol = h * HD, kcol = 1024 + h * HD, vcol = 2048 + h * HD;
    NaCtx nc; nc.bias = biasL; nc.r = r; { int rs = r - 4; nc.rs = rs < 0 ? 0 : (rs > GR - KH ? GR - KH : rs); } nc.qc = qc; { int cs = qc - 8; nc.cs = cs < 0 ? 0 : (cs > GW - KW ? GW - KW : cs); }
    const int rs_w = __builtin_amdgcn_readfirstlane(nc.rs);
    __syncthreads();
    for (int i = tid; i < 15 * 31; i += NTHR) biasL[i] = rpb[h * 15 * 31 + i] * LOG2E;
    float m_reg = -1e30f, l_reg = 0; f32x16 o[4] = {}; bf16x8 qr[8];
    { const bf16_t* Qw = QKV + (size_t)qtok * INC + qcol + hi * 8;
#pragma unroll
      for (int d0 = 0; d0 < 8; ++d0) qr[d0] = *(const bf16x8*)(Qw + d0 * 16); }
    const int sr = lane >> 4, sc = (lane & 15) * 8;
    const int vb0 = (int)(unsigned)(uintptr_t)R + v_rd_base(lane);
    const bf16_t* Kg = QKV + (size_t)(b * S + rs_w * GW + sr) * INC + kcol + sc; const bf16_t* Vg = QKV + (size_t)(b * S + rs_w * GW + sr) * INC + vcol + sc;
    bf16x8 st[16];
#define WLOAD(gp, j) do { _Pragma("unroll") for (int i = 0; i < 16; ++i) st[i] = *(const bf16x8*)((gp) + (size_t)((j) * 64 + 4 * i) * INC); } while (0)
    WLOAD(Kg, 0);
    __syncthreads();
#pragma unroll 1
    for (int j = 0; j < KH; ++j) {
        const int kr = rs_w + j;
#pragma unroll
        for (int i = 0; i < 16; ++i) *(LAS bf16x8*)(R + KSWZ(sr + 4 * i, sc * 2)) = st[i];
        asm volatile("s_waitcnt lgkmcnt(0)" ::: "memory");
        WLOAD(Vg, j);
        f32x16 p0, p1; float mn, al; bf16x8 pa0, pa1, pa2, pa3;
        qkt<8, false>(p0, p1, R, qr, nullptr, 0, r32, hi);
        partialSM<1>(p0, p1, m_reg, mn, al, nc, kr, hi);
        if (__any(al < 1.f)) { if (hi == 0) al_l[r32] = al; asm volatile("s_waitcnt lgkmcnt(0)" ::: "memory");
#pragma unroll
            for (int d = 0; d < 4; ++d)
#pragma unroll
                for (int rr = 0; rr < 16; ++rr) o[d][rr] *= al_l[crow(rr, hi)]; }
        finishSM(p0, p1, al, l_reg, pa0, pa1, pa2, pa3);
        asm volatile("s_waitcnt lgkmcnt(0)" ::: "memory");
#pragma unroll
        for (int i = 0; i < 16; ++i) *(LAS bf16x8*)(R + v_st(sr + 4 * i, sc)) = st[i];
        asm volatile("s_waitcnt lgkmcnt(0)" ::: "memory");
        if (j + 1 < KH) WLOAD(Kg, j + 1);
        pv_d0(o, vb0, pa0, pa1, pa2, pa3);
    }
#undef WLOAD
    if (hi == 0) li_l[r32] = l_reg; asm volatile("s_waitcnt lgkmcnt(0)" ::: "memory");
    float rli[16];
#pragma unroll
    for (int rr = 0; rr < 16; ++rr) rli[rr] = __builtin_amdgcn_rcpf(li_l[crow(rr, hi)]);
    const int tid2 = opaque_tid(), wid2 = tid2 >> 6, lane2 = tid2 & 63, r32b = lane2 & 31, hib = lane2 >> 5;
    LAS bf16_t* OT = (LAS bf16_t*)(lds + wid2 * 16384);
#pragma unroll
    for (int d = 0; d < 4; ++d)
#pragma unroll
        for (int rr = 0; rr < 16; ++rr) OT[crow(rr, hib) * 128 + d * 32 + r32b] = f2bf(o[d][rr] * rli[rr]);
    asm volatile("s_waitcnt lgkmcnt(0)" ::: "memory");
    const int otok0 = b * S + (blk * 4 + (wid2 >> 1)) * GW + 32 * (wid2 & 1);
#pragma unroll
    for (int it = 0; it < 8; ++it) { const int row = it * 4 + (lane2 >> 4), cc = (lane2 & 15) * 8;
        *(u32x4*)(ATT + (size_t)(otok0 + row) * D + h * HD + cc) = *(const LAS u32x4*)(OT + row * 128 + cc); }
}
#undef KSWZ
#undef SBAR
}

__device__ __forceinline__ unsigned pk2(float lo, float hi) { return (unsigned)f2bf(lo) | ((unsigned)f2bf(hi) << 16); }
struct TDesc { const float* W; bf16_t* WT; const float* gain; size_t ob; int K, N, rbase, k0, n0, f8, mode, rs; };
__device__ __forceinline__ void tfix(TDesc& d) {
    if ((d.N & 255) == 0) { const int ksz = d.f8 ? 128 : 64; d.ob = (size_t)(d.rbase >> 8) * 256 * d.K + (size_t)(d.k0 / ksz) * (256 * ksz) + (size_t)(d.rbase & 255) * ksz; d.rs = ksz; }
    else { d.ob = (size_t)d.rbase * d.K + d.k0; d.rs = d.K; }
}
__device__ __forceinline__ void tmake(TDesc& d, const float* W, int K, int N, bf16_t* WT, int mode, const float* gain, int item, int f8 = 0) {
    d.W = W; d.WT = WT; d.gain = gain; d.K = K; d.N = N; d.f8 = f8; d.mode = mode;
    if (f8) { const int nblk = N / 32, kb = item / nblk, nb = item % nblk; d.k0 = 128 * kb; d.n0 = 32 * nb; }
    else { const int nblk = N / 64, kb = item / nblk, nb = item % nblk; d.k0 = 64 * kb; d.n0 = 64 * nb; }
    d.rbase = (mode == 0) ? d.n0 : (256 * (d.n0 >> 7) + (d.n0 & 127) + (mode == 2 ? 128 : 0)); tfix(d);
}
__device__ __forceinline__ void tload(const TDesc& d, f32x4 (&v)[16], float (&gq)[2], int lane) {
    gq[0] = d.gain ? d.gain[d.k0 + lane] : 1.f; gq[1] = (d.gain && d.f8) ? d.gain[d.k0 + 64 + lane] : 1.f;
    if (d.f8) { const float* p = d.W + (size_t)(d.k0 + (lane >> 3)) * d.N + d.n0 + (lane & 7) * 4;
#pragma unroll
        for (int i = 0; i < 16; ++i) v[i] = __builtin_nontemporal_load((const f32x4*)(p + (size_t)(8 * i) * d.N));
        return; }
    const float* p = d.W + (size_t)(d.k0 + (lane >> 4)) * d.N + d.n0 + (lane & 15) * 4;
#pragma unroll
    for (int i = 0; i < 16; ++i) v[i] = __builtin_nontemporal_load((const f32x4*)(p + (size_t)(4 * i) * d.N));
}
__device__ __forceinline__ void tstore(const TDesc& d, const f32x4 (&v)[16], const float (&gq)[2], LAS unsigned char* scr, int lane) {
    const int g = lane >> 4, l16 = lane & 15, r = l16 >> 2, c = l16 & 3; const unsigned sbase = (unsigned)(uintptr_t)scr;
    u32x2 t[8];
    if (d.f8) {
        const float g0 = gq[0] * W8_SCALE, g1 = gq[1] * W8_SCALE;
#pragma unroll
        for (int i = 0; i < 16; ++i) { const int k = 8 * i + (lane >> 3); const float gg = (i < 8) ? __shfl(g0, k) : __shfl(g1, k - 64); const f32x4 x = v[i] * gg;
            u32x2 pk; pk.x = cvt_pk_bf16(x[0], x[1]); pk.y = cvt_pk_bf16(x[2], x[3]); *(LAS u32x2*)(scr + k * 72 + (lane & 7) * 8) = pk; }
        asm volatile("s_waitcnt lgkmcnt(0)" ::: "memory");
        const unsigned lb = sbase + (unsigned)((16 * g + r) * 72 + 8 * c);
        unsigned char* W8 = (unsigned char*)d.WT;
#pragma unroll
        for (int jh = 0; jh < 2; ++jh) {
            if (jh == 0) { asm volatile("ds_read_b64_tr_b16 %0, %8 offset:0\n\tds_read_b64_tr_b16 %1, %8 offset:288\n\tds_read_b64_tr_b16 %2, %8 offset:576\n\tds_read_b64_tr_b16 %3, %8 offset:864\n\tds_read_b64_tr_b16 %4, %8 offset:4608\n\tds_read_b64_tr_b16 %5, %8 offset:4896\n\tds_read_b64_tr_b16 %6, %8 offset:5184\n\tds_read_b64_tr_b16 %7, %8 offset:5472\n\ts_waitcnt lgkmcnt(0)" : "=&v"(t[0]), "=&v"(t[1]), "=&v"(t[2]), "=&v"(t[3]), "=&v"(t[4]), "=&v"(t[5]), "=&v"(t[6]), "=&v"(t[7]) : "v"(lb) : "memory"); } else { asm volatile("ds_read_b64_tr_b16 %0, %8 offset:32\n\tds_read_b64_tr_b16 %1, %8 offset:320\n\tds_read_b64_tr_b16 %2, %8 offset:608\n\tds_read_b64_tr_b16 %3, %8 offset:896\n\tds_read_b64_tr_b16 %4, %8 offset:4640\n\tds_read_b64_tr_b16 %5, %8 offset:4928\n\tds_read_b64_tr_b16 %6, %8 offset:5216\n\tds_read_b64_tr_b16 %7, %8 offset:5504\n\ts_waitcnt lgkmcnt(0)" : "=&v"(t[0]), "=&v"(t[1]), "=&v"(t[2]), "=&v"(t[3]), "=&v"(t[4]), "=&v"(t[5]), "=&v"(t[6]), "=&v"(t[7]) : "v"(lb) : "memory"); }
#pragma unroll
            for (int jj = 0; jj < 2; ++jj) { const int j = jh * 2 + jj, nb = j >> 1, kc = (j & 1) * 4 + g; u32x4 o;
#pragma unroll
                for (int h = 0; h < 4; ++h) { const u32x2 w = t[jj * 4 + h];
                    o[h] = pk4_fp8(__uint_as_float(w.x << 16), __uint_as_float(w.x & 0xffff0000u), __uint_as_float(w.y << 16), __uint_as_float(w.y & 0xffff0000u)); }
                __builtin_nontemporal_store(o, (u32x4*)(W8 + d.ob + (size_t)(16 * nb + l16) * d.rs + 16 * kc)); } }
        return;
    }
    const float gv = gq[0];
#pragma unroll
    for (int i = 0; i < 16; ++i) { const int k = 4 * i + (lane >> 4); const float gg = __shfl(gv, k); const f32x4 x = v[i] * gg;
        u32x2 pk; pk.x = cvt_pk_bf16(x[0], x[1]); pk.y = cvt_pk_bf16(x[2], x[3]); *(LAS u32x2*)(scr + k * 144 + (lane & 15) * 8) = pk; }
    asm volatile("s_waitcnt lgkmcnt(0)" ::: "memory");
    const unsigned lb = sbase + (unsigned)((8 * g + r) * 144 + 8 * c);
#pragma unroll
    for (int jh = 0; jh < 2; ++jh) {
        if (jh == 0) { asm volatile("ds_read_b64_tr_b16 %0, %8 offset:0\n\tds_read_b64_tr_b16 %1, %8 offset:576\n\tds_read_b64_tr_b16 %2, %8 offset:4608\n\tds_read_b64_tr_b16 %3, %8 offset:5184\n\tds_read_b64_tr_b16 %4, %8 offset:32\n\tds_read_b64_tr_b16 %5, %8 offset:608\n\tds_read_b64_tr_b16 %6, %8 offset:4640\n\tds_read_b64_tr_b16 %7, %8 offset:5216\n\ts_waitcnt lgkmcnt(0)" : "=&v"(t[0]), "=&v"(t[1]), "=&v"(t[2]), "=&v"(t[3]), "=&v"(t[4]), "=&v"(t[5]), "=&v"(t[6]), "=&v"(t[7]) : "v"(lb) : "memory"); } else { asm volatile("ds_read_b64_tr_b16 %0, %8 offset:64\n\tds_read_b64_tr_b16 %1, %8 offset:640\n\tds_read_b64_tr_b16 %2, %8 offset:4672\n\tds_read_b64_tr_b16 %3, %8 offset:5248\n\tds_read_b64_tr_b16 %4, %8 offset:96\n\tds_read_b64_tr_b16 %5, %8 offset:672\n\tds_read_b64_tr_b16 %6, %8 offset:4704\n\tds_read_b64_tr_b16 %7, %8 offset:5280\n\ts_waitcnt lgkmcnt(0)" : "=&v"(t[0]), "=&v"(t[1]), "=&v"(t[2]), "=&v"(t[3]), "=&v"(t[4]), "=&v"(t[5]), "=&v"(t[6]), "=&v"(t[7]) : "v"(lb) : "memory"); }
#pragma unroll
        for (int jj = 0; jj < 4; ++jj) { const int j = jh * 4 + jj, nb = j >> 1, kc = (j & 1) * 4 + g; u32x4 o; o.x = t[2 * jj].x; o.y = t[2 * jj].y; o.z = t[2 * jj + 1].x; o.w = t[2 * jj + 1].y;
            *(u32x4*)(d.WT + d.ob + (size_t)(16 * nb + l16) * d.rs + 8 * kc) = o; } }
}

#ifndef DUP_MASK
#define DUP_MASK 0
#endif
struct MArgs { const float* in[30]; float* out; unsigned char* ws; int ph_lo, ph_hi; };
__global__ void __launch_bounds__(NTHR, 2) mega(MArgs args) {
    extern __shared__ __attribute__((aligned(16))) unsigned char lds_raw[];
    LAS unsigned char* lds = (LAS unsigned char*)lds_raw;
    const int tid = threadIdx.x;
    const int G = gridDim.x;
    unsigned char* ws = args.ws;
    unsigned* ctl = (unsigned*)(ws + WS_CTL);
    bf16_t* WB = (bf16_t*)(ws + WS_WBF);
    float* PART = (float*)(ws + WS_PART);
    LAS float* PL = (LAS float*)(lds + MISC_OFF + 4096);
    volatile LAS unsigned* MISC = (volatile LAS unsigned*)(lds + MISC_OFF);
    if (tid < 64) MISC[tid] = 0u;
    __syncthreads();
    const int lo = args.ph_lo, hi = args.ph_hi;
    const bool multi = (hi - lo) > 1;
    XcdBarrier bar; bar.bar = ctl + CW_BAR; bar.x = 0; bar.st = nullptr;
    if (multi) bar = xcd_barrier_post(ctl + CW_BAR, MISC + 8);
#define IN(k) (lo <= (k) && (k) < hi)
#define REP(k) for (int rep_ = 0; rep_ <= ((DUP_MASK >> (k)) & 1); ++rep_)
#define SEAM(k) do { if (IN(k) && IN((k) + 1)) xcd_barrier(bar); } while (0)
    const int NGW = G * NWAVES;
#define PHASE_IDS() const int ptid = opaque_tid(), lane = ptid & 63, wave = __builtin_amdgcn_readfirstlane(ptid >> 6), gw = blockIdx.x * NWAVES + wave; (void)lane; (void)gw

    constexpr int I_IN0 = (D / 64) * (INC / 64), I_SQ = (D / 64) * (D / 64), I_FF = (D / 64) * (FF / 64), I_DN = (FF / 64) * (D / 64), I_IN1 = (D / 64) * (2 * D / 64), I_LRU = 64 * 4;
    constexpr int NITEMS = I_IN0 + I_SQ + 2 * I_FF + I_DN + I_IN1 + I_SQ + I_LRU + NE * (2 * I_FF + I_DN);
    constexpr int NDENSE = I_IN0 + I_LRU;
    constexpr int QLRU = I_IN0 + I_SQ + 2 * I_FF + I_DN + I_IN1 + I_SQ;
    constexpr int QA = QLRU - I_IN0;
    constexpr int TAIL_ITEMS = 24576, TAILQ = ((NITEMS - I_IN0 - I_LRU) - TAIL_ITEMS) & ~15;
    static_assert(QA % 16 == 0 && (INC / 64) % 16 == 0 && (D / 64) % 16 == 0 && (FF / 64) % 16 == 0 && (2 * D / 64) % 16 == 0 && (FF / 32) % 16 == 0 && (D / 32) % 16 == 0, "a 16-item queue chunk stays inside one (matrix, k-block)");
    REP(0) if (IN(0)) { PHASE_IDS();
        LAS unsigned char* scr = lds + wave * 16384;
#define TDECODE(dd, it_) do { int r = (it_); \
            if (r < I_IN0) { tmake(dd, args.in[2], D, INC, WB + WT_IN0, 0, args.in[1], r); break; } r -= I_IN0; \
            if (r < I_SQ) { tmake(dd, args.in[9], D, D, WB + WT_OUT0, 0, nullptr, r); break; } r -= I_SQ; \
            if (r < I_FF) { tmake(dd, args.in[11], D, FF, WB + WT_GU0, 1, args.in[10], r, FFNGU8); break; } r -= I_FF; \
            if (r < I_FF) { tmake(dd, args.in[12], D, FF, WB + WT_GU0, 2, args.in[10], r, FFNGU8); break; } r -= I_FF; \
            if (r < I_DN) { tmake(dd, args.in[13], FF, D, WB + WT_DN0, 0, nullptr, r, FFNDN8); break; } r -= I_DN; \
            if (r < I_IN1) { tmake(dd, args.in[15], D, 2 * D, WB + WT_IN1, 0, args.in[14], r); break; } r -= I_IN1; \
            if (r < I_SQ) { tmake(dd, args.in[23], D, D, WB + WT_OUT1, 0, nullptr, r); break; } r -= I_SQ; \
            if (r < I_LRU) { const int mat = r >> 2, sub = r & 3; const float* src = (mat < 32 ? args.in[18] : args.in[20]) + (size_t)(mat & 31) * LBD * LBD; \
                tmake(dd, src, LBD, LBD, WB + WT_LRU + (size_t)mat * LBD * LBD, 0, nullptr, sub); break; } r -= I_LRU; \
            { const int per = 2 * I_FF + I_DN, e = r / per; int q = r % per; \
              if (q < I_FF) { tmake(dd, args.in[26] + (size_t)e * D * FF, D, FF, (bf16_t*)((unsigned char*)(WB + WT_MGU) + (size_t)e * 2 * FF * D), 1, args.in[24], q, 1); break; } q -= I_FF; \
              if (q < I_FF) { tmake(dd, args.in[27] + (size_t)e * D * FF, D, FF, (bf16_t*)((unsigned char*)(WB + WT_MGU) + (size_t)e * 2 * FF * D), 2, args.in[24], q, 1); break; } q -= I_FF; \
              tmake(dd, args.in[28] + (size_t)e * FF * D, FF, D, (bf16_t*)((unsigned char*)(WB + WT_MDN) + (size_t)e * FF * D), 0, nullptr, q, 1); } } while (0)
        { TDesc dc, dn; f32x4 cur[16], nxt[16]; float gc[2], gn2[2]; int it = gw;
#define P0_ITEM(i_) ((i_) < I_IN0 ? (i_) : (i_) - I_IN0 + QLRU)
          if (it < NDENSE) { TDECODE(dc, P0_ITEM(it)); tload(dc, cur, gc, lane); }
          for (; it < NDENSE; it += NGW) {
              const int nit = it + NGW; const bool hn = nit < NDENSE;
              if (hn) { TDECODE(dn, P0_ITEM(nit)); tload(dn, nxt, gn2, lane); }
              tstore(dc, cur, gc, scr, lane);
              if (hn) { dc = dn; gc[0] = gn2[0]; gc[1] = gn2[1];
#pragma unroll
                  for (int i = 0; i < 16; ++i) cur[i] = nxt[i]; } }
#undef P0_ITEM
        }
        { float* C8 = (float*)(ws + WS_C8SP);
          for (int i = blockIdx.x * NTHR + tid; i < 2 * D; i += G * NTHR) { const float ap = args.in[22][i]; const float sp = (-ap > 20.f) ? -ap : log1pf(expf(-ap)); C8[i] = -8.0f * sp * 1.4426950408889634f; } }
        { float* RC = (float*)(ws + WS_ROPE); float* RS = RC + S * 32;
          for (int i = blockIdx.x * NTHR + tid; i < S * 32; i += G * NTHR) { const int s = i / 32, j = i % 32; const float inv = 1.0f / powf(10000.0f, (float)(2 * j) / 64.0f); const float ang = (float)s * inv; RC[i] = cosf(ang); RS[i] = sinf(ang); } }
        { bf16_t* XB = (bf16_t*)(ws + WS_XB);
          for (int m = gw; m < T; m += NGW) { const f32x4* xr = (const f32x4*)(args.in[0] + (size_t)m * D) + lane; float ss = 0.f;
#pragma unroll
              for (int j = 0; j < 8; ++j) { const f32x4 v = xr[64 * j]; ss += (v[0] * v[0] + v[1] * v[1]) + (v[2] * v[2] + v[3] * v[3]);
                  u32x2 w; w.x = cvt_pk_bf16(v[0], v[1]); w.y = cvt_pk_bf16(v[2], v[3]); *((u32x2*)(XB + (size_t)m * D) + lane + 64 * j) = w; }
              ss = wave_sum(ss); if (lane < 8) PART[(size_t)m * 8 + lane] = (lane == 0) ? ss : 0.f; } }
    }
    SEAM(0);
    REP(1) if (IN(1)) {
        Gemm g{(const bf16_t*)(ws + WS_XB), WB + WT_IN0, INC, D, 0}; StaticOrder So; So.init(T, INC, G, (int)blockIdx.x);
        EpiQkv E{(bf16_t*)(ws + WS_QKV), PART, (const float*)(ws + WS_ROPE), (const float*)(ws + WS_ROPE) + S * 32};
        gemm_phase<EpiQkv, StaticOrder, 2, false>(lds, g, So, E);
    }
    SEAM(1);
    REP(2) if (IN(2)) { PHASE_IDS();
        const bf16_t* QKV = (const bf16_t*)(ws + WS_QKV); bf16_t* ATT = (bf16_t*)(ws + WS_ATT);
        float s1 = 0.f, s2 = 0.f;
        for (int i = 0; i < 64; ++i) { s1 += args.in[4][i] * args.in[5][i]; s2 += args.in[6][i] * args.in[7][i]; }
        const float lam = expf(s1) - expf(s2) + 0.2f;
        const unsigned myx = xb_xcc_id() & 7u;
        if (tid == 0) MISC[16] = xb_add(ctl + CW_XRANK + 64 * myx, 1u);
        __syncthreads();
        const bool conv_first = (unsigned)__builtin_amdgcn_readfirstlane((int)MISC[16]) < (unsigned)NCV_PER_XCD;
#define P2_NEXT(dd, ok) do { if (crem == 0) { if (!qhave) { cstepn = (qpos >= TAILQ) ? 4 : 16; qnext = 4 * (int)__builtin_amdgcn_readfirstlane((int)(lane == 0 ? xb_add(ctl + CW_CVQ, (unsigned)(cstepn >> 2)) : 0u)); } \
                qpos = qnext; crem = cstepn; cbase = -1; qhave = false; } \
            if (cbase < 0 || (qpos & 15) == 0) { const int item_ = I_IN0 + qpos + (qpos >= QA ? I_LRU : 0); cvalid = item_ < NITEMS; if (cvalid) { TDECODE(cd, item_); } cbase = qpos; } \
            ok = cvalid; if (ok) { dd = cd; dd.n0 = cd.n0 + (qpos - cbase) * (cd.f8 ? 32 : 64); dd.rbase = (cd.mode == 0) ? dd.n0 : (256 * (dd.n0 >> 7) + (dd.n0 & 127) + (cd.mode == 2 ? 128 : 0)); tfix(dd); } \
            ++qpos; --crem; qwant = (crem == 0) && cvalid; } while (0)
#define P2_POST() do { if (qwant) { cstepn = (qpos >= TAILQ) ? 4 : 16; qnext = 4 * (int)__builtin_amdgcn_readfirstlane((int)(lane == 0 ? xb_add(ctl + CW_CVQ, (unsigned)(cstepn >> 2)) : 0u)); qhave = true; qwant = false; } } while (0)
#define P2_CONVERT() do { LAS unsigned char* scr = lds + wave * 16384; TDesc cd, dc, dn; f32x4 cur[16], nxt[16]; float gc[2], gn2[2]; int qpos = 0, crem = 0, cbase = -1, cstepn = 16, qnext = 0; bool cvalid = false, qhave = false, qwant = false, okc, okn; \
            P2_NEXT(dc, okc); if (okc) tload(dc, cur, gc, lane); P2_POST(); \
            while (okc) { \
                P2_NEXT(dn, okn); if (okn) tload(dn, nxt, gn2, lane); P2_POST(); \
                tstore(dc, cur, gc, scr, lane); \
                if (okn) { dc = dn; gc[0] = gn2[0]; gc[1] = gn2[1]; _Pragma("unroll") for (int i = 0; i < 16; ++i) cur[i] = nxt[i]; } \
                okc = okn; } \
            __syncthreads(); } while (0)
#define P2_CONVERT3() do { const int lane = opaque_tid() & 63; LAS unsigned char* scr = lds + wave * 16384; TDesc cd, d0, d1, d2; f32x4 b0[16], b1[16], b2[16]; float g0q[2], g1q[2], g2q[2]; int qpos = 0, crem = 0, cbase = -1, cstepn = 16, qnext = 0; bool cvalid = false, qhave = false, qwant = false, k0, k1, k2; \
            P2_NEXT(d0, k0); if (k0) tload(d0, b0, g0q, lane); P2_POST(); \
            P2_NEXT(d1, k1); if (k1) tload(d1, b1, g1q, lane); P2_POST(); \
            while (k0) { \
                P2_NEXT(d2, k2); if (k2) tload(d2, b2, g2q, lane); P2_POST(); \
                tstore(d0, b0, g0q, scr, lane); \
                if (!k1) break; \
                P2_NEXT(d0, k0); if (k0) tload(d0, b0, g0q, lane); P2_POST(); \
                tstore(d1, b1, g1q, scr, lane); \
                if (!k2) break; \
                P2_NEXT(d1, k1); if (k1) tload(d1, b1, g1q, lane); P2_POST(); \
                tstore(d2, b2, g2q, scr, lane); } \
            } while (0)
        if (conv_first) { P2_CONVERT3(); __syncthreads(); }
#pragma unroll 1
        for (unsigned qx = 0; qx < 8; ++qx) { const unsigned x = (myx + qx) & 7u;
            for (;;) {
                __syncthreads();
                if (tid == 0) MISC[17] = xb_add(ctl + CW_AQ + 64 * x, 1u);
                __syncthreads();
                const unsigned u = MISC[17]; if (u >= 96u) break;
                if (u < 64u) { const int bh = 2 * (int)x + (int)(u >> 5), qb = (int)(u & 31u); att::attn_unit<0>(QKV, ATT, bh >> 3, bh & 7, qb, lds, args.in[8], lam, nullptr); }
                else { const int c = (int)u - 64, bh = 2 * (int)x + (c >> 4), rb = c & 15; att::na_unit(QKV, ATT, bh >> 3, bh & 7, rb, lds, args.in[3]); } } }
        __syncthreads();
        if (!conv_first) { P2_CONVERT3(); __syncthreads(); }
#undef P2_CONVERT
#undef P2_CONVERT3
#undef P2_NEXT
#undef P2_POST
    }
#undef TDECODE
    SEAM(2);
    REP(3) if (IN(3)) {
        Gemm g{(const bf16_t*)(ws + WS_ATT), WB + WT_OUT0, D, D, 0}; StaticOrder So; So.init(T, D, G, (int)blockIdx.x);
        EpiResid E{args.in[0], (float*)(ws + WS_X1), (bf16_t*)(ws + WS_XB), PART + 8 * T, PL, FFNGU8 ? (unsigned char*)(ws + WS_HA) : nullptr, 1.f};
        gemm_phase<EpiResid, StaticOrder, 0, false>(lds, g, So, E);
    }
    SEAM(3);
    REP(4) if (IN(4)) {
        Gemm g{(const bf16_t*)(ws + (FFNGU8 ? WS_HA : WS_XB)), WB + WT_GU0, 2 * FF, D, 0}; StaticOrder So; So.init(T, 2 * FF, G, (int)blockIdx.x);
        EpiGateUp<false, FFNDN8, FFNGU8> E{(bf16_t*)(ws + WS_ACT), PART + 8 * T, nullptr};
        gemm_phase<EpiGateUp<false, FFNDN8, FFNGU8>, StaticOrder, 1, false, FFNGU8>(lds, g, So, E);
    }
    SEAM(4);
    REP(5) if (IN(5)) {
        Gemm g{(const bf16_t*)(ws + WS_ACT), WB + WT_DN0, D, FF, 0}; StaticOrder So; So.init(T, D, G, (int)blockIdx.x);
        EpiResid E{(const float*)(ws + WS_X1), (float*)(ws + WS_X2), (bf16_t*)(ws + WS_XB), PART + 16 * T, PL, nullptr, FFNDN8 ? W8_INV : 1.f};
        gemm_phase<EpiResid, StaticOrder, 0, false, FFNDN8>(lds, g, So, E);
    }
    SEAM(5);
    REP(6) if (IN(6)) {
        Gemm g{(const bf16_t*)(ws + WS_XB), WB + WT_IN1, 2 * D, D, 0}; StaticOrder So; So.init(T, 2 * D, G, (int)blockIdx.x);
        EpiL1In E{(bf16_t*)(ws + WS_Y), (bf16_t*)(ws + WS_REC), PART + 16 * T};
        gemm_phase<EpiL1In, StaticOrder, 1, false>(lds, g, So, E);
    }
    SEAM(6);
    REP(7) if (IN(7)) {
        const int ptid = opaque_tid(), wv = __builtin_amdgcn_readfirstlane(ptid >> 6);
        const bf16_t* REC = (const bf16_t*)(ws + WS_REC); bf16_t* AB = (bf16_t*)(ws + WS_AB); const float* C8 = (const float*)(ws + WS_C8SP);
        float* SUMM = (float*)(ws + WS_SUMM);
        LAS unsigned char* Us = lds;
        LAS unsigned char* Ws = lds + 65536;
        LAS float* BL = (LAS float*)(lds + MISC_OFF + 8192);
        LAS unsigned char* TB = Us + wv * 8192;
#define SWZ(row, colB) ((row) * 256 + ((colB) ^ (((row) & 7) << 4)))
        constexpr float L2E = 1.4426950408889634f;
        for (int unit = blockIdx.x; unit < (T / 256) * LB; unit += G) {
            const int nb_ = unit % LB, tt = unit / LB, t0 = tt * 256, c0 = nb_ * LBD;
            {
              const int ctid = opaque_tid(); const int cg = ctid & 15, tr = ctid >> 4, cc = c0 + cg * 8; const int tb = t0 & ~(S - 1);
              float w8[4][8], b8[8];
              { const f32x4 b0 = *(const f32x4*)(args.in[17] + cc), b1 = *(const f32x4*)(args.in[17] + cc + 4);
#pragma unroll
                for (int i = 0; i < 4; ++i) { b8[i] = b0[i]; b8[4 + i] = b1[i]; } }
#pragma unroll
              for (int j = 0; j < 4; ++j) { const f32x4 x0 = *(const f32x4*)(args.in[16] + j * D + cc), x1 = *(const f32x4*)(args.in[16] + j * D + cc + 4);
#pragma unroll
                  for (int i = 0; i < 4; ++i) { w8[j][i] = x0[i]; w8[j][4 + i] = x1[i]; } }
              u32x4 rv[11];
#pragma unroll
              for (int q = 0; q < 11; ++q) { const int t = t0 + tr * 8 + q - 1; const bool ok = (t >= tb) && (t < tb + S);
                  rv[q] = ok ? *(const u32x4*)(REC + ((size_t)(t >> 8) * LB + nb_) * (256 * LBD) + (size_t)(t & 255) * LBD + cg * 8) : (u32x4){0u, 0u, 0u, 0u}; }
#pragma unroll
              for (int q = 0; q < 8; ++q) { float uo[8];
#pragma unroll
                  for (int i = 0; i < 8; ++i) { float acc_ = b8[i];
#pragma unroll
                      for (int j = 0; j < 4; ++j) { const unsigned w = rv[q + j][i >> 1]; acc_ += w8[j][i] * __uint_as_float((i & 1) ? (w & 0xffff0000u) : (w << 16)); }
                      uo[i] = acc_; }
                  u32x4 pk; pk.x = cvt_pk_bf16(uo[0], uo[1]); pk.y = cvt_pk_bf16(uo[2], uo[3]); pk.z = cvt_pk_bf16(uo[4], uo[5]); pk.w = cvt_pk_bf16(uo[6], uo[7]);
                  *(LAS u32x4*)(Us + SWZ(tr * 8 + q, cg * 16)) = pk; } }
            asm volatile("s_waitcnt lgkmcnt(0)" ::: "memory");
            bf16x8 uf[2][4]; const int ul = opaque_tid();
#pragma unroll
            for (int tg = 0; tg < 2; ++tg)
#pragma unroll
                for (int ks = 0; ks < 4; ++ks) uf[tg][ks] = *(const LAS bf16x8*)(Us + SWZ((ul >> 6) * 32 + tg * 16 + (ul & 15), 64 * ((ul >> 4) & 3) + 16 * ks));
#pragma unroll 1
            for (int dir = 0; dir < 2; ++dir) {
                __syncthreads();
                { const int stid = opaque_tid();
                  const bf16_t* wa = WB + WT_LRU + (size_t)(0 * 32 + dir * 16 + nb_) * LBD * LBD; const bf16_t* wx = WB + WT_LRU + (size_t)(1 * 32 + dir * 16 + nb_) * LBD * LBD;
#pragma unroll
                  for (int q = 0; q < 4; ++q) { const int idx = stid + q * NTHR, slot = idx >> 4, ch = idx & 15, row = 32 * ((slot & 15) >> 2) + 4 * (slot >> 4) + (slot & 3);
                      *(LAS u32x4*)(Ws + SWZ(slot, ch * 16)) = *(const u32x4*)(wa + row * LBD + ch * 8);
                      *(LAS u32x4*)(Ws + 32768 + SWZ(slot, ch * 16)) = *(const u32x4*)(wx + row * LBD + ch * 8); }
                  if (dir == 0) { for (int i = stid; i < 768; i += NTHR) { const int d_ = i / 384, k_ = (i >> 7) % 3, c_ = i & 127;
                      BL[i] = (k_ == 0) ? -L2E * args.in[19][d_ * D + c0 + c_] : (k_ == 1) ? -L2E * args.in[21][d_ * D + c0 + c_] : C8[d_ * D + c0 + c_]; } } }
                __syncthreads();
                f32x4 aa[2][8], ax[2][8]; const int ml = opaque_tid() & 63, mfr = ml & 15, mfq = ml >> 4;
#pragma unroll
                for (int nb = 0; nb < 8; ++nb) { aa[0][nb] = (f32x4){0.f, 0.f, 0.f, 0.f}; ax[0][nb] = aa[0][nb]; aa[1][nb] = aa[0][nb]; ax[1][nb] = aa[0][nb]; }
#pragma unroll
                for (int ks = 0; ks < 4; ++ks)
#pragma unroll
                    for (int nb = 0; nb < 8; ++nb) { const bf16x8 wfa = *(const LAS bf16x8*)(Ws + SWZ(nb * 16 + mfr, 64 * mfq + 16 * ks)), wfx = *(const LAS bf16x8*)(Ws + 32768 + SWZ(nb * 16 + mfr, 64 * mfq + 16 * ks));
                        aa[0][nb] = __builtin_amdgcn_mfma_f32_16x16x32_bf16(wfa, uf[0][ks], aa[0][nb], 0, 0, 0); ax[0][nb] = __builtin_amdgcn_mfma_f32_16x16x32_bf16(wfx, uf[0][ks], ax[0][nb], 0, 0, 0);
                        aa[1][nb] = __builtin_amdgcn_mfma_f32_16x16x32_bf16(wfa, uf[1][ks], aa[1][nb], 0, 0, 0); ax[1][nb] = __builtin_amdgcn_mfma_f32_16x16x32_bf16(wfx, uf[1][ks], ax[1][nb], 0, 0, 0); }
                const int l2 = opaque_tid() & 63, fr2 = l2 & 15, fq2 = l2 >> 4;
                const LAS float* blp = BL + dir * 384 + 32 * fq2;
                float sml[2][2], smh[2][2];
#pragma unroll
                for (int tg = 0; tg < 2; ++tg) {
#pragma unroll
                    for (int nb = 0; nb < 8; ++nb) {
                        const f32x4 ba = *(const LAS f32x4*)(blp + 4 * nb), bx = *(const LAS f32x4*)(blp + 128 + 4 * nb), c8 = *(const LAS f32x4*)(blp + 256 + 4 * nb);
                        const unsigned w0 = (unsigned)(unsigned short)uf[tg][nb >> 1][(nb & 1) * 4 + 0] | ((unsigned)(unsigned short)uf[tg][nb >> 1][(nb & 1) * 4 + 1] << 16);
                        const unsigned w1 = (unsigned)(unsigned short)uf[tg][nb >> 1][(nb & 1) * 4 + 2] | ((unsigned)(unsigned short)uf[tg][nb >> 1][(nb & 1) * 4 + 3] << 16);
                        const float uvv[4] = {__uint_as_float(w0 << 16), __uint_as_float(w0 & 0xffff0000u), __uint_as_float(w1 << 16), __uint_as_float(w1 & 0xffff0000u)};
                        float av[4], bv[4];
#pragma unroll
                        for (int i = 0; i < 4; ++i) { const float ga = __builtin_amdgcn_rcpf(1.f + __builtin_amdgcn_exp2f(fmaf(aa[tg][nb][i], -L2E, ba[i]))), gx = __builtin_amdgcn_rcpf(1.f + __builtin_amdgcn_exp2f(fmaf(ax[tg][nb][i], -L2E, bx[i])));
                            const float la2 = c8[i] * ga; const float a = __builtin_amdgcn_exp2f(la2);
                            av[i] = la2; bv[i] = __builtin_amdgcn_sqrtf(fmaxf(fmaf(-a, a, 1.f), 0.f)) * gx * uvv[i]; }
                        u32x2 pa, pb; pa.x = cvt_pk_bf16(av[0], av[1]); pa.y = cvt_pk_bf16(av[2], av[3]); pb.x = cvt_pk_bf16(bv[0], bv[1]); pb.y = cvt_pk_bf16(bv[2], bv[3]);
                        const int off = fr2 * 256 + (((4 * fq2 + (nb >> 1)) ^ fr2) << 4) + (nb & 1) * 8;
                        *(LAS u32x2*)(TB + off) = pa; *(LAS u32x2*)(TB + 4096 + off) = pb; }
                    asm volatile("s_waitcnt lgkmcnt(0)" ::: "memory");
#pragma unroll
                    for (int q = 0; q < 4; ++q) { const int row = 4 * q + fq2, chunk = fr2; const size_t go = (size_t)(wv * 32 + tg * 16 + row) * LBD + 8 * chunk;
                        const u32x4 va = *(const LAS u32x4*)(TB + row * 256 + ((chunk ^ row) << 4)), vb = *(const LAS u32x4*)(TB + 4096 + row * 256 + ((chunk ^ row) << 4));
                        *(u32x4*)(AB + (size_t)(unit * 4 + dir * 2 + 0) * (256 * LBD) + go) = va; *(u32x4*)(AB + (size_t)(unit * 4 + dir * 2 + 1) * (256 * LBD) + go) = vb; }
                    { float sl0 = 0.f, sl1 = 0.f, h0 = 0.f, h1 = 0.f; const int cc16 = (l2 >> 2) << 4, cin = (l2 & 3) * 4;
#pragma unroll
                      for (int i = 0; i < 16; ++i) { const int ri = dir ? 15 - i : i; const int ad = ri * 256 + (cc16 ^ (ri << 4)) + cin;
                          const unsigned wa_ = *(const LAS unsigned*)(TB + ad), wb_ = *(const LAS unsigned*)(TB + 4096 + ad);
                          const float la0 = __uint_as_float(wa_ << 16), la1 = __uint_as_float(wa_ & 0xffff0000u);
                          h0 = fmaf(__builtin_amdgcn_exp2f(la0), h0, __uint_as_float(wb_ << 16)); h1 = fmaf(__builtin_amdgcn_exp2f(la1), h1, __uint_as_float(wb_ & 0xffff0000u));
                          sl0 += la0; sl1 += la1; }
                      sml[tg][0] = sl0; sml[tg][1] = sl1; smh[tg][0] = h0; smh[tg][1] = h1; }
                }
                {
                  const int c = c0 + 2 * l2, b_ = t0 / S, chk = ((t0 & (S - 1)) >> 5) + wv;
                  f32x2 Pv, Hv;
#pragma unroll
                  for (int j = 0; j < 2; ++j) { const float A0 = __builtin_amdgcn_exp2f(sml[0][j]), A1 = __builtin_amdgcn_exp2f(sml[1][j]);
                      Pv[j] = __builtin_amdgcn_exp2f(sml[0][j] + sml[1][j]); Hv[j] = dir ? fmaf(A0, smh[1][j], smh[0][j]) : fmaf(A1, smh[0][j], smh[1][j]); }
                  float* sp = SUMM + ((size_t)((b_ * 2 + dir) * 128 + chk) * D) * 2 + (size_t)(c >> 2) * 8 + (c & 3);
                  *(f32x2*)sp = Pv; *(f32x2*)(sp + 4) = Hv; }
            }
        }
#undef SWZ
        __syncthreads();
    }
    SEAM(7);
    REP(9) if (IN(9)) {
        const int ptid = opaque_tid();
        const float* SUMM = (const float*)(ws + WS_SUMM); float* CARRY = (float*)(ws + WS_CARRY);
        for (int it = blockIdx.x * NTHR + ptid; it < NB * 2 * (D / 4) * 16; it += G * NTHR) {
            const int seg = it & 15, c4 = (it >> 4) % (D / 4), dir = ((it >> 4) / (D / 4)) % 2, b = (it >> 4) / (D / 4) / 2;
            f32x4 P[8], H[8];
#pragma unroll
            for (int j = 0; j < 8; ++j) { const int k = seg * 8 + j, ch = dir ? 127 - k : k; const size_t base = (size_t)((b * 2 + dir) * 128 + ch) * D + c4 * 4;
                P[j] = *(const f32x4*)(SUMM + base * 2); H[j] = *(const f32x4*)(SUMM + base * 2 + 4); }
            f32x4 A = P[0], Bv = H[0];
#pragma unroll
            for (int j = 1; j < 8; ++j) { Bv = P[j] * Bv + H[j]; A = A * P[j]; }
#pragma unroll
            for (int off = 1; off < 16; off <<= 1) { f32x4 Ap, Bp;
#pragma unroll
                for (int q = 0; q < 4; ++q) { Ap[q] = __shfl_up(A[q], off, 16); Bp[q] = __shfl_up(Bv[q], off, 16); }
                if (seg >= off) { Bv = A * Bp + Bv; A = A * Ap; } }
            f32x4 h;
#pragma unroll
            for (int q = 0; q < 4; ++q) h[q] = __shfl_up(Bv[q], 1, 16);
            if (seg == 0) h = (f32x4){0.f, 0.f, 0.f, 0.f};
#pragma unroll
            for (int j = 0; j < 8; ++j) { const int k = seg * 8 + j, ch = dir ? 127 - k : k; const size_t base = (size_t)((b * 2 + dir) * 128 + ch) * D + c4 * 4;
                *(f32x4*)(CARRY + base) = h; h = P[j] * h + H[j]; }
        }
    }
    SEAM(9);
    REP(10) if (IN(10)) {
        const int ptid = opaque_tid();
        const bf16_t* AB = (const bf16_t*)(ws + WS_AB); const float* CARRY = (const float*)(ws + WS_CARRY); const bf16_t* Y = (const bf16_t*)(ws + WS_Y); bf16_t* Z = (bf16_t*)(ws + WS_Z);
        for (int it = blockIdx.x * NTHR + ptid; it < NB * 128 * (D / 2); it += G * NTHR) {
            const int c2 = it % (D / 2), ch = (it / (D / 2)) % 128, b = it / (D / 2) / 128; const int c = c2 * 2;
            const bf16_t* af = AB + (size_t)((c >> 7) * 4) * (256 * LBD) + (c & 127); const bf16_t* bf = af + 256 * LBD; const bf16_t* ab = af + 2 * 256 * LBD; const bf16_t* bb = af + 3 * 256 * LBD;
#define LD2(p) ({ const unsigned _w = *(const unsigned*)(p); (f32x2){__uint_as_float(_w << 16), __uint_as_float(_w & 0xffff0000u)}; })
#define EXP2V(v) ((f32x2){__builtin_amdgcn_exp2f((v)[0]), __builtin_amdgcn_exp2f((v)[1])})
            f32x2 h = *(const f32x2*)(CARRY + (size_t)((b * 2 + 0) * 128 + ch) * D + c);
            LAS f32x2* hf = (LAS f32x2*)lds + ptid;
            const size_t o0 = (size_t)(b * S + ch * 32) * D; const int tk0 = b * S + ch * 32; const size_t q0 = (size_t)(tk0 >> 8) * (LB * 4 * 256 * LBD) + (size_t)(tk0 & 255) * LBD;
#pragma unroll 8
            for (int i = 0; i < 32; ++i) { const size_t o = q0 + (size_t)i * LBD; const f32x2 la = LD2(af + o); h = EXP2V(la) * h + LD2(bf + o); hf[i * NTHR] = h; }
            h = *(const f32x2*)(CARRY + (size_t)((b * 2 + 1) * 128 + ch) * D + c);
#pragma unroll 8
            for (int i = 31; i >= 0; --i) { const size_t o = o0 + (size_t)i * D, q = q0 + (size_t)i * LBD; const f32x2 la = LD2(ab + q); h = EXP2V(la) * h + LD2(bb + q);
                const unsigned yv = *(const unsigned*)(Y + o + c); const float y0 = __uint_as_float(yv << 16), y1 = __uint_as_float(yv & 0xffff0000u);
                const f32x2 hv = hf[i * NTHR];
                *(unsigned*)(Z + o + c) = cvt_pk_bf16(y0 * (hv[0] + h[0]), y1 * (hv[1] + h[1])); }
#undef LD2
#undef EXP2V
        }
    }
    SEAM(10);
    REP(11) if (IN(11)) {
        Gemm g{(const bf16_t*)(ws + WS_Z), WB + WT_OUT1, D, D, 0}; StaticOrder So; So.init(T, D, G, (int)blockIdx.x);
        EpiResid E{(const float*)(ws + WS_X2), (float*)(ws + WS_X1), (bf16_t*)(ws + WS_XB), PART + 24 * T, PL, nullptr, 1.f};
        gemm_phase<EpiResid, StaticOrder, 0, false>(lds, g, So, E);
    }
    SEAM(11);
    REP(12) if (IN(12)) { PHASE_IDS();
        const float* X3 = (const float*)(ws + WS_X1); const float* P3 = PART + 24 * T; const float* gn = args.in[24]; const float* rw = args.in[25];
        int* LIST = (int*)(ws + WS_LIST); int* INV = (int*)(ws + WS_INV); float* GATEW = (float*)(ws + WS_GATEW); unsigned* CNT = ctl + CW_CNT;
        volatile LAS int* sel = (volatile LAS int*)(lds + MISC_OFF + 8192);
        unsigned char* XN8 = (unsigned char*)(ws + WS_HA);
        LAS float* RT = (LAS float*)lds;
        f32x4 xr[8], xq[8];
        if ((int)blockIdx.x * 32 < T) {
#pragma unroll
            for (int j = 0; j < 8; ++j) xr[j] = *(const f32x4*)(X3 + (size_t)(blockIdx.x * 32 + wave * 4) * D + lane * 4 + 256 * j); }
        __syncthreads();
        for (int idx = tid; idx < D * 2; idx += NTHR) { const int c = idx >> 1, hf = idx & 1, slot = ((c >> 8) * 4 + (c & 3)) * 64 + ((c & 255) >> 2);
            *(LAS f32x4*)(RT + slot * 8 + hf * 4) = *(const f32x4*)(rw + (size_t)c * NE + hf * 4) * gn[c]; }
        __syncthreads();
        for (int t0 = blockIdx.x * 32; t0 < T; t0 += G * 32) {
            if (t0 != (int)blockIdx.x * 32) {
#pragma unroll
                for (int j = 0; j < 8; ++j) xr[j] = *(const f32x4*)(X3 + (size_t)(t0 + wave * 4) * D + lane * 4 + 256 * j); }
#pragma unroll 1
            for (int q = 0; q < 4; ++q) { const int tl = wave * 4 + q, t = t0 + tl;
                if (q < 3) {
#pragma unroll
                    for (int j = 0; j < 8; ++j) xq[j] = *(const f32x4*)(X3 + (size_t)(t + 1) * D + lane * 4 + 256 * j); }
                const float rstd = row_rstd(P3, t); float lg[NE];
#pragma unroll
                for (int e = 0; e < NE; ++e) lg[e] = 0.f;
#pragma unroll
                for (int j = 0; j < 8; ++j) { const int c0 = lane * 4 + 256 * j; const f32x4 xv = xr[j] * rstd;
                    *(unsigned*)(XN8 + (size_t)t * D + c0) = pk4_fp8(xv[0], xv[1], xv[2], xv[3]);
#pragma unroll
                    for (int i = 0; i < 4; ++i) { const float hv = xv[i]; const LAS float* rp = RT + ((j * 4 + i) * 64 + lane) * 8; const f32x4 r0 = *(const LAS f32x4*)rp, r1 = *(const LAS f32x4*)(rp + 4);
                        lg[0] += hv * r0[0]; lg[1] += hv * r0[1]; lg[2] += hv * r0[2]; lg[3] += hv * r0[3]; lg[4] += hv * r1[0]; lg[5] += hv * r1[1]; lg[6] += hv * r1[2]; lg[7] += hv * r1[3]; } }
#pragma unroll
                for (int e = 0; e < NE; ++e) lg[e] = wave_sum(lg[e]);
                int i1 = 0; float v1 = lg[0];
#pragma unroll
                for (int e = 1; e < NE; ++e) if (lg[e] > v1) { v1 = lg[e]; i1 = e; }
                int i2 = -1; float v2 = -3.0e38f;
#pragma unroll
                for (int e = 0; e < NE; ++e) if (e != i1 && lg[e] > v2) { v2 = lg[e]; i2 = e; }
                const float e2 = __expf(v2 - v1), g1 = 1.f / (1.f + e2), g2 = e2 / (1.f + e2);
                if (lane == 0) { sel[2 * tl] = i1; sel[2 * tl + 1] = i2; GATEW[2 * t] = g1; GATEW[2 * t + 1] = g2; }
#pragma unroll
                for (int j = 0; j < 8; ++j) xr[j] = xq[j];
            }
            __syncthreads();
            if (tid < NE) { int n = 0; for (int a = 0; a < 64; ++a) n += (sel[a] == tid) ? 1 : 0;
                sel[64 + tid] = n ? (int)__hip_atomic_fetch_add(CNT + tid, (unsigned)n, __ATOMIC_RELAXED, __HIP_MEMORY_SCOPE_AGENT) : 0; }
            __syncthreads();
            if (tid < 64) { const int e = sel[tid]; int rank = 0; for (int a = 0; a < tid; ++a) rank += (sel[a] == e) ? 1 : 0;
                const int ent = 2 * (t0 + (tid >> 1)) + (tid & 1), pos = sel[64 + e] + rank; LIST[e * T + pos] = ent; INV[ent] = e * T + pos; }
            __syncthreads();
        }
    }
    SEAM(12);
    if (IN(13) || IN(14)) {
        volatile LAS int* tab = (volatile LAS int*)(lds + MISC_OFF + 12288);
        if (tid < NE) tab[tid] = (int)__hip_atomic_load(ctl + CW_CNT + tid, __ATOMIC_RELAXED, __HIP_MEMORY_SCOPE_AGENT);
        __syncthreads();
        if (tid == 0) { int p = 0; for (int e = 0; e < NE; ++e) { tab[8 + e] = p; p += (tab[e] + BM - 1) / BM; } tab[16] = p; }
        __syncthreads();
        REP(13) if (IN(13)) {
            Gemm g{(const bf16_t*)(ws + WS_HA), WB + WT_MGU, 2 * FF, D, (size_t)2 * FF * D}; MoeOrder Mo; Mo.init(tab, (const int*)(ws + WS_LIST), 2 * FF / BM, G, (int)blockIdx.x);
            EpiGateUp<true> E{(bf16_t*)(ws + WS_MACT), PART + 24 * T, (const int*)(ws + WS_LIST)};
            gemm_phase<EpiGateUp<true>, MoeOrder, 1, true, true>(lds, g, Mo, E);
        }
        SEAM(13);
        REP(14) if (IN(14)) {
            Gemm g{(const bf16_t*)(ws + WS_MACT), WB + WT_MDN, D, FF, (size_t)FF * D}; MoeOrder Mo; Mo.init(tab, (const int*)(ws + WS_LIST), D / BM, G, (int)blockIdx.x); Mo.ksplit = (G == 256 && Mo.nwg >= 2 * G) ? 1 : 0; Mo.KT4 = FF / 128 / 4;
            EpiMoeDown E{(bf16_t*)(ws + WS_CONTRIB), (const int*)(ws + WS_LIST), (const float*)(ws + WS_GATEW), (float*)(ws + WS_PARTK)};
            gemm_phase<EpiMoeDown, MoeOrder, 0, false, true>(lds, g, Mo, E);
        }
    }
    SEAM(14);
    REP(15) if (IN(15)) { PHASE_IDS();
        const float* X3 = (const float*)(ws + WS_X1); const bf16_t* C = (const bf16_t*)(ws + WS_CONTRIB); const float* gn = args.in[29];
        const int* INV = (const int*)(ws + WS_INV); const float* GATEW = (const float*)(ws + WS_GATEW); const float* PARTK = (const float*)(ws + WS_PARTK);
        volatile LAS int* tab = (volatile LAS int*)(lds + MISC_OFF + 12288);
        __syncthreads();
        if (tid < NE) tab[tid] = (int)__hip_atomic_load(ctl + CW_CNT + tid, __ATOMIC_RELAXED, __HIP_MEMORY_SCOPE_AGENT);
        __syncthreads();
        if (tid == 0) { int p = 0; for (int e = 0; e < NE; ++e) { tab[8 + e] = p; p += (tab[e] + BM - 1) / BM; } tab[16] = p; }
        __syncthreads();
        const int nwg = __builtin_amdgcn_readfirstlane(tab[16]) * (D / BM); const bool ksplit = (G == 256 && nwg >= 2 * G);
        const int cq = nwg / NXCD, cr = nwg % NXCD, cb_ = cr * (cq + 1);
        for (int t = gw; t < T; t += NGW) { f32x4 v[8]; float ss = 0.f;
            u32x2 ca[2][8];
#pragma unroll
            for (int j = 0; j < 8; ++j) { v[j] = *(const f32x4*)(X3 + (size_t)t * D + lane * 4 + 256 * j);
                ca[0][j] = *(const u32x2*)(C + (size_t)(2 * t) * D + lane * 4 + 256 * j); ca[1][j] = *(const u32x2*)(C + (size_t)(2 * t + 1) * D + lane * 4 + 256 * j); }
            unsigned smask = 0u;
            int ridx_[2][8]; int lr_[2] = {0, 0}; float gw8_[2] = {0.f, 0.f};
            if (ksplit) {
#pragma unroll
                for (int k = 0; k < 2; ++k) { const int ent = 2 * t + k; const int inv = __builtin_amdgcn_readfirstlane(INV[ent]); const int e = inv >> 13, li = inv & (T - 1);
                    const int p0 = __builtin_amdgcn_readfirstlane(tab[8 + e]), npan = __builtin_amdgcn_readfirstlane(tab[9 + e]) - p0, pl = li >> 8; lr_[k] = li & 255; gw8_[k] = GATEW[ent] * W8_INV;
#pragma unroll
                    for (int j = 0; j < 8; ++j) { const int wg = p0 * (D / BM) + j * npan + pl; int x, off;
                        if (wg < cb_) { x = wg / (cq + 1); off = wg - x * (cq + 1); } else { const int w2 = wg - cb_; x = w2 / cq; off = w2 - x * cq; x += cr; }
                        ridx_[k][j] = (off - 2 * G / NXCD) * NXCD + x; if (off >= 2 * G / NXCD) smask |= 1u << (k * 8 + j); } } }
#pragma unroll
            for (int k = 0; k < 2; ++k)
#pragma unroll
                for (int j = 0; j < 8; ++j) { const u32x2 c2 = ca[k][j];
                    const f32x4 cv = {__uint_as_float(c2.x << 16), __uint_as_float(c2.x & 0xffff0000u), __uint_as_float(c2.y << 16), __uint_as_float(c2.y & 0xffff0000u)};
                    if (!((smask >> (k * 8 + j)) & 1u)) v[j] = v[j] + cv; }
            if (smask) {
#pragma unroll
                for (int k = 0; k < 2; ++k)
#pragma unroll
                    for (int j = 0; j < 8; ++j) if ((smask >> (k * 8 + j)) & 1u) { const float* pp = PARTK + ((size_t)(ridx_[k][j] * 4) << 16) + lr_[k] * BM + lane * 4;
                        const f32x4 sm = (*(const f32x4*)pp + *(const f32x4*)(pp + 65536)) + (*(const f32x4*)(pp + 2 * 65536) + *(const f32x4*)(pp + 3 * 65536));
                        v[j] = v[j] + sm * gw8_[k]; } }
#pragma unroll
            for (int j = 0; j < 8; ++j) ss += (v[j][0] * v[j][0] + v[j][1] * v[j][1]) + (v[j][2] * v[j][2] + v[j][3] * v[j][3]);
            ss = wave_sum(ss); const float rs = rsqrtf(ss * (1.0f / D) + EPS);
#pragma unroll
            for (int j = 0; j < 8; ++j) { const int c0 = lane * 4 + 256 * j; *(f32x4*)(args.out + (size_t)t * D + c0) = v[j] * rs * *(const f32x4*)(gn + c0); } }
    }
#undef IN
#undef SEAM
}

static int g_grid = 0;
static void mega_launch(hipStream_t st, const float* const* in, float* out, unsigned char* ws, int lo, int hi) {
    MArgs a{};
    for (int i = 0; i < 30; ++i) a.in[i] = in[i];
    a.out = out; a.ws = ws; a.ph_lo = lo; a.ph_hi = hi;
    hipLaunchKernelGGL(mega, dim3(g_grid), dim3(NTHR), LDS_BYTES, st, a);
}

extern "C" void kernel_launch(void* const* d_in, const int* in_sizes, int n_in, void* d_out, int out_size, void* d_ws, size_t ws_size, hipStream_t stream) {
    if (n_in != 30 || out_size != T * D || ws_size < WS_END2) { fprintf(stderr, "kernel_launch: unexpected shapes n_in %d out %d ws %zu (need %zu)\n", n_in, out_size, ws_size, (size_t)WS_END); return; }
    const float* const* in = (const float* const*)d_in;
    unsigned char* ws = (unsigned char*)d_ws;
    if (g_grid == 0) {
        int dev = 0, cus = 0;
        if (hipGetDevice(&dev) != hipSuccess || hipDeviceGetAttribute(&cus, hipDeviceAttributeMultiprocessorCount, dev) != hipSuccess) { fprintf(stderr, "kernel_launch: device query failed\n"); return; }
        if (hipFuncSetAttribute((const void*)mega, hipFuncAttributeMaxDynamicSharedMemorySize, LDS_BYTES) != hipSuccess) { fprintf(stderr, "kernel_launch: hipFuncSetAttribute failed\n"); return; }
        int per_cu = 0;
        if (hipOccupancyMaxActiveBlocksPerMultiprocessor(&per_cu, (const void*)mega, NTHR, LDS_BYTES) != hipSuccess || per_cu < 1) { fprintf(stderr, "kernel_launch: occupancy query says %d\n", per_cu); (void)hipGetLastError(); }
        g_grid = cus;
    }
    (void)hipMemsetAsync(ws + WS_CTL, 0, CTL_BYTES, stream);
    mega_launch(stream, in, (float*)d_out, ws, 0, 16);
}
```

```cpp
#include <hip/hip_runtime.h>
#include <stdint.h>
#include <stdio.h>

typedef unsigned short bf16_t;
typedef short bf16x8 __attribute__((ext_vector_type(8)));
typedef float f32x4 __attribute__((ext_vector_type(4)));

constexpr int NB = 2, S = 4096, T = NB * S, D = 2048;
constexpr int HD = 128, NAH = 8, DAH = 8, DQ = 64;
constexpr int GW = 64, GR = S / GW, KH = 8, KW = 16;
constexpr int INC = 6144, FF = 7168, NE = 8;
constexpr int LB = 16, LBD = 128;
constexpr float EPS = 1e-6f;

constexpr size_t MiB = 1048576;
constexpr size_t WS_WBF = 0;
constexpr size_t WS_X1 = 816 * MiB;
constexpr size_t WS_X2 = WS_X1 + 64 * MiB;
constexpr size_t WS_HA = WS_X2 + 64 * MiB;
constexpr size_t WS_HB = WS_HA + 32 * MiB;
constexpr size_t WS_R1 = WS_HB + 32 * MiB;
constexpr size_t WS_QKV = WS_R1;
constexpr size_t WS_ATT = WS_R1 + 96 * MiB;
constexpr size_t WS_ACT = WS_R1 + 128 * MiB;
constexpr size_t WS_AB = WS_R1;
constexpr size_t WS_R2 = WS_R1 + 256 * MiB;
constexpr size_t WS_Y = WS_R2;
constexpr size_t WS_REC = WS_R2 + 32 * MiB;
constexpr size_t WS_U = WS_R2 + 96 * MiB;
constexpr size_t WS_Z = WS_R2 + 160 * MiB;
constexpr size_t WS_R3 = WS_R2 + 192 * MiB;
constexpr size_t WS_HF = WS_R3;
constexpr size_t WS_HBW = WS_R3 + 64 * MiB;
constexpr size_t WS_MISC = WS_R3 + 128 * MiB;
constexpr size_t WS_ROPE = WS_MISC;
constexpr size_t WS_COMB = WS_MISC + 1 * MiB;
constexpr size_t WS_C8SP = WS_COMB + 768 * 1024;
constexpr size_t WS_LIST = WS_COMB + 256 * 1024;
constexpr size_t WS_GATEW = WS_COMB + 512 * 1024;
constexpr size_t WS_MACT = WS_R1;
constexpr size_t WS_PARTK = WS_R1 + 128 * MiB;
constexpr size_t WS_INV = WS_COMB + 576 * 1024;
constexpr size_t WS_CONTRIB = WS_R2;
constexpr size_t WS_END = WS_MISC + 2 * MiB;

__device__ __forceinline__ bf16_t f2bf(float f) { unsigned u = __float_as_uint(f); u += 0x7FFFu + ((u >> 16) & 1u); return (bf16_t)(u >> 16); }
__device__ __forceinline__ float bf2f(bf16_t b) { return __uint_as_float(((unsigned)b) << 16); }
__device__ __forceinline__ float wave_sum(float v) {
#pragma unroll
    for (int o = 1; o < 64; o <<= 1) v += __shfl_xor(v, o);
    return v;
}
__device__ __forceinline__ float wave_max(float v) {
#pragma unroll
    for (int o = 1; o < 64; o <<= 1) v = fmaxf(v, __shfl_xor(v, o));
    return v;
}
__device__ __forceinline__ float sigmoidf_(float x) { return 1.f / (1.f + expf(-x)); }
__device__ __forceinline__ float siluf_(float x) { return x / (1.f + expf(-x)); }
__device__ __forceinline__ float gelu_tanh(float x) { const float u = 0.7978845608028654f * (x + 0.044715f * x * x * x); return 0.5f * x * (1.f + tanhf(u)); }

#define LAS __attribute__((address_space(3)))
#define GAS __attribute__((address_space(1)))
typedef unsigned u32x4 __attribute__((ext_vector_type(4)));
typedef unsigned u32x2 __attribute__((ext_vector_type(2)));
typedef float f32x2 __attribute__((ext_vector_type(2)));
constexpr int NWAVES = 8, NTHR = 512;
constexpr int BM = 256, BK = 64, HALF = 128, HTB = HALF * BK * 2, STAGE_BYTES = 8 * HTB, NXCD = 8, WGM = 8;
constexpr int MISC_OFF = STAGE_BYTES, LDS_BYTES = STAGE_BYTES + 16384;
constexpr size_t WT_IN0 = 0;
constexpr size_t WT_OUT0 = WT_IN0 + (size_t)INC * D;
constexpr size_t WT_GU0 = WT_OUT0 + (size_t)D * D;
constexpr size_t WT_DN0 = WT_GU0 + (size_t)2 * FF * D;
constexpr size_t WT_IN1 = WT_DN0 + (size_t)FF * D;
constexpr size_t WT_OUT1 = WT_IN1 + (size_t)2 * D * D;
constexpr size_t WT_LRU = WT_OUT1 + (size_t)D * D;
constexpr size_t WT_MGU = WT_LRU + (size_t)2 * 2 * LB * LBD * LBD;
constexpr size_t WT_MDN = WT_MGU + (size_t)NE * 2 * FF * D;
constexpr size_t WT_END = WT_MDN + (size_t)NE * FF * D;
static_assert(WT_END * 2 <= 816 * MiB, "weights region");
constexpr size_t WS_CTL = WS_END;
constexpr size_t CTL_BYTES = 256 * 1024;
constexpr int CW_BAR = 0;
constexpr int CW_CNT = 4096;
constexpr int CW_XRANK = 8192;
constexpr int CW_AQ = 8192 + 1024;
#define CW_CVQ (8192 + 2048)
#ifndef NCV_PER_XCD
#define NCV_PER_XCD 16
#endif
constexpr size_t WS_XB = WS_CTL + CTL_BYTES;
constexpr size_t WS_PART = WS_XB + 32 * MiB;
constexpr size_t WS_SUMM = WS_PART + 1 * MiB;
constexpr size_t WS_CARRY = WS_SUMM + 8 * MiB;
constexpr size_t WS_END2 = WS_CARRY + 4 * MiB;

__device__ __forceinline__ int opaque_tid() { int t = threadIdx.x; asm volatile("" : "+v"(t)); return t; }
__device__ __forceinline__ float sat8(float x) { return __builtin_amdgcn_fmed3f(x, -448.f, 448.f); }
__device__ __forceinline__ unsigned pk4_fp8(float a, float b, float c, float d) { unsigned w = 0; w = __builtin_amdgcn_cvt_pk_fp8_f32(sat8(a), sat8(b), w, false); w = __builtin_amdgcn_cvt_pk_fp8_f32(sat8(c), sat8(d), w, true); return w; }
constexpr float W8_SCALE = 64.f, W8_INV = 1.f / 64.f;
#ifndef FFN_GU8
#define FFN_GU8 1
#endif
#ifndef FFN_DN8
#define FFN_DN8 1
#endif
constexpr bool FFNGU8 = FFN_GU8, FFNDN8 = FFN_DN8;
#define XB_TMO      128
#define XB_XCNT(j)  (256  + 64 * (j))
#define XB_XSUB(j)  (1280 + 64 * (j))
#define XB_XGEN(j)  (2304 + 64 * (j))
#define XB_TOP      3328
#define XB_TOPGEN   3392
#define XCD_BAR_WORDS 3456
#define XB_SPIN_CAP (1u << 18)
__device__ __forceinline__ unsigned xb_ld(unsigned* p)              { return __hip_atomic_load(p, __ATOMIC_RELAXED, __HIP_MEMORY_SCOPE_AGENT); }
__device__ __forceinline__ unsigned xb_add(unsigned* p, unsigned v) { return __hip_atomic_fetch_add(p, v, __ATOMIC_RELAXED, __HIP_MEMORY_SCOPE_AGENT); }
__device__ __forceinline__ unsigned xb_xcc_id() { return (unsigned)__builtin_amdgcn_s_getreg((3 << 11) | 20) & 0xFu; }
#define XB_SPIN(cond, bar) do { unsigned _sp = 0; while (cond) { __builtin_amdgcn_s_sleep(1); \
    if ((++_sp & 255u) == 0u) { if (xb_ld(&(bar)[XB_TMO])) break; if (_sp > XB_SPIN_CAP) { atomicAdd(&(bar)[XB_TMO], 1u); break; } } } } while (0)
struct XcdBarrier { unsigned* bar; unsigned x; volatile LAS unsigned* st; };
__device__ __forceinline__ XcdBarrier xcd_barrier_post(unsigned* bar, volatile LAS unsigned* st) {
    XcdBarrier b; b.bar = bar; b.x = xb_xcc_id(); b.st = st;
    if (threadIdx.x == 0) (void)xb_add(&bar[XB_XCNT(b.x)], 1u);
    return b;
}
__device__ __forceinline__ void xcd_barrier_complete(unsigned* bar, unsigned x, unsigned& nloc, unsigned& nx) {
    const unsigned G = gridDim.x * gridDim.y * gridDim.z;
    unsigned sum, cnt, mine, sp = 0u;
    for (;;) {
        sum = 0u; cnt = 0u; mine = 0u;
#pragma unroll
        for (unsigned j = 0; j < 16; ++j) { const unsigned c = xb_ld(&bar[XB_XCNT(j)]); sum += c; cnt += (c > 0u) ? 1u : 0u; mine = (j == x) ? c : mine; }
        if (sum == G) break;
        __builtin_amdgcn_s_sleep(1);
        if ((++sp & 255u) == 0u) { if (xb_ld(&bar[XB_TMO])) break; if (sp > XB_SPIN_CAP) { atomicAdd(&bar[XB_TMO], 1u); break; } }
    }
    nloc = mine > 0u ? mine : 1u; nx = cnt > 0u ? cnt : 1u;
}
__device__ __forceinline__ void xcd_barrier(const XcdBarrier& b) {
    asm volatile("s_waitcnt vmcnt(0)" ::: "memory");
    __syncthreads();
    if (threadIdx.x == 0) {
        unsigned* bar = b.bar;
        __builtin_amdgcn_s_waitcnt(0);
        unsigned nloc = b.st[0], nx = b.st[1];
        if (nloc == 0u) { xcd_barrier_complete(bar, b.x, nloc, nx); b.st[0] = nloc; b.st[1] = nx; }
        const unsigned old = xb_add(&bar[XB_XSUB(b.x)], 1u);
        const unsigned gen = old / nloc;
        if (old + 1u == (gen + 1u) * nloc) {
            __builtin_amdgcn_fence(__ATOMIC_RELEASE, "agent");
            asm volatile("s_waitcnt vmcnt(0)" ::: "memory");
            const unsigned og = xb_add(&bar[XB_TOP], 1u);
            const unsigned tg = og / nx;
            if (og + 1u == (tg + 1u) * nx) xb_add(&bar[XB_TOPGEN], 1u);
            else XB_SPIN(xb_ld(&bar[XB_TOPGEN]) == tg, bar);
            __builtin_amdgcn_fence(__ATOMIC_ACQUIRE, "agent");
            xb_add(&bar[XB_XGEN(b.x)], 1u);
            asm volatile("s_waitcnt vmcnt(0)" ::: "memory");
        } else {
            XB_SPIN(xb_ld(&bar[XB_XGEN(b.x)]) == gen, bar);
            __builtin_amdgcn_fence(__ATOMIC_ACQUIRE, "agent");
            asm volatile("s_waitcnt vmcnt(0)" ::: "memory");
        }
    }
    __syncthreads();
}

__host__ __device__ __forceinline__ int lds_byte(int r, int c) { const int st = (r >> 4) * 2 + (c >> 5), rr = r & 15, cc = c & 31, ob = rr * 64 + cc * 2; return st * 1024 + (ob ^ (((ob >> 9) & 1) << 5)); }
__host__ __device__ __forceinline__ void stage_rc(int b, int& R, int& C) { const int st = b / 1024, sb = b % 1024, swz = sb ^ (((sb >> 9) & 1) << 5); R = (st >> 1) * 16 + swz / 64; C = (st & 1) * 32 + (swz % 64) / 2; }
__host__ __device__ __forceinline__ int perm32(int rho) { const int n = rho >> 4, i = rho & 15; return 8 * (i >> 2) + 4 * n + (i & 3); }
__device__ __forceinline__ unsigned cvt_pk_bf16(float lo, float hi) { unsigned r; asm volatile("v_cvt_pk_bf16_f32 %0, %1, %2" : "=v"(r) : "v"(lo), "v"(hi)); return r; }

struct Unit { int pm, pn, e, r0, cnt, k0, nkt, kq, ridx; };
struct Gemm { const bf16_t* A; const bf16_t* Bt; int N, K; size_t bstride; };

struct StaticOrder {
    int nM, nN, nwg, G, c;
    __device__ void init(int M, int N, int G_, int c_) { nM = M / BM; nN = N / BM; nwg = nM * nN; G = G_; c = c_; }
    __device__ bool next(int i, Unit& u) const {
        const long L = (long)i * G + c; if (L >= nwg) return false;
        int wgid = (int)L; { const int q = nwg / NXCD, r = nwg % NXCD, xcd = wgid % NXCD, off = wgid / NXCD; wgid = (xcd < r ? xcd * (q + 1) : r * (q + 1) + (xcd - r) * q) + off; }
        const int nig = WGM * nN, gid = wgid / nig, fm = gid * WGM, gsz = (nM - fm) < WGM ? (nM - fm) : WGM;
        u.pm = fm + ((wgid % nig) % gsz); u.pn = (wgid % nig) / gsz; u.e = 0; u.r0 = 0; u.cnt = 0; u.k0 = 0; u.nkt = 0; u.kq = -1; u.ridx = 0; return true;
    }
    __device__ __forceinline__ int arow(const Unit& u, int lr) const { return u.pm * BM + lr; }
};

typedef int i32x8 __attribute__((ext_vector_type(8)));
typedef int i32x4 __attribute__((ext_vector_type(4)));
template <class Epi, class Sched, int BL, bool GATHER, bool F8 = false>
__device__ __forceinline__ void gemm_phase(LAS unsigned char* lds, const Gemm g, const Sched& S, const Epi& E) {
    const int tid = opaque_tid(), wid = __builtin_amdgcn_readfirstlane(tid >> 6), lane = tid & 63, wr = wid >> 2, wc = wid & 3, fr = lane & 15, fq = lane >> 4;
    constexpr int ESZ = F8 ? 1 : 2;
    const int K = g.K, KB = K * ESZ, nt = KB / 128;
    unsigned voffA[2], voffB[2], CA[2]; int RA[2];
#pragma unroll
    for (int i = 0; i < 2; ++i) { int R, C; stage_rc(tid * 16 + i * 8192, R, C); RA[i] = R; CA[i] = (unsigned)C * 2u;
        int Rb = R; if (BL >= 1) Rb = (R & ~31) + perm32(R & 31); if (BL == 2) Rb = 64 * (Rb >> 5) + (Rb & 31);
        voffA[i] = (unsigned)(R * KB) + (unsigned)C * 2u; voffB[i] = (unsigned)(Rb * 128) + (unsigned)C * 2u; }
    const size_t kstep = 128, kstepB = 256 * 128;
    const size_t hstep = (size_t)HALF * KB;
    const size_t hstepB = (BL == 2) ? (size_t)32 * 128 : (size_t)HALF * 128;
    const size_t tstep = 2 * hstep;
    const unsigned ldsw = (unsigned)wid * 1024u;
    const int aoff = F8 ? lds_byte(wr * 64 + fr, fq * 16) : lds_byte(wr * 64 + fr, fq * 8), boff = F8 ? lds_byte(wc * 32 + fr, fq * 16) : lds_byte(wc * 32 + fr, fq * 8);
#define PG8_SA(b, h) (((b) * 2 + (h)) * HTB)
#define PG8_SB(b, h) ((4 + (b) * 2 + (h)) * HTB)
#define PG8_STAGE(bufoff, gbase, voff) do { _Pragma("unroll") for (int _i = 0; _i < 2; ++_i) \
        __builtin_amdgcn_global_load_lds((const unsigned*)((const char*)(gbase) + (voff)[_i]), (LAS unsigned*)(lds + (bufoff) + ldsw + _i * 8192), 16, 0, 0); } while (0)
#define PG8_LDA(b, h) do { if constexpr (F8) { _Pragma("unroll") for (int m = 0; m < 4; ++m) { const i32x4 lo_ = *(const LAS i32x4*)(lds + PG8_SA(b, h) + aoff + m * 2048), hi_ = *(const LAS i32x4*)(lds + PG8_SA(b, h) + aoff + m * 2048 + 16); \
            At8[m] = (i32x8){lo_[0], lo_[1], lo_[2], lo_[3], hi_[0], hi_[1], hi_[2], hi_[3]}; } } \
        else { _Pragma("unroll") for (int m = 0; m < 4; ++m) _Pragma("unroll") for (int k = 0; k < 2; ++k) At[m][k] = *(const LAS bf16x8*)(lds + PG8_SA(b, h) + aoff + m * 2048 + k * 1024); } } while (0)
#define PG8_LDB(w, b, h) do { if constexpr (F8) { _Pragma("unroll") for (int n = 0; n < 2; ++n) { const i32x4 lo_ = *(const LAS i32x4*)(lds + PG8_SB(b, h) + boff + n * 2048), hi_ = *(const LAS i32x4*)(lds + PG8_SB(b, h) + boff + n * 2048 + 16); \
            Bq8[w][n] = (i32x8){lo_[0], lo_[1], lo_[2], lo_[3], hi_[0], hi_[1], hi_[2], hi_[3]}; } } \
        else { _Pragma("unroll") for (int n = 0; n < 2; ++n) _Pragma("unroll") for (int k = 0; k < 2; ++k) Bq[w][n][k] = *(const LAS bf16x8*)(lds + PG8_SB(b, h) + boff + n * 2048 + k * 1024); } } while (0)
#define PG8_MMA(ai, bj) do { __builtin_amdgcn_s_setprio(1); if constexpr (F8) { _Pragma("unroll") for (int m = 0; m < 4; ++m) _Pragma("unroll") for (int n = 0; n < 2; ++n) \
            asm volatile("v_mfma_scale_f32_16x16x128_f8f6f4 %0, %1, %2, %0, %3, %3 op_sel_hi:[0,0,0]" : "+v"(acc[ai][bj][m][n]) : "v"(Bq8[bj][n]), "v"(At8[m]), "v"(sc8)); } \
        else { _Pragma("unroll") for (int m = 0; m < 4; ++m) _Pragma("unroll") for (int n = 0; n < 2; ++n) _Pragma("unroll") for (int k = 0; k < 2; ++k) \
            acc[ai][bj][m][n] = __builtin_amdgcn_mfma_f32_16x16x32_bf16(Bq[bj][n][k], At[m][k], acc[ai][bj][m][n], 0, 0, 0); } __builtin_amdgcn_s_setprio(0); } while (0)
#define PG8_WAIT_V(n) asm volatile("s_waitcnt vmcnt(" #n ")" ::: "memory")
#define PG8_WAIT_L(n) asm volatile("s_waitcnt lgkmcnt(" #n ")" ::: "memory")
#define PG8_BAR __builtin_amdgcn_s_barrier()
#define PG8_SCHED __builtin_amdgcn_sched_barrier(0)
    Unit cur, nxt; int ui = 0;
    if (!S.next(0, cur)) return;
    f32x4 acc[2][2][4][2];
#pragma unroll
    for (int a = 0; a < 2; ++a)
#pragma unroll
        for (int b = 0; b < 2; ++b)
#pragma unroll
            for (int m = 0; m < 4; ++m)
#pragma unroll
                for (int n = 0; n < 2; ++n) acc[a][b][m][n] = (f32x4){0.f, 0.f, 0.f, 0.f};
    bf16x8 At[4][2], Bq[2][2][2]; i32x8 At8[4], Bq8[2][2]; const int sc8 = 0x7f7f7f7f;
    unsigned oA0[2], oA1[2], nA0[2], nA1[2];
    const char* cA; const char* cB = (const char*)g.Bt + ((size_t)cur.e * g.bstride + (size_t)cur.pn * BM * K) * ESZ + (size_t)cur.k0 * kstepB;
    if constexpr (GATHER) { cA = (const char*)g.A + (size_t)cur.k0 * 128;
#pragma unroll
        for (int i = 0; i < 2; ++i) { oA0[i] = (unsigned)S.arow(cur, RA[i]) * (unsigned)KB + CA[i]; oA1[i] = (unsigned)S.arow(cur, HALF + RA[i]) * (unsigned)KB + CA[i]; }
    } else { cA = (const char*)g.A + (size_t)cur.pm * tstep + (size_t)cur.k0 * 128;
#pragma unroll
        for (int i = 0; i < 2; ++i) { oA0[i] = voffA[i]; oA1[i] = voffA[i] + (unsigned)hstep; } }
#pragma unroll
    for (int i = 0; i < 2; ++i) { nA0[i] = oA0[i]; nA1[i] = oA1[i]; }
    PG8_STAGE(PG8_SB(0, 0), cB, voffB); PG8_STAGE(PG8_SB(0, 1), cB + hstepB, voffB); PG8_STAGE(PG8_SA(0, 0), cA, oA0); PG8_STAGE(PG8_SA(0, 1), cA, oA1);
    if (wr == 1) PG8_BAR;
    PG8_WAIT_V(2); PG8_BAR;
    PG8_STAGE(PG8_SB(1, 0), cB + kstepB, voffB); PG8_STAGE(PG8_SA(1, 0), cA + kstep, oA0); PG8_STAGE(PG8_SB(1, 1), cB + hstepB + kstepB, voffB);
    PG8_WAIT_V(6); PG8_BAR;
    for (;;) {
        const bool has_next = S.next(ui + 1, nxt);
        const char* nA; const char* nB = has_next ? (const char*)g.Bt + ((size_t)nxt.e * g.bstride + (size_t)nxt.pn * BM * K) * ESZ + (size_t)nxt.k0 * kstepB : cB;
        const int ntu = cur.nkt ? cur.nkt : nt;
        if constexpr (GATHER) { nA = has_next ? (const char*)g.A + (size_t)nxt.k0 * 128 : cA;
            if (has_next) {
#pragma unroll
                for (int i = 0; i < 2; ++i) { nA0[i] = (unsigned)S.arow(nxt, RA[i]) * (unsigned)KB + CA[i]; nA1[i] = (unsigned)S.arow(nxt, HALF + RA[i]) * (unsigned)KB + CA[i]; } }
        } else { nA = has_next ? (const char*)g.A + (size_t)nxt.pm * tstep + (size_t)nxt.k0 * 128 : cA; }
        for (int t = 0; t < ntu; t += 2) {
            const bool last = (t == ntu - 2);
            const char* a1 = cA + (size_t)(t + 1) * kstep;
            const char* a2 = last ? nA : cA + (size_t)(t + 2) * kstep; const char* b2 = last ? nB : cB + (size_t)(t + 2) * kstepB;
            const char* a3 = a2 + kstep; const char* b3 = b2 + kstepB;
            unsigned xA0[2], xA1[2];
#pragma unroll
            for (int i = 0; i < 2; ++i) { xA0[i] = (GATHER && last) ? nA0[i] : oA0[i]; xA1[i] = (GATHER && last) ? nA1[i] : oA1[i]; }
            PG8_LDB(0, 0, 0); PG8_LDB(1, 0, 1); PG8_SCHED; PG8_LDA(0, 0); PG8_STAGE(PG8_SA(1, 1), a1, oA1);
            PG8_WAIT_V(8); PG8_WAIT_L(0); PG8_BAR; PG8_MMA(0, 0); PG8_MMA(0, 1); PG8_BAR; PG8_SCHED;
            PG8_LDA(0, 1); PG8_STAGE(PG8_SB(0, 0), b2, voffB); PG8_STAGE(PG8_SB(0, 1), b2 + hstepB, voffB); PG8_STAGE(PG8_SA(0, 0), a2, xA0);
            PG8_WAIT_V(8); PG8_WAIT_L(0); PG8_BAR; PG8_MMA(1, 0); PG8_MMA(1, 1); PG8_BAR; PG8_SCHED;
            PG8_LDB(0, 1, 0); PG8_LDB(1, 1, 1); PG8_SCHED; PG8_LDA(1, 0); PG8_STAGE(PG8_SA(0, 1), a2, xA1);
            PG8_WAIT_V(8); PG8_WAIT_L(0); PG8_BAR; PG8_MMA(0, 0); PG8_MMA(0, 1); PG8_BAR; PG8_SCHED;
            PG8_LDA(1, 1); PG8_STAGE(PG8_SB(1, 0), b3, voffB); PG8_STAGE(PG8_SB(1, 1), b3 + hstepB, voffB); PG8_STAGE(PG8_SA(1, 0), a3, xA0);
            PG8_WAIT_V(8); PG8_WAIT_L(0); PG8_BAR; PG8_MMA(1, 0); PG8_MMA(1, 1); PG8_BAR; PG8_SCHED;
        }
        if (wr == 0) PG8_BAR;
        if constexpr (F8) asm volatile("s_nop 15\n\ts_nop 15" ::: "memory");
        { int efr = fr, efq = fq; asm volatile("" : "+v"(efr), "+v"(efq)); E(acc, cur, wr, wc, efr, efq); }
        if (!has_next) break;
#pragma unroll
        for (int a = 0; a < 2; ++a)
#pragma unroll
            for (int b = 0; b < 2; ++b)
#pragma unroll
                for (int m = 0; m < 4; ++m)
#pragma unroll
                    for (int n = 0; n < 2; ++n) acc[a][b][m][n] = (f32x4){0.f, 0.f, 0.f, 0.f};
        cur = nxt; cA = nA; cB = nB; ++ui;
#pragma unroll
        for (int i = 0; i < 2; ++i) { oA0[i] = nA0[i]; oA1[i] = nA1[i]; }
        if (wr == 1) PG8_BAR;
    }
    PG8_WAIT_V(0);
    PG8_BAR;
#undef PG8_SA
#undef PG8_SB
#undef PG8_STAGE
#undef PG8_LDA
#undef PG8_LDB
#undef PG8_MMA
#undef PG8_WAIT_V
#undef PG8_WAIT_L
#undef PG8_BAR
#undef PG8_SCHED
}

__device__ __forceinline__ float row_rstd(const float* part, int row) { const f32x4 a = *(const f32x4*)(part + (size_t)row * 8), b = *(const f32x4*)(part + (size_t)row * 8 + 4);
    return rsqrtf((((a[0] + a[1]) + (a[2] + a[3])) + ((b[0] + b[1]) + (b[2] + b[3]))) * (1.0f / D) + EPS); }
struct EpiResid {
    const float* Xin; float* Xout; bf16_t* XB; float* part; LAS float* P; unsigned char* X8; float sc;
    __device__ __forceinline__ void operator()(const f32x4 (&acc)[2][2][4][2], const Unit& u, int wr, int wc, int fr, int fq) const {
        const int row0 = u.pm * BM + wr * 64 + fr, col0 = u.pn * BM + wc * 32 + 4 * fq;
#pragma unroll
        for (int ai = 0; ai < 2; ++ai)
#pragma unroll
            for (int m = 0; m < 4; ++m) { const int row = row0 + ai * HALF + m * 16; const size_t ro = (size_t)row * D + col0; float ss = 0.f;
#pragma unroll
                for (int bj = 0; bj < 2; ++bj)
#pragma unroll
                    for (int n = 0; n < 2; ++n) { const f32x4 v = *(const f32x4*)(Xin + ro + bj * HALF + n * 16) + acc[ai][bj][m][n] * sc;
                        *(f32x4*)(Xout + ro + bj * HALF + n * 16) = v; ss += (v[0] * v[0] + v[1] * v[1]) + (v[2] * v[2] + v[3] * v[3]);
                        if (XB) { u32x2 w; w.x = cvt_pk_bf16(v[0], v[1]); w.y = cvt_pk_bf16(v[2], v[3]); *(u32x2*)(XB + ro + bj * HALF + n * 16) = w; }
                        if (X8) *(unsigned*)(X8 + ro + bj * HALF + n * 16) = pk4_fp8(v[0], v[1], v[2], v[3]); }
                ss += __shfl_xor(ss, 16); ss += __shfl_xor(ss, 32);
                if (fq == 0) P[(wr * 64 + fr + ai * HALF + m * 16) * 4 + wc] = ss; }
        asm volatile("s_waitcnt lgkmcnt(0)" ::: "memory"); __builtin_amdgcn_s_barrier(); asm volatile("" ::: "memory");
        const int t = threadIdx.x;
        if (t < BM) { const f32x4 p = *(const LAS f32x4*)(P + t * 4); part[(size_t)(u.pm * BM + t) * 8 + u.pn] = (p[0] + p[1]) + (p[2] + p[3]); }
    }
};

__device__ __forceinline__ float fast_silu(float g) { return g * __builtin_amdgcn_rcpf(1.f + __expf(-g)); }
__device__ __forceinline__ float fast_gelu_tanh(float x) { const float u = 1.5957691216057308f * (x + 0.044715f * x * x * x); return x * (1.f - __builtin_amdgcn_rcpf(1.f + __expf(u))); }
struct EpiQkv {
    bf16_t* O; const float* part; const float* rc; const float* rs;
    __device__ __forceinline__ void operator()(const f32x4 (&acc)[2][2][4][2], const Unit& u, int wr, int wc, int fr, int fq) const {
        const int row0 = u.pm * BM + wr * 64 + fr, col0 = u.pn * BM + wc * 64 + 8 * fq; const bool rope = (u.pn >= 12 && u.pn < 20);
#pragma unroll
        for (int ai = 0; ai < 2; ++ai)
#pragma unroll
            for (int m = 0; m < 4; ++m) { const int row = row0 + ai * HALF + m * 16; const float rstd = row_rstd(part, row);
                f32x4 x1a = acc[ai][0][m][0] * rstd, x1b = acc[ai][0][m][1] * rstd, x2a = acc[ai][1][m][0] * rstd, x2b = acc[ai][1][m][1] * rstd;
                if (rope) { const int s = row & (S - 1); const f32x4 ca = *(const f32x4*)(rc + s * 32 + 8 * fq), cb = *(const f32x4*)(rc + s * 32 + 8 * fq + 4), sa = *(const f32x4*)(rs + s * 32 + 8 * fq), sb = *(const f32x4*)(rs + s * 32 + 8 * fq + 4);
                    const f32x4 o1a = x1a * ca - x2a * sa, o1b = x1b * cb - x2b * sb, o2a = x2a * ca + x1a * sa, o2b = x2b * cb + x1b * sb; x1a = o1a; x1b = o1b; x2a = o2a; x2b = o2b; }
                bf16_t* rowp = O + (size_t)row * INC + col0;
                u32x4 w1, w2; w1.x = cvt_pk_bf16(x1a[0], x1a[1]); w1.y = cvt_pk_bf16(x1a[2], x1a[3]); w1.z = cvt_pk_bf16(x1b[0], x1b[1]); w1.w = cvt_pk_bf16(x1b[2], x1b[3]);
                w2.x = cvt_pk_bf16(x2a[0], x2a[1]); w2.y = cvt_pk_bf16(x2a[2], x2a[3]); w2.z = cvt_pk_bf16(x2b[0], x2b[1]); w2.w = cvt_pk_bf16(x2b[2], x2b[3]);
                *(u32x4*)rowp = w1; *(u32x4*)(rowp + 32) = w2; }
    }
};
template <bool MOE, bool F8O = MOE, bool F8I = F8O> struct EpiGateUp {
    bf16_t* O; const float* part; const int* list;
    __device__ __forceinline__ void operator()(const f32x4 (&acc)[2][2][4][2], const Unit& u, int wr, int wc, int fr, int fq) const {
        const int lr0 = wr * 64 + fr, col0 = u.pn * HALF + wc * 32 + 8 * fq;
#pragma unroll
        for (int ai = 0; ai < 2; ++ai)
#pragma unroll
            for (int m = 0; m < 4; ++m) { const int lr = lr0 + ai * HALF + m * 16; int srow = u.pm * BM + lr; const int orow = u.pm * BM + lr;
                const float rstd = MOE ? W8_INV : row_rstd(part, srow) * (F8I ? W8_INV : 1.f);
                const f32x4 g0 = acc[ai][0][m][0] * rstd, g1 = acc[ai][0][m][1] * rstd, u0 = acc[ai][1][m][0] * rstd, u1 = acc[ai][1][m][1] * rstd;
                if constexpr (F8O) { u32x2 w8; w8.x = pk4_fp8(fast_silu(g0[0]) * u0[0], fast_silu(g0[1]) * u0[1], fast_silu(g0[2]) * u0[2], fast_silu(g0[3]) * u0[3]);
                    w8.y = pk4_fp8(fast_silu(g1[0]) * u1[0], fast_silu(g1[1]) * u1[1], fast_silu(g1[2]) * u1[2], fast_silu(g1[3]) * u1[3]);
                    *(u32x2*)((unsigned char*)O + (size_t)orow * FF + col0) = w8; continue; }
                u32x4 w; w.x = cvt_pk_bf16(fast_silu(g0[0]) * u0[0], fast_silu(g0[1]) * u0[1]); w.y = cvt_pk_bf16(fast_silu(g0[2]) * u0[2], fast_silu(g0[3]) * u0[3]);
                w.z = cvt_pk_bf16(fast_silu(g1[0]) * u1[0], fast_silu(g1[1]) * u1[1]); w.w = cvt_pk_bf16(fast_silu(g1[2]) * u1[2], fast_silu(g1[3]) * u1[3]);
                *(u32x4*)(O + (size_t)orow * FF + col0) = w; }
    }
};
struct EpiL1In {
    bf16_t* Y; bf16_t* R; const float* part;
    __device__ __forceinline__ void operator()(const f32x4 (&acc)[2][2][4][2], const Unit& u, int wr, int wc, int fr, int fq) const {
        const int row0 = u.pm * BM + wr * 64 + fr, col0 = u.pn * BM + wc * 32 + 8 * fq;
#pragma unroll
        for (int ai = 0; ai < 2; ++ai)
#pragma unroll
            for (int m = 0; m < 4; ++m) { const int row = row0 + ai * HALF + m * 16; const float rstd = row_rstd(part, row);
#pragma unroll
                for (int bj = 0; bj < 2; ++bj) { const f32x4 v0 = acc[ai][bj][m][0] * rstd, v1 = acc[ai][bj][m][1] * rstd; const int col = col0 + bj * HALF;
                    if (u.pn < 8) { u32x4 w; w.x = cvt_pk_bf16(fast_gelu_tanh(v0[0]), fast_gelu_tanh(v0[1])); w.y = cvt_pk_bf16(fast_gelu_tanh(v0[2]), fast_gelu_tanh(v0[3]));
                        w.z = cvt_pk_bf16(fast_gelu_tanh(v1[0]), fast_gelu_tanh(v1[1])); w.w = cvt_pk_bf16(fast_gelu_tanh(v1[2]), fast_gelu_tanh(v1[3])); *(u32x4*)(Y + (size_t)row * D + col) = w; }
                    else { u32x4 w; w.x = cvt_pk_bf16(v0[0], v0[1]); w.y = cvt_pk_bf16(v0[2], v0[3]); w.z = cvt_pk_bf16(v1[0], v1[1]); w.w = cvt_pk_bf16(v1[2], v1[3]); *(u32x4*)(R + ((size_t)(row >> 8) * LB + (u.pn - 8) * 2 + bj) * (256 * LBD) + (size_t)(row & 255) * LBD + wc * 32 + 8 * fq) = w; } } }
    }
};

struct MoeOrder {
    const volatile LAS int* tab; const int* list; int NP, nwg, G, c, KT4;
    __device__ __forceinline__ int tb(int i) const { return __builtin_amdgcn_readfirstlane(tab[i]); }
    __device__ void init(const volatile LAS int* tab_, const int* list_, int NP_, int G_, int c_) { tab = tab_; list = list_; NP = NP_; G = G_; c = c_; nwg = __builtin_amdgcn_readfirstlane(tab_[16]) * NP_; ksplit = 0; KT4 = 0; }
    int ksplit;
    __device__ bool next(int i, Unit& u) const {
        long L = (long)i * G + c; u.k0 = 0; u.nkt = 0; u.kq = -1; u.ridx = 0;
        if (ksplit && i >= 2) { if (i > 2 || c >= 4 * (nwg - 2 * G)) return false; L = 2 * G + (c >> 2); u.kq = c & 3; u.ridx = c >> 2; u.nkt = KT4; u.k0 = u.kq * KT4; }
        if (L >= nwg) return false;
        int wgid = (int)L; { const int q = nwg / NXCD, r = nwg % NXCD, xcd = wgid % NXCD, off = wgid / NXCD; wgid = (xcd < r ? xcd * (q + 1) : r * (q + 1) + (xcd - r) * q) + off; }
        int e = 0;
#pragma unroll
        for (int k = 1; k < NE; ++k) e += (wgid >= tb(8 + k) * NP) ? 1 : 0;
        const int p0 = tb(8 + e), npan = tb(9 + e) - p0, w = wgid - p0 * NP;
        const int pl = w % npan; u.pn = w / npan; u.pm = p0 + pl; u.e = e; u.r0 = pl * BM; u.cnt = tb(e); return true;
    }
    __device__ __forceinline__ int arow(const Unit& u, int lr) const { const int li = u.r0 + lr; return (li < u.cnt) ? (list[u.e * T + li] >> 1) : 0; }
};
struct EpiMoeDown {
    bf16_t* C; const int* list; const float* gatew; float* partk;
    __device__ __forceinline__ void operator()(const f32x4 (&acc)[2][2][4][2], const Unit& u, int wr, int wc, int fr, int fq) const {
        const int lr0 = wr * 64 + fr, col0 = u.pn * BM + wc * 32 + 4 * fq;
        if (u.kq >= 0) {
            float* pt = partk + ((size_t)(u.ridx * 4 + u.kq) << 16) + wc * 32 + 4 * fq;
#pragma unroll
            for (int ai = 0; ai < 2; ++ai)
#pragma unroll
                for (int m = 0; m < 4; ++m) { float* rp = pt + (lr0 + ai * HALF + m * 16) * BM;
#pragma unroll
                    for (int bj = 0; bj < 2; ++bj)
#pragma unroll
                        for (int n = 0; n < 2; ++n) *(f32x4*)(rp + bj * HALF + n * 16) = acc[ai][bj][m][n]; }
            return;
        }
#pragma unroll
        for (int ai = 0; ai < 2; ++ai)
#pragma unroll
            for (int m = 0; m < 4; ++m) { const int li = u.r0 + lr0 + ai * HALF + m * 16;
                if (li < u.cnt) { const int ent = list[u.e * T + li]; const float w = gatew[ent] * W8_INV; bf16_t* rp = C + (size_t)ent * D + col0;
#pragma unroll
                    for (int bj = 0; bj < 2; ++bj)
#pragma unroll
                        for (int n = 0; n < 2; ++n) { const f32x4 v = acc[ai][bj][m][n] * w; u32x2 pk; pk.x = cvt_pk_bf16(v[0], v[1]); pk.y = cvt_pk_bf16(v[2], v[3]); *(u32x2*)(rp + bj * HALF + n * 16) = pk; } } }
    }
};

namespace att {
using f32x16 = __attribute__((ext_vector_type(16))) float;
using s16x4  = __attribute__((ext_vector_type(4))) short;
constexpr int SHM_V = 64 * 128 * 2, SHM_K = 64 * 128 * 2;
constexpr float LOG2E = 1.4426950408889634f;
constexpr float THR2 = 8.f * LOG2E;
#define KSWZ(row, colB) ((row) * 256 + ((colB) ^ (((row) & 7) << 4)))
#define SBAR() __builtin_amdgcn_sched_barrier(0)
__device__ __forceinline__ int crow(int r, int hi) { return (r & 3) + 8 * (r >> 2) + 4 * hi; }
__device__ __forceinline__ unsigned cvtpk(float lo, float hi) { unsigned r; asm volatile("v_cvt_pk_bf16_f32 %0, %1, %2" : "=v"(r) : "v"(lo), "v"(hi)); return r; }
__device__ __forceinline__ int v_st(int k, int c) { const int kk = (k & ~0xC) | ((k & 4) << 1) | ((k & 8) >> 1); return ((kk >> 3) * 4 + (c >> 5)) * 512 + ((kk & 7) * 32 + (c & 31)) * 2; }
__device__ __forceinline__ int v_rd_base(int lane) { return ((lane & 3) << 3) | (((lane >> 2) & 3) << 6) | (((lane >> 4) & 1) << 5) | (((lane >> 5) & 1) << 8); }
constexpr int v_rd_off(int d0, int ks, int half) { return d0 * 512 + ks * 4096 + half * 2048; }
template <int OFF> __device__ __forceinline__ s16x4 tr_read(int vb) { s16x4 r; asm volatile("ds_read_b64_tr_b16 %0, %1 offset:%2" : "=&v"(r) : "v"(vb), "i"(OFF) : "memory"); return r; }
template <int D0> __device__ __forceinline__ void pv_one(f32x16& od, int vb, bf16x8 pa0, bf16x8 pa1, bf16x8 pa2, bf16x8 pa3) {
    const s16x4 l0 = tr_read<v_rd_off(D0, 0, 0)>(vb), h0 = tr_read<v_rd_off(D0, 0, 1)>(vb), l1 = tr_read<v_rd_off(D0, 1, 0)>(vb), h1 = tr_read<v_rd_off(D0, 1, 1)>(vb);
    const s16x4 l2 = tr_read<v_rd_off(D0, 2, 0)>(vb), h2 = tr_read<v_rd_off(D0, 2, 1)>(vb), l3 = tr_read<v_rd_off(D0, 3, 0)>(vb), h3 = tr_read<v_rd_off(D0, 3, 1)>(vb);
    asm volatile("s_waitcnt lgkmcnt(0)" ::: "memory"); SBAR();
#define PK(L, H) (bf16x8){L[0], L[1], L[2], L[3], H[0], H[1], H[2], H[3]}
    od = __builtin_amdgcn_mfma_f32_32x32x16_bf16(pa0, PK(l0, h0), od, 0, 0, 0);
    od = __builtin_amdgcn_mfma_f32_32x32x16_bf16(pa1, PK(l1, h1), od, 0, 0, 0);
    od = __builtin_amdgcn_mfma_f32_32x32x16_bf16(pa2, PK(l2, h2), od, 0, 0, 0);
    od = __builtin_amdgcn_mfma_f32_32x32x16_bf16(pa3, PK(l3, h3), od, 0, 0, 0);
#undef PK
}
__device__ __forceinline__ void pv_d0(f32x16* o, int vb, bf16x8 pa0, bf16x8 pa1, bf16x8 pa2, bf16x8 pa3) {
    pv_one<0>(o[0], vb, pa0, pa1, pa2, pa3); pv_one<1>(o[1], vb, pa0, pa1, pa2, pa3); pv_one<2>(o[2], vb, pa0, pa1, pa2, pa3); pv_one<3>(o[3], vb, pa0, pa1, pa2, pa3);
}
struct NaCtx { const LAS float* bias; int r, rs, qc, cs; };
template <int MODE> __device__ __forceinline__ void partialSM(f32x16& p0, f32x16& p1, float& m_reg, float& mn, float& alpha, const NaCtx& nc, int kr, int hi) {
    float pmax;
    if constexpr (MODE == 0) {
        constexpr float C = 0.125f * LOG2E;
        pmax = p0[0];
#pragma unroll
        for (int r = 1; r < 16; ++r) pmax = fmaxf(pmax, p0[r]);
#pragma unroll
        for (int r = 0; r < 16; ++r) pmax = fmaxf(pmax, p1[r]);
        pmax *= C;
    } else {
        constexpr float C = 0.08838834764831845f * LOG2E;
        const bool rowin = (unsigned)(kr - nc.rs) < 8u;
        const int base = (kr - nc.r + 7) * 31 + 15 - nc.qc;
#pragma unroll
        for (int r = 0; r < 16; ++r) { const int kc0 = crow(r, hi), kc1 = 32 + kc0;
            const bool v0 = rowin && ((unsigned)(kc0 - nc.cs) < 16u), v1 = rowin && ((unsigned)(kc1 - nc.cs) < 16u);
            const float b0 = nc.bias[v0 ? base + kc0 : 0], b1 = nc.bias[v1 ? base + kc1 : 0];
            p0[r] = v0 ? fmaf(p0[r], C, b0) : -1.0e30f; p1[r] = v1 ? fmaf(p1[r], C, b1) : -1.0e30f; }
        pmax = p0[0];
#pragma unroll
        for (int r = 1; r < 16; ++r) pmax = fmaxf(pmax, p0[r]);
#pragma unroll
        for (int r = 0; r < 16; ++r) pmax = fmaxf(pmax, p1[r]);
    }
    { auto rr = __builtin_amdgcn_permlane32_swap(__float_as_uint(pmax), __float_as_uint(pmax), false, false);
      pmax = fmaxf(__uint_as_float(rr[0]), __uint_as_float(rr[1])); }
    if (__builtin_expect(__all(pmax - m_reg <= THR2), 1)) { mn = m_reg; alpha = 1.f; }
    else { mn = fmaxf(m_reg, pmax); alpha = __builtin_amdgcn_exp2f(m_reg - mn); m_reg = mn; }
    if constexpr (MODE == 0) { constexpr float C = 0.125f * LOG2E; const float mnC = -mn;
#pragma unroll
        for (int r = 0; r < 16; ++r) p0[r] = fmaf(p0[r], C, mnC);
#pragma unroll
        for (int r = 0; r < 16; ++r) p1[r] = fmaf(p1[r], C, mnC);
    } else {
#pragma unroll
        for (int r = 0; r < 16; ++r) p0[r] = p0[r] - mn;
#pragma unroll
        for (int r = 0; r < 16; ++r) p1[r] = p1[r] - mn;
    }
#pragma unroll
    for (int r = 0; r < 16; ++r) p0[r] = __builtin_amdgcn_exp2f(p0[r]);
}
__device__ __forceinline__ void finishSM(f32x16& p0, f32x16& p1, float alpha, float& l_reg, bf16x8& pa0, bf16x8& pa1, bf16x8& pa2, bf16x8& pa3) {
#pragma unroll
    for (int r = 0; r < 16; ++r) p1[r] = __builtin_amdgcn_exp2f(p1[r]);
    float ps = 0;
#pragma unroll
    for (int r = 0; r < 16; ++r) ps += p0[r];
#pragma unroll
    for (int r = 0; r < 16; ++r) ps += p1[r];
    { auto rr = __builtin_amdgcn_permlane32_swap(__float_as_uint(ps), __float_as_uint(ps), false, false);
      ps = __uint_as_float(rr[0]) + __uint_as_float(rr[1]); }
    l_reg = l_reg * alpha + ps;
#define PK4(P, BASE, OUT) do { unsigned a0 = cvtpk(P[BASE + 0], P[BASE + 1]), a1 = cvtpk(P[BASE + 2], P[BASE + 3]);   \
    unsigned b0 = cvtpk(P[BASE + 4], P[BASE + 5]), b1 = cvtpk(P[BASE + 6], P[BASE + 7]);                              \
    auto r0 = __builtin_amdgcn_permlane32_swap(a0, b0, false, false); auto r1 = __builtin_amdgcn_permlane32_swap(a1, b1, false, false); \
    u32x4 w = {r0[0], r1[0], r0[1], r1[1]}; OUT = *reinterpret_cast<bf16x8*>(&w); } while (0)
    PK4(p0, 0, pa0); PK4(p0, 8, pa1); PK4(p1, 0, pa2); PK4(p1, 8, pa3);
#undef PK4
}
template <int NKS, bool QLDS> __device__ __forceinline__ void qkt(f32x16& p0, f32x16& p1, const LAS unsigned char* Ks, const bf16x8* qr, const LAS unsigned char* Qs, int kcb, int r32, int hi) {
    p0 = f32x16{}; p1 = f32x16{};
#pragma unroll
    for (int d0 = 0; d0 < NKS; ++d0) { const int cb = kcb + (d0 * 16 + hi * 8) * 2;
        const bf16x8 b0 = *(const LAS bf16x8*)(Ks + KSWZ(r32, cb));
        const bf16x8 b1 = *(const LAS bf16x8*)(Ks + KSWZ(32 + r32, cb));
        bf16x8 q; if constexpr (QLDS) q = *(const LAS bf16x8*)(Qs + KSWZ(r32, (d0 * 16 + hi * 8) * 2)); else q = qr[d0];
        p0 = __builtin_amdgcn_mfma_f32_32x32x16_bf16(b0, q, p0, 0, 0, 0);
        p1 = __builtin_amdgcn_mfma_f32_32x32x16_bf16(b1, q, p1, 0, 0, 0); }
}

template <int MODE>
__device__ __forceinline__ void attn_unit(const bf16_t* __restrict__ QKV, bf16_t* __restrict__ ATT, int b, int h, int blk, LAS unsigned char* lds, const float* __restrict__ subln, float lam, const float* __restrict__ rpb) {
    constexpr int NKS = (MODE == 0) ? 4 : 8;
    const int tid = opaque_tid(), wid = tid >> 6, lane = tid & 63, r32 = lane & 31, hi = lane >> 5;
    LAS unsigned char* V_lds = lds; LAS unsigned char* K_lds = lds + 2 * SHM_V;
    LAS float* wsr = (LAS float*)(lds + MISC_OFF + 1024) + wid * 64; LAS float* li_l = wsr; LAS float* al_l = wsr + 32;
    LAS float* biasL = (LAS float*)(lds + MISC_OFF + 8192);
    int qtok, qcol, kcol, vcol, tok0, NT, ocol; NaCtx nc; nc.bias = biasL; nc.r = 0; nc.rs = 0; nc.qc = 0; nc.cs = 0; int kr0 = 0;
    if constexpr (MODE == 0) { const int map = wid >> 2;
        qtok = b * S + blk * 128 + (wid & 3) * 32 + r32; qcol = 3 * 1024 + h * HD + map * 64; kcol = 4 * 1024 + h * HD; vcol = 5 * 1024 + h * HD; tok0 = b * S; NT = S / 64; ocol = 1024 + h * HD;
    } else { const int r = blk * 4 + (wid >> 1), qc = 32 * (wid & 1) + r32;
        qtok = b * S + r * GW + qc; qcol = h * HD; kcol = 1024 + h * HD; vcol = 2048 + h * HD; ocol = h * HD;
        int rlo = blk * 4 - 4; rlo = rlo < 0 ? 0 : (rlo > GR - KH ? GR - KH : rlo);
        int rhi = blk * 4 + 3 - 4; rhi = rhi < 0 ? 0 : (rhi > GR - KH ? GR - KH : rhi); rhi += KH - 1;
        int cnt = rhi - rlo + 1; if (cnt & 1) { if (rhi + 1 < GR) ++rhi; else --rlo; ++cnt; }
        kr0 = rlo; NT = cnt; tok0 = b * S + rlo * GW;
        nc.r = r; int rs = r - 4; nc.rs = rs < 0 ? 0 : (rs > GR - KH ? GR - KH : rs); nc.qc = qc; int cs = qc - 8; nc.cs = cs < 0 ? 0 : (cs > GW - KW ? GW - KW : cs);
    }
    __syncthreads();
    if constexpr (MODE == 1) { for (int i = tid; i < 15 * 31; i += NTHR) biasL[i] = rpb[h * 15 * 31 + i] * LOG2E; }
    constexpr bool QLDS = (MODE == 1);
    LAS unsigned char* Qs = lds + 65536 + wid * 8192;
    float m_reg = -1e30f, l_reg = 0; f32x16 o[4] = {}; bf16x8 qr[QLDS ? 1 : NKS];
    { const bf16_t* Qw = QKV + (size_t)qtok * INC + qcol + hi * 8;
#pragma unroll
      for (int d0 = 0; d0 < NKS; ++d0) { const bf16x8 qv = *(const bf16x8*)(Qw + d0 * 16);
          if constexpr (QLDS) *(LAS bf16x8*)(Qs + KSWZ(r32, (d0 * 16 + hi * 8) * 2)) = qv; else qr[d0] = qv; } }
    const int kcb = (MODE == 0) ? (wid >> 2) * 128 : 0;
    const int sr = tid >> 4, sc = (tid & 15) * 8, vst0 = v_st(sr, sc), vst1 = v_st(32 + sr, sc);
    const int vb0 = (int)(unsigned)(uintptr_t)V_lds + v_rd_base(lane);
    const bf16_t* Kg = QKV + (size_t)tok0 * INC + kcol + sc; const bf16_t* Vg = QKV + (size_t)tok0 * INC + vcol + sc;
    constexpr int SDEPTH = (MODE == 0) ? 2 : 1;
    struct { bf16x8 vs0, vs1, ks0, ks1; } sr_[SDEPTH];
#define SLOAD(i, k0) do { sr_[i].vs0 = *(const bf16x8*)(Vg + (size_t)((k0) + sr) * INC); sr_[i].vs1 = *(const bf16x8*)(Vg + (size_t)((k0) + 32 + sr) * INC); \
    sr_[i].ks0 = *(const bf16x8*)(Kg + (size_t)((k0) + sr) * INC); sr_[i].ks1 = *(const bf16x8*)(Kg + (size_t)((k0) + 32 + sr) * INC); } while (0)
#define SWRITE(bb, i) do { *(LAS bf16x8*)(V_lds + (bb) * SHM_V + vst0) = sr_[i].vs0; *(LAS bf16x8*)(V_lds + (bb) * SHM_V + vst1) = sr_[i].vs1; const int kc = sc * 2; \
    *(LAS bf16x8*)(K_lds + (bb) * SHM_K + KSWZ(sr, kc)) = sr_[i].ks0; *(LAS bf16x8*)(K_lds + (bb) * SHM_K + KSWZ(32 + sr, kc)) = sr_[i].ks1; } while (0)
#define SWAIT() do { if constexpr (SDEPTH == 2) asm volatile("s_waitcnt vmcnt(4)" ::: "memory"); else asm volatile("s_waitcnt vmcnt(0)" ::: "memory"); } while (0)
#define RESC(a) do { if (__any((a) < 1.f)) { if (hi == 0) al_l[r32] = (a); asm volatile("s_waitcnt lgkmcnt(0)" ::: "memory"); \
    _Pragma("unroll") for (int d = 0; d < 4; ++d) _Pragma("unroll") for (int r = 0; r < 16; ++r) o[d][r] *= al_l[crow(r, hi)]; } } while (0)
    f32x16 pA0, pA1, pB0, pB1; float mnA, mnB, alA, alB; bf16x8 pa0, pa1, pa2, pa3;
    constexpr int SE = 0, SO = SDEPTH - 1;
    if (wid >= 4) __builtin_amdgcn_s_setprio(1);
    SLOAD(SE, 0); asm volatile("s_waitcnt vmcnt(0)" ::: "memory"); SWRITE(0, SE); __syncthreads();
    qkt<NKS, QLDS>(pA0, pA1, K_lds, qr, Qs, kcb, r32, hi); partialSM<MODE>(pA0, pA1, m_reg, mnA, alA, nc, kr0, hi);
    SLOAD(SO, 64); if constexpr (SDEPTH == 2) { if (2 < NT) SLOAD(SE, 2 * 64); }
    SWAIT(); SWRITE(1, SO); __syncthreads();
    for (int j = 1; j + 1 < NT; j += 2) {
        SBAR(); qkt<NKS, QLDS>(pB0, pB1, K_lds + SHM_K, qr, Qs, kcb, r32, hi);
        finishSM(pA0, pA1, alA, l_reg, pa0, pa1, pa2, pa3); SBAR();
        SLOAD(SO, (j + SDEPTH) * 64); SBAR();
        pv_d0(o, vb0, pa0, pa1, pa2, pa3); partialSM<MODE>(pB0, pB1, m_reg, mnB, alB, nc, kr0 + j, hi);
        __syncthreads(); SWAIT(); SWRITE(0, SE);
        RESC(alB); __syncthreads();
        SBAR(); qkt<NKS, QLDS>(pA0, pA1, K_lds, qr, Qs, kcb, r32, hi);
        finishSM(pB0, pB1, alB, l_reg, pa0, pa1, pa2, pa3); SBAR();
        if (SDEPTH == 1 || j + 3 < NT) SLOAD(SE, (j + 1 + SDEPTH) * 64); SBAR();
        pv_d0(o, vb0 + SHM_V, pa0, pa1, pa2, pa3); partialSM<MODE>(pA0, pA1, m_reg, mnA, alA, nc, kr0 + j + 1, hi);
        __syncthreads(); SWAIT(); SWRITE(1, SO);
        RESC(alA); __syncthreads();
    }
    SBAR(); qkt<NKS, QLDS>(pB0, pB1, K_lds + SHM_K, qr, Qs, kcb, r32, hi);
    finishSM(pA0, pA1, alA, l_reg, pa0, pa1, pa2, pa3); SBAR();
    pv_d0(o, vb0, pa0, pa1, pa2, pa3); partialSM<MODE>(pB0, pB1, m_reg, mnB, alB, nc, kr0 + NT - 1, hi);
    __syncthreads(); RESC(alB);
    finishSM(pB0, pB1, alB, l_reg, pa0, pa1, pa2, pa3); SBAR();
    pv_d0(o, vb0 + SHM_V, pa0, pa1, pa2, pa3);
    __builtin_amdgcn_s_setprio(0);
    if (hi == 0) li_l[r32] = l_reg; asm volatile("s_waitcnt lgkmcnt(0)" ::: "memory");
    float rli[16];
#pragma unroll
    for (int r = 0; r < 16; ++r) rli[r] = __builtin_amdgcn_rcpf(li_l[crow(r, hi)]);
    const int tid2 = opaque_tid(), wid2 = tid2 >> 6, lane2 = tid2 & 63, r32b = lane2 & 31, hib = lane2 >> 5;
    LAS bf16_t* OT = (LAS bf16_t*)(lds + 65536 + wid2 * 8192);
    if constexpr (MODE == 0) {
        LAS float* XCH = (LAS float*)lds;
        __syncthreads();
        if (wid2 >= 4) {
#pragma unroll
            for (int d = 0; d < 4; ++d)
#pragma unroll
                for (int r = 0; r < 16; ++r) XCH[((wid2 - 4) * 64 + d * 16 + r) * 64 + lane2] = o[d][r] * rli[r] * lam;
        }
        __syncthreads();
        if (wid2 < 4) {
            float ssr[16];
#pragma unroll
            for (int r = 0; r < 16; ++r) ssr[r] = 0.f;
#pragma unroll
            for (int d = 0; d < 4; ++d)
#pragma unroll
                for (int r = 0; r < 16; ++r) { const float v = o[d][r] * rli[r] - XCH[(wid2 * 64 + d * 16 + r) * 64 + lane2]; o[d][r] = v; ssr[r] += v * v; }
#pragma unroll
            for (int r = 0; r < 16; ++r) { float s_ = ssr[r]; s_ += __shfl_xor(s_, 1); s_ += __shfl_xor(s_, 2); s_ += __shfl_xor(s_, 4); s_ += __shfl_xor(s_, 8); s_ += __shfl_xor(s_, 16);
                ssr[r] = rsqrtf(s_ * (1.0f / 128.0f) + EPS) * 0.8f; }
#pragma unroll
            for (int d = 0; d < 4; ++d) { const float sg = subln[d * 32 + r32b];
#pragma unroll
                for (int r = 0; r < 16; ++r) OT[crow(r, hib) * 128 + d * 32 + r32b] = f2bf(o[d][r] * ssr[r] * sg); }
        }
    } else {
#pragma unroll
        for (int d = 0; d < 4; ++d)
#pragma unroll
            for (int r = 0; r < 16; ++r) OT[crow(r, hib) * 128 + d * 32 + r32b] = f2bf(o[d][r] * rli[r]);
    }
    if (MODE == 1 || wid2 < 4) {
        asm volatile("s_waitcnt lgkmcnt(0)" ::: "memory");
        const int otok0 = (MODE == 0) ? (b * S + blk * 128 + wid2 * 32) : (b * S + (blk * 4 + (wid2 >> 1)) * GW + 32 * (wid2 & 1)); const int ocol2 = (MODE == 0) ? (1024 + h * HD) : (h * HD);
#pragma unroll
        for (int it = 0; it < 8; ++it) { const int row = it * 4 + (lane2 >> 4), cc = (lane2 & 15) * 8;
            *(u32x4*)(ATT + (size_t)(otok0 + row) * D + ocol2 + cc) = *(const LAS u32x4*)(OT + row * 128 + cc); }
    }
#undef SLOAD
#undef SWRITE
#undef SWAIT
#undef RESC
}

__device__ __forceinline__ void na_unit(const bf16_t* __restrict__ QKV, bf16_t* __restrict__ ATT, int b, int h, int blk, LAS unsigned char* lds, const float* __restrict__ rpb) {
    const int tid = opaque_tid(), wid = tid >> 6, lane = tid & 63, r32 = lane & 31, hi = lane >> 5;
    LAS unsigned char* R = lds + wid * 16384;
    LAS float* wsr = (LAS float*)(lds + MISC_OFF + 1024) + wid * 64; LAS float* li_l = wsr; LAS float* al_l = wsr + 32;
    LAS float* biasL = (LAS float*)(lds + MISC_OFF + 8192);
    const int r = blk * 4 + (wid >> 1), qc = 32 * (wid & 1) + r32;
    const int qtok = b * S + r * GW + qc, qcol = h * HD, kcol = 1024 + h * HD, vcol = 2048 + h * HD;
    NaCtx nc; nc.bias = biasL; nc.r = r; { int rs = r - 4; nc.rs = rs < 0 ? 0 : (rs > GR - KH ? GR - KH : rs); } nc.qc = qc; { int cs = qc - 8; nc.cs = cs < 0 ? 0 : (cs > GW - KW ? GW - KW : cs); }
    const int rs_w = __builtin_amdgcn_readfirstlane(nc.rs);
    __syncthreads();
    for (int i = tid; i < 15 * 31; i += NTHR) biasL[i] = rpb[h * 15 * 31 + i] * LOG2E;
    float m_reg = -1e30f, l_reg = 0; f32x16 o[4] = {}; bf16x8 qr[8];
    { const bf16_t* Qw = QKV + (size_t)qtok * INC + qcol + hi * 8;
#pragma unroll
      for (int d0 = 0; d0 < 8; ++d0) qr[d0] = *(const bf16x8*)(Qw + d0 * 16); }
    const int sr = lane >> 4, sc = (lane & 15) * 8;
    const int vb0 = (int)(unsigned)(uintptr_t)R + v_rd_base(lane);
    const bf16_t* Kg = QKV + (size_t)(b * S + rs_w * GW + sr) * INC + kcol + sc; const bf16_t* Vg = QKV + (size_t)(b * S + rs_w * GW + sr) * INC + vcol + sc;
    bf16x8 st[16];
#define WLOAD(gp, j) do { _Pragma("unroll") for (int i = 0; i < 16; ++i) st[i] = *(const bf16x8*)((gp) + (size_t)((j) * 64 + 4 * i) * INC); } while (0)
    WLOAD(Kg, 0);
    __syncthreads();
#pragma unroll 1
    for (int j = 0; j < KH; ++j) {
        const int kr = rs_w + j;
#pragma unroll
        for (int i = 0; i < 16; ++i) *(LAS bf16x8*)(R + KSWZ(sr + 4 * i, sc * 2)) = st[i];
        asm volatile("s_waitcnt lgkmcnt(0)" ::: "memory");
        WLOAD(Vg, j);
        f32x16 p0, p1; float mn, al; bf16x8 pa0, pa1, pa2, pa3;
        qkt<8, false>(p0, p1, R, qr, nullptr, 0, r32, hi);
        partialSM<1>(p0, p1, m_reg, mn, al, nc, kr, hi);
        if (__any(al < 1.f)) { if (hi == 0) al_l[r32] = al; asm volatile("s_waitcnt lgkmcnt(0)" ::: "memory");
#pragma unroll
            for (int d = 0; d < 4; ++d)
#pragma unroll
                for (int rr = 0; rr < 16; ++rr) o[d][rr] *= al_l[crow(rr, hi)]; }
        finishSM(p0, p1, al, l_reg, pa0, pa1, pa2, pa3);
        asm volatile("s_waitcnt lgkmcnt(0)" ::: "memory");
#pragma unroll
        for (int i = 0; i < 16; ++i) *(LAS bf16x8*)(R + v_st(sr + 4 * i, sc)) = st[i];
        asm volatile("s_waitcnt lgkmcnt(0)" ::: "memory");
        if (j + 1 < KH) WLOAD(Kg, j + 1);
        pv_d0(o, vb0, pa0, pa1, pa2, pa3);
    }
#undef WLOAD
    if (hi == 0) li_l[r32] = l_reg; asm volatile("s_waitcnt lgkmcnt(0)" ::: "memory");
    float rli[16];
#pragma unroll
    for (int rr = 0; rr < 16; ++rr) rli[rr] = __builtin_amdgcn_rcpf(li_l[crow(rr, hi)]);
    const int tid2 = opaque_tid(), wid2 = tid2 >> 6, lane2 = tid2 & 63, r32b = lane2 & 31, hib = lane2 >> 5;
    LAS bf16_t* OT = (LAS bf16_t*)(lds + wid2 * 16384);
#pragma unroll
    for (int d = 0; d < 4; ++d)
#pragma unroll
        for (int rr = 0; rr < 16; ++rr) OT[crow(rr, hib) * 128 + d * 32 + r32b] = f2bf(o[d][rr] * rli[rr]);
    asm volatile("s_waitcnt lgkmcnt(0)" ::: "memory");
    const int otok0 = b * S + (blk * 4 + (wid2 >> 1)) * GW + 32 * (wid2 & 1);
#pragma unroll
    for (int it = 0; it < 8; ++it) { const int row = it * 4 + (lane2 >> 4), cc = (lane2 & 15) * 8;
        *(u32x4*)(ATT + (size_t)(otok0 + row) * D + h * HD + cc) = *(const LAS u32x4*)(OT + row * 128 + cc); }
}
#undef KSWZ
#undef SBAR
}

__device__ __forceinline__ unsigned pk2(float lo, float hi) { return (unsigned)f2bf(lo) | ((unsigned)f2bf(hi) << 16); }
struct TDesc { const float* W; bf16_t* WT; const float* gain; size_t ob; int K, N, rbase, k0, n0, f8, mode, rs; };
__device__ __forceinline__ void tfix(TDesc& d) {
    if ((d.N & 255) == 0) { const int ksz = d.f8 ? 128 : 64; d.ob = (size_t)(d.rbase >> 8) * 256 * d.K + (size_t)(d.k0 / ksz) * (256 * ksz) + (size_t)(d.rbase & 255) * ksz; d.rs = ksz; }
    else { d.ob = (size_t)d.rbase * d.K + d.k0; d.rs = d.K; }
}
__device__ __forceinline__ void tmake(TDesc& d, const float* W, int K, int N, bf16_t* WT, int mode, const float* gain, int item, int f8 = 0) {
    d.W = W; d.WT = WT; d.gain = gain; d.K = K; d.N = N; d.f8 = f8; d.mode = mode;
    if (f8) { const int nblk = N / 32, kb = item / nblk, nb = item % nblk; d.k0 = 128 * kb; d.n0 = 32 * nb; }
    else { const int nblk = N / 64, kb = item / nblk, nb = item % nblk; d.k0 = 64 * kb; d.n0 = 64 * nb; }
    d.rbase = (mode == 0) ? d.n0 : (256 * (d.n0 >> 7) + (d.n0 & 127) + (mode == 2 ? 128 : 0)); tfix(d);
}
__device__ __forceinline__ void tload(const TDesc& d, f32x4 (&v)[16], float (&gq)[2], int lane) {
    gq[0] = d.gain ? d.gain[d.k0 + lane] : 1.f; gq[1] = (d.gain && d.f8) ? d.gain[d.k0 + 64 + lane] : 1.f;
    if (d.f8) { const float* p = d.W + (size_t)(d.k0 + (lane >> 3)) * d.N + d.n0 + (lane & 7) * 4;
#pragma unroll
        for (int i = 0; i < 16; ++i) v[i] = __builtin_nontemporal_load((const f32x4*)(p + (size_t)(8 * i) * d.N));
        return; }
    const float* p = d.W + (size_t)(d.k0 + (lane >> 4)) * d.N + d.n0 + (lane & 15) * 4;
#pragma unroll
    for (int i = 0; i < 16; ++i) v[i] = __builtin_nontemporal_load((const f32x4*)(p + (size_t)(4 * i) * d.N));
}
__device__ __forceinline__ void tstore(const TDesc& d, const f32x4 (&v)[16], const float (&gq)[2], LAS unsigned char* scr, int lane) {
    const int g = lane >> 4, l16 = lane & 15, r = l16 >> 2, c = l16 & 3; const unsigned sbase = (unsigned)(uintptr_t)scr;
    u32x2 t[8];
    if (d.f8) {
        const float g0 = gq[0] * W8_SCALE, g1 = gq[1] * W8_SCALE;
#pragma unroll
        for (int i = 0; i < 16; ++i) { const int k = 8 * i + (lane >> 3); const float gg = (i < 8) ? __shfl(g0, k) : __shfl(g1, k - 64); const f32x4 x = v[i] * gg;
            u32x2 pk; pk.x = cvt_pk_bf16(x[0], x[1]); pk.y = cvt_pk_bf16(x[2], x[3]); *(LAS u32x2*)(scr + k * 72 + (lane & 7) * 8) = pk; }
        asm volatile("s_waitcnt lgkmcnt(0)" ::: "memory");
        const unsigned lb = sbase + (unsigned)((16 * g + r) * 72 + 8 * c);
        unsigned char* W8 = (unsigned char*)d.WT;
#pragma unroll
        for (int jh = 0; jh < 2; ++jh) {
            if (jh == 0) { asm volatile("ds_read_b64_tr_b16 %0, %8 offset:0\n\tds_read_b64_tr_b16 %1, %8 offset:288\n\tds_read_b64_tr_b16 %2, %8 offset:576\n\tds_read_b64_tr_b16 %3, %8 offset:864\n\tds_read_b64_tr_b16 %4, %8 offset:4608\n\tds_read_b64_tr_b16 %5, %8 offset:4896\n\tds_read_b64_tr_b16 %6, %8 offset:5184\n\tds_read_b64_tr_b16 %7, %8 offset:5472\n\ts_waitcnt lgkmcnt(0)" : "=&v"(t[0]), "=&v"(t[1]), "=&v"(t[2]), "=&v"(t[3]), "=&v"(t[4]), "=&v"(t[5]), "=&v"(t[6]), "=&v"(t[7]) : "v"(lb) : "memory"); } else { asm volatile("ds_read_b64_tr_b16 %0, %8 offset:32\n\tds_read_b64_tr_b16 %1, %8 offset:320\n\tds_read_b64_tr_b16 %2, %8 offset:608\n\tds_read_b64_tr_b16 %3, %8 offset:896\n\tds_read_b64_tr_b16 %4, %8 offset:4640\n\tds_read_b64_tr_b16 %5, %8 offset:4928\n\tds_read_b64_tr_b16 %6, %8 offset:5216\n\tds_read_b64_tr_b16 %7, %8 offset:5504\n\ts_waitcnt lgkmcnt(0)" : "=&v"(t[0]), "=&v"(t[1]), "=&v"(t[2]), "=&v"(t[3]), "=&v"(t[4]), "=&v"(t[5]), "=&v"(t[6]), "=&v"(t[7]) : "v"(lb) : "memory"); }
#pragma unroll
            for (int jj = 0; jj < 2; ++jj) { const int j = jh * 2 + jj, nb = j >> 1, kc = (j & 1) * 4 + g; u32x4 o;
#pragma unroll
                for (int h = 0; h < 4; ++h) { const u32x2 w = t[jj * 4 + h];
                    o[h] = pk4_fp8(__uint_as_float(w.x << 16), __uint_as_float(w.x & 0xffff0000u), __uint_as_float(w.y << 16), __uint_as_float(w.y & 0xffff0000u)); }
                __builtin_nontemporal_store(o, (u32x4*)(W8 + d.ob + (size_t)(16 * nb + l16) * d.rs + 16 * kc)); } }
        return;
    }
    const float gv = gq[0];
#pragma unroll
    for (int i = 0; i < 16; ++i) { const int k = 4 * i + (lane >> 4); const float gg = __shfl(gv, k); const f32x4 x = v[i] * gg;
        u32x2 pk; pk.x = cvt_pk_bf16(x[0], x[1]); pk.y = cvt_pk_bf16(x[2], x[3]); *(LAS u32x2*)(scr + k * 144 + (lane & 15) * 8) = pk; }
    asm volatile("s_waitcnt lgkmcnt(0)" ::: "memory");
    const unsigned lb = sbase + (unsigned)((8 * g + r) * 144 + 8 * c);
#pragma unroll
    for (int jh = 0; jh < 2; ++jh) {
        if (jh == 0) { asm volatile("ds_read_b64_tr_b16 %0, %8 offset:0\n\tds_read_b64_tr_b16 %1, %8 offset:576\n\tds_read_b64_tr_b16 %2, %8 offset:4608\n\tds_read_b64_tr_b16 %3, %8 offset:5184\n\tds_read_b64_tr_b16 %4, %8 offset:32\n\tds_read_b64_tr_b16 %5, %8 offset:608\n\tds_read_b64_tr_b16 %6, %8 offset:4640\n\tds_read_b64_tr_b16 %7, %8 offset:5216\n\ts_waitcnt lgkmcnt(0)" : "=&v"(t[0]), "=&v"(t[1]), "=&v"(t[2]), "=&v"(t[3]), "=&v"(t[4]), "=&v"(t[5]), "=&v"(t[6]), "=&v"(t[7]) : "v"(lb) : "memory"); } else { asm volatile("ds_read_b64_tr_b16 %0, %8 offset:64\n\tds_read_b64_tr_b16 %1, %8 offset:640\n\tds_read_b64_tr_b16 %2, %8 offset:4672\n\tds_read_b64_tr_b16 %3, %8 offset:5248\n\tds_read_b64_tr_b16 %4, %8 offset:96\n\tds_read_b64_tr_b16 %5, %8 offset:672\n\tds_read_b64_tr_b16 %6, %8 offset:4704\n\tds_read_b64_tr_b16 %7, %8 offset:5280\n\ts_waitcnt lgkmcnt(0)" : "=&v"(t[0]), "=&v"(t[1]), "=&v"(t[2]), "=&v"(t[3]), "=&v"(t[4]), "=&v"(t[5]), "=&v"(t[6]), "=&v"(t[7]) : "v"(lb) : "memory"); }
#pragma unroll
        for (int jj = 0; jj < 4; ++jj) { const int j = jh * 4 + jj, nb = j >> 1, kc = (j & 1) * 4 + g; u32x4 o; o.x = t[2 * jj].x; o.y = t[2 * jj].y; o.z = t[2 * jj + 1].x; o.w = t[2 * jj + 1].y;
            *(u32x4*)(d.WT + d.ob + (size_t)(16 * nb + l16) * d.rs + 8 * kc) = o; } }
}

#ifndef DUP_MASK
#define DUP_MASK 0
#endif
struct MArgs { const float* in[30]; float* out; unsigned char* ws; int ph_lo, ph_hi; };
__global__ void __launch_bounds__(NTHR, 2) mega(MArgs args) {
    extern __shared__ __attribute__((aligned(16))) unsigned char lds_raw[];
    LAS unsigned char* lds = (LAS unsigned char*)lds_raw;
    const int tid = threadIdx.x;
    const int G = gridDim.x;
    unsigned char* ws = args.ws;
    unsigned* ctl = (unsigned*)(ws + WS_CTL);
    bf16_t* WB = (bf16_t*)(ws + WS_WBF);
    float* PART = (float*)(ws + WS_PART);
    LAS float* PL = (LAS float*)(lds + MISC_OFF + 4096);
    volatile LAS unsigned* MISC = (volatile LAS unsigned*)(lds + MISC_OFF);
    if (tid < 64) MISC[tid] = 0u;
    __syncthreads();
    const int lo = args.ph_lo, hi = args.ph_hi;
    const bool multi = (hi - lo) > 1;
    XcdBarrier bar; bar.bar = ctl + CW_BAR; bar.x = 0; bar.st = nullptr;
    if (multi) bar = xcd_barrier_post(ctl + CW_BAR, MISC + 8);
#define IN(k) (lo <= (k) && (k) < hi)
#define REP(k) for (int rep_ = 0; rep_ <= ((DUP_MASK >> (k)) & 1); ++rep_)
#define SEAM(k) do { if (IN(k) && IN((k) + 1)) xcd_barrier(bar); } while (0)
    const int NGW = G * NWAVES;
#define PHASE_IDS() const int ptid = opaque_tid(), lane = ptid & 63, wave = __builtin_amdgcn_readfirstlane(ptid >> 6), gw = blockIdx.x * NWAVES + wave; (void)lane; (void)gw

    constexpr int I_IN0 = (D / 64) * (INC / 64), I_SQ = (D / 64) * (D / 64), I_FF = (D / 64) * (FF / 64), I_DN = (FF / 64) * (D / 64), I_IN1 = (D / 64) * (2 * D / 64), I_LRU = 64 * 4;
    constexpr int NITEMS = I_IN0 + I_SQ + 2 * I_FF + I_DN + I_IN1 + I_SQ + I_LRU + NE * (2 * I_FF + I_DN);
    constexpr int NDENSE = I_IN0 + I_LRU;
    constexpr int QLRU = I_IN0 + I_SQ + 2 * I_FF + I_DN + I_IN1 + I_SQ;
    constexpr int QA = QLRU - I_IN0;
    constexpr int TAIL_ITEMS = 24576, TAILQ = ((NITEMS - I_IN0 - I_LRU) - TAIL_ITEMS) & ~15;
    static_assert(QA % 16 == 0 && (INC / 64) % 16 == 0 && (D / 64) % 16 == 0 && (FF / 64) % 16 == 0 && (2 * D / 64) % 16 == 0 && (FF / 32) % 16 == 0 && (D / 32) % 16 == 0, "a 16-item queue chunk stays inside one (matrix, k-block)");
    REP(0) if (IN(0)) { PHASE_IDS();
        LAS unsigned char* scr = lds + wave * 16384;
#define TDECODE(dd, it_) do { int r = (it_); \
            if (r < I_IN0) { tmake(dd, args.in[2], D, INC, WB + WT_IN0, 0, args.in[1], r); break; } r -= I_IN0; \
            if (r < I_SQ) { tmake(dd, args.in[9], D, D, WB + WT_OUT0, 0, nullptr, r); break; } r -= I_SQ; \
            if (r < I_FF) { tmake(dd, args.in[11], D, FF, WB + WT_GU0, 1, args.in[10], r, FFNGU8); break; } r -= I_FF; \
            if (r < I_FF) { tmake(dd, args.in[12], D, FF, WB + WT_GU0, 2, args.in[10], r, FFNGU8); break; } r -= I_FF; \
            if (r < I_DN) { tmake(dd, args.in[13], FF, D, WB + WT_DN0, 0, nullptr, r, FFNDN8); break; } r -= I_DN; \
            if (r < I_IN1) { tmake(dd, args.in[15], D, 2 * D, WB + WT_IN1, 0, args.in[14], r); break; } r -= I_IN1; \
            if (r < I_SQ) { tmake(dd, args.in[23], D, D, WB + WT_OUT1, 0, nullptr, r); break; } r -= I_SQ; \
            if (r < I_LRU) { const int mat = r >> 2, sub = r & 3; const float* src = (mat < 32 ? args.in[18] : args.in[20]) + (size_t)(mat & 31) * LBD * LBD; \
                tmake(dd, src, LBD, LBD, WB + WT_LRU + (size_t)mat * LBD * LBD, 0, nullptr, sub); break; } r -= I_LRU; \
            { const int per = 2 * I_FF + I_DN, e = r / per; int q = r % per; \
              if (q < I_FF) { tmake(dd, args.in[26] + (size_t)e * D * FF, D, FF, (bf16_t*)((unsigned char*)(WB + WT_MGU) + (size_t)e * 2 * FF * D), 1, args.in[24], q, 1); break; } q -= I_FF; \
              if (q < I_FF) { tmake(dd, args.in[27] + (size_t)e * D * FF, D, FF, (bf16_t*)((unsigned char*)(WB + WT_MGU) + (size_t)e * 2 * FF * D), 2, args.in[24], q, 1); break; } q -= I_FF; \
              tmake(dd, args.in[28] + (size_t)e * FF * D, FF, D, (bf16_t*)((unsigned char*)(WB + WT_MDN) + (size_t)e * FF * D), 0, nullptr, q, 1); } } while (0)
        { TDesc dc, dn; f32x4 cur[16], nxt[16]; float gc[2], gn2[2]; int it = gw;
#define P0_ITEM(i_) ((i_) < I_IN0 ? (i_) : (i_) - I_IN0 + QLRU)
          if (it < NDENSE) { TDECODE(dc, P0_ITEM(it)); tload(dc, cur, gc, lane); }
          for (; it < NDENSE; it += NGW) {
              const int nit = it + NGW; const bool hn = nit < NDENSE;
              if (hn) { TDECODE(dn, P0_ITEM(nit)); tload(dn, nxt, gn2, lane); }
              tstore(dc, cur, gc, scr, lane);
              if (hn) { dc = dn; gc[0] = gn2[0]; gc[1] = gn2[1];
#pragma unroll
                  for (int i = 0; i < 16; ++i) cur[i] = nxt[i]; } }
#undef P0_ITEM
        }
        { float* C8 = (float*)(ws + WS_C8SP);
          for (int i = blockIdx.x * NTHR + tid; i < 2 * D; i += G * NTHR) { const float ap = args.in[22][i]; const float sp = (-ap > 20.f) ? -ap : log1pf(expf(-ap)); C8[i] = -8.0f * sp * 1.4426950408889634f; } }
        { float* RC = (float*)(ws + WS_ROPE); float* RS = RC + S * 32;
          for (int i = blockIdx.x * NTHR + tid; i < S * 32; i += G * NTHR) { const int s = i / 32, j = i % 32; const float inv = 1.0f / powf(10000.0f, (float)(2 * j) / 64.0f); const float ang = (float)s * inv; RC[i] = cosf(ang); RS[i] = sinf(ang); } }
        { bf16_t* XB = (bf16_t*)(ws + WS_XB);
          for (int m = gw; m < T; m += NGW) { const f32x4* xr = (const f32x4*)(args.in[0] + (size_t)m * D) + lane; float ss = 0.f;
#pragma unroll
              for (int j = 0; j < 8; ++j) { const f32x4 v = xr[64 * j]; ss += (v[0] * v[0] + v[1] * v[1]) + (v[2] * v[2] + v[3] * v[3]);
                  u32x2 w; w.x = cvt_pk_bf16(v[0], v[1]); w.y = cvt_pk_bf16(v[2], v[3]); *((u32x2*)(XB + (size_t)m * D) + lane + 64 * j) = w; }
              ss = wave_sum(ss); if (lane < 8) PART[(size_t)m * 8 + lane] = (lane == 0) ? ss : 0.f; } }
    }
    SEAM(0);
    REP(1) if (IN(1)) {
        Gemm g{(const bf16_t*)(ws + WS_XB), WB + WT_IN0, INC, D, 0}; StaticOrder So; So.init(T, INC, G, (int)blockIdx.x);
        EpiQkv E{(bf16_t*)(ws + WS_QKV), PART, (const float*)(ws + WS_ROPE), (const float*)(ws + WS_ROPE) + S * 32};
        gemm_phase<EpiQkv, StaticOrder, 2, false>(lds, g, So, E);
    }
    SEAM(1);
    REP(2) if (IN(2)) { PHASE_IDS();
        const bf16_t* QKV = (const bf16_t*)(ws + WS_QKV); bf16_t* ATT = (bf16_t*)(ws + WS_ATT);
        float s1 = 0.f, s2 = 0.f;
        for (int i = 0; i < 64; ++i) { s1 += args.in[4][i] * args.in[5][i]; s2 += args.in[6][i] * args.in[7][i]; }
        const float lam = expf(s1) - expf(s2) + 0.2f;
        const unsigned myx = xb_xcc_id() & 7u;
        if (tid == 0) MISC[16] = xb_add(ctl + CW_XRANK + 64 * myx, 1u);
        __syncthreads();
        const bool conv_first = (unsigned)__builtin_amdgcn_readfirstlane((int)MISC[16]) < (unsigned)NCV_PER_XCD;
#define P2_NEXT(dd, ok) do { if (crem == 0) { if (!qhave) { cstepn = (qpos >= TAILQ) ? 4 : 16; qnext = 4 * (int)__builtin_amdgcn_readfirstlane((int)(lane == 0 ? xb_add(ctl + CW_CVQ, (unsigned)(cstepn >> 2)) : 0u)); } \
                qpos = qnext; crem = cstepn; cbase = -1; qhave = false; } \
            if (cbase < 0 || (qpos & 15) == 0) { const int item_ = I_IN0 + qpos + (qpos >= QA ? I_LRU : 0); cvalid = item_ < NITEMS; if (cvalid) { TDECODE(cd, item_); } cbase = qpos; } \
            ok = cvalid; if (ok) { dd = cd; dd.n0 = cd.n0 + (qpos - cbase) * (cd.f8 ? 32 : 64); dd.rbase = (cd.mode == 0) ? dd.n0 : (256 * (dd.n0 >> 7) + (dd.n0 & 127) + (cd.mode == 2 ? 128 : 0)); tfix(dd); } \
            ++qpos; --crem; qwant = (crem == 0) && cvalid; } while (0)
#define P2_POST() do { if (qwant) { cstepn = (qpos >= TAILQ) ? 4 : 16; qnext = 4 * (int)__builtin_amdgcn_readfirstlane((int)(lane == 0 ? xb_add(ctl + CW_CVQ, (unsigned)(cstepn >> 2)) : 0u)); qhave = true; qwant = false; } } while (0)
#define P2_CONVERT() do { LAS unsigned char* scr = lds + wave * 16384; TDesc cd, dc, dn; f32x4 cur[16], nxt[16]; float gc[2], gn2[2]; int qpos = 0, crem = 0, cbase = -1, cstepn = 16, qnext = 0; bool cvalid = false, qhave = false, qwant = false, okc, okn; \
            P2_NEXT(dc, okc); if (okc) tload(dc, cur, gc, lane); P2_POST(); \
            while (okc) { \
                P2_NEXT(dn, okn); if (okn) tload(dn, nxt, gn2, lane); P2_POST(); \
                tstore(dc, cur, gc, scr, lane); \
                if (okn) { dc = dn; gc[0] = gn2[0]; gc[1] = gn2[1]; _Pragma("unroll") for (int i = 0; i < 16; ++i) cur[i] = nxt[i]; } \
                okc = okn; } \
            __syncthreads(); } while (0)
#define P2_CONVERT3() do { const int lane = opaque_tid() & 63; LAS unsigned char* scr = lds + wave * 16384; TDesc cd, d0, d1, d2; f32x4 b0[16], b1[16], b2[16]; float g0q[2], g1q[2], g2q[2]; int qpos = 0, crem = 0, cbase = -1, cstepn = 16, qnext = 0; bool cvalid = false, qhave = false, qwant = false, k0, k1, k2; \
            P2_NEXT(d0, k0); if (k0) tload(d0, b0, g0q, lane); P2_POST(); \
            P2_NEXT(d1, k1); if (k1) tload(d1, b1, g1q, lane); P2_POST(); \
            while (k0) { \
                P2_NEXT(d2, k2); if (k2) tload(d2, b2, g2q, lane); P2_POST(); \
                tstore(d0, b0, g0q, scr, lane); \
                if (!k1) break; \
                P2_NEXT(d0, k0); if (k0) tload(d0, b0, g0q, lane); P2_POST(); \
                tstore(d1, b1, g1q, scr, lane); \
                if (!k2) break; \
                P2_NEXT(d1, k1); if (k1) tload(d1, b1, g1q, lane); P2_POST(); \
                tstore(d2, b2, g2q, scr, lane); } \
            } while (0)
        if (conv_first) { P2_CONVERT3(); __syncthreads(); }
#pragma unroll 1
        for (unsigned qx = 0; qx < 8; ++qx) { const unsigned x = (myx + qx) & 7u;
            for (;;) {
                __syncthreads();
                if (tid == 0) MISC[17] = xb_add(ctl + CW_AQ + 64 * x, 1u);
                __syncthreads();
                const unsigned u = MISC[17]; if (u >= 96u) break;
                if (u < 64u) { const int bh = 2 * (int)x + (int)(u >> 5), qb = (int)(u & 31u); att::attn_unit<0>(QKV, ATT, bh >> 3, bh & 7, qb, lds, args.in[8], lam, nullptr); }
                else { const int c = (int)u - 64, bh = 2 * (int)x + (c >> 4), rb = c & 15; att::na_unit(QKV, ATT, bh >> 3, bh & 7, rb, lds, args.in[3]); } } }
        __syncthreads();
        if (!conv_first) { P2_CONVERT3(); __syncthreads(); }
#undef P2_CONVERT
#undef P2_CONVERT3
#undef P2_NEXT
#undef P2_POST
    }
#undef TDECODE
    SEAM(2);
    REP(3) if (IN(3)) {
        Gemm g{(const bf16_t*)(ws + WS_ATT), WB + WT_OUT0, D, D, 0}; StaticOrder So; So.init(T, D, G, (int)blockIdx.x);
        EpiResid E{args.in[0], (float*)(ws + WS_X1), FFNGU8 ? nullptr : (bf16_t*)(ws + WS_XB), PART + 8 * T, PL, FFNGU8 ? (unsigned char*)(ws + WS_HA) : nullptr, 1.f};
        gemm_phase<EpiResid, StaticOrder, 0, false>(lds, g, So, E);
    }
    SEAM(3);
    REP(4) if (IN(4)) {
        Gemm g{(const bf16_t*)(ws + (FFNGU8 ? WS_HA : WS_XB)), WB + WT_GU0, 2 * FF, D, 0}; StaticOrder So; So.init(T, 2 * FF, G, (int)blockIdx.x);
        EpiGateUp<false, FFNDN8, FFNGU8> E{(bf16_t*)(ws + WS_ACT), PART + 8 * T, nullptr};
        gemm_phase<EpiGateUp<false, FFNDN8, FFNGU8>, StaticOrder, 1, false, FFNGU8>(lds, g, So, E);
    }
    SEAM(4);
    REP(5) if (IN(5)) {
        Gemm g{(const bf16_t*)(ws + WS_ACT), WB + WT_DN0, D, FF, 0}; StaticOrder So; So.init(T, D, G, (int)blockIdx.x);
        EpiResid E{(const float*)(ws + WS_X1), (float*)(ws + WS_X2), (bf16_t*)(ws + WS_XB), PART + 16 * T, PL, nullptr, FFNDN8 ? W8_INV : 1.f};
        gemm_phase<EpiResid, StaticOrder, 0, false, FFNDN8>(lds, g, So, E);
    }
    SEAM(5);
    REP(6) if (IN(6)) {
        Gemm g{(const bf16_t*)(ws + WS_XB), WB + WT_IN1, 2 * D, D, 0}; StaticOrder So; So.init(T, 2 * D, G, (int)blockIdx.x);
        EpiL1In E{(bf16_t*)(ws + WS_Y), (bf16_t*)(ws + WS_REC), PART + 16 * T};
        gemm_phase<EpiL1In, StaticOrder, 1, false>(lds, g, So, E);
    }
    SEAM(6);
    REP(7) if (IN(7)) {
        const int ptid = opaque_tid(), wv = __builtin_amdgcn_readfirstlane(ptid >> 6);
        const bf16_t* REC = (const bf16_t*)(ws + WS_REC); bf16_t* AB = (bf16_t*)(ws + WS_AB); const float* C8 = (const float*)(ws + WS_C8SP);
        float* SUMM = (float*)(ws + WS_SUMM);
        LAS unsigned char* Us = lds;
        LAS unsigned char* Ws = lds + 65536;
        LAS float* BL = (LAS float*)(lds + MISC_OFF + 8192);
        LAS unsigned char* TB = Us + wv * 8192;
#define SWZ(row, colB) ((row) * 256 + ((colB) ^ (((row) & 7) << 4)))
        constexpr float L2E = 1.4426950408889634f;
        for (int unit = blockIdx.x; unit < (T / 256) * LB; unit += G) {
            const int nb_ = unit % LB, tt = unit / LB, t0 = tt * 256, c0 = nb_ * LBD;
            {
              const int ctid = opaque_tid(); const int cg = ctid & 15, tr = ctid >> 4, cc = c0 + cg * 8; const int tb = t0 & ~(S - 1);
              float w8[4][8], b8[8];
              { const f32x4 b0 = *(const f32x4*)(args.in[17] + cc), b1 = *(const f32x4*)(args.in[17] + cc + 4);
#pragma unroll
                for (int i = 0; i < 4; ++i) { b8[i] = b0[i]; b8[4 + i] = b1[i]; } }
#pragma unroll
              for (int j = 0; j < 4; ++j) { const f32x4 x0 = *(const f32x4*)(args.in[16] + j * D + cc), x1 = *(const f32x4*)(args.in[16] + j * D + cc + 4);
#pragma unroll
                  for (int i = 0; i < 4; ++i) { w8[j][i] = x0[i]; w8[j][4 + i] = x1[i]; } }
              u32x4 rv[11];
#pragma unroll
              for (int q = 0; q < 11; ++q) { const int t = t0 + tr * 8 + q - 1; const bool ok = (t >= tb) && (t < tb + S);
                  rv[q] = ok ? *(const u32x4*)(REC + ((size_t)(t >> 8) * LB + nb_) * (256 * LBD) + (size_t)(t & 255) * LBD + cg * 8) : (u32x4){0u, 0u, 0u, 0u}; }
#pragma unroll
              for (int q = 0; q < 8; ++q) { float uo[8];
#pragma unroll
                  for (int i = 0; i < 8; ++i) { float acc_ = b8[i];
#pragma unroll
                      for (int j = 0; j < 4; ++j) { const unsigned w = rv[q + j][i >> 1]; acc_ += w8[j][i] * __uint_as_float((i & 1) ? (w & 0xffff0000u) : (w << 16)); }
                      uo[i] = acc_; }
                  u32x4 pk; pk.x = cvt_pk_bf16(uo[0], uo[1]); pk.y = cvt_pk_bf16(uo[2], uo[3]); pk.z = cvt_pk_bf16(uo[4], uo[5]); pk.w = cvt_pk_bf16(uo[6], uo[7]);
                  *(LAS u32x4*)(Us + SWZ(tr * 8 + q, cg * 16)) = pk; } }
            asm volatile("s_waitcnt lgkmcnt(0)" ::: "memory");
            bf16x8 uf[2][4]; const int ul = opaque_tid();
#pragma unroll
            for (int tg = 0; tg < 2; ++tg)
#pragma unroll
                for (int ks = 0; ks < 4; ++ks) uf[tg][ks] = *(const LAS bf16x8*)(Us + SWZ((ul >> 6) * 32 + tg * 16 + (ul & 15), 64 * ((ul >> 4) & 3) + 16 * ks));
#pragma unroll 1
            for (int dir = 0; dir < 2; ++dir) {
                __syncthreads();
                { const int stid = opaque_tid();
                  const bf16_t* wa = WB + WT_LRU + (size_t)(0 * 32 + dir * 16 + nb_) * LBD * LBD; const bf16_t* wx = WB + WT_LRU + (size_t)(1 * 32 + dir * 16 + nb_) * LBD * LBD;
#pragma unroll
                  for (int q = 0; q < 4; ++q) { const int idx = stid + q * NTHR, slot = idx >> 4, ch = idx & 15, row = 32 * ((slot & 15) >> 2) + 4 * (slot >> 4) + (slot & 3);
                      *(LAS u32x4*)(Ws + SWZ(slot, ch * 16)) = *(const u32x4*)(wa + row * LBD + ch * 8);
                      *(LAS u32x4*)(Ws + 32768 + SWZ(slot, ch * 16)) = *(const u32x4*)(wx + row * LBD + ch * 8); }
                  if (dir == 0) { for (int i = stid; i < 768; i += NTHR) { const int d_ = i / 384, k_ = (i >> 7) % 3, c_ = i & 127;
                      BL[i] = (k_ == 0) ? -L2E * args.in[19][d_ * D + c0 + c_] : (k_ == 1) ? -L2E * args.in[21][d_ * D + c0 + c_] : C8[d_ * D + c0 + c_]; } } }
                __syncthreads();
                f32x4 aa[2][8], ax[2][8]; const int ml = opaque_tid() & 63, mfr = ml & 15, mfq = ml >> 4;
#pragma unroll
                for (int nb = 0; nb < 8; ++nb) { aa[0][nb] = (f32x4){0.f, 0.f, 0.f, 0.f}; ax[0][nb] = aa[0][nb]; aa[1][nb] = aa[0][nb]; ax[1][nb] = aa[0][nb]; }
#pragma unroll
                for (int ks = 0; ks < 4; ++ks)
#pragma unroll
                    for (int nb = 0; nb < 8; ++nb) { const bf16x8 wfa = *(const LAS bf16x8*)(Ws + SWZ(nb * 16 + mfr, 64 * mfq + 16 * ks)), wfx = *(const LAS bf16x8*)(Ws + 32768 + SWZ(nb * 16 + mfr, 64 * mfq + 16 * ks));
                        aa[0][nb] = __builtin_amdgcn_mfma_f32_16x16x32_bf16(wfa, uf[0][ks], aa[0][nb], 0, 0, 0); ax[0][nb] = __builtin_amdgcn_mfma_f32_16x16x32_bf16(wfx, uf[0][ks], ax[0][nb], 0, 0, 0);
                        aa[1][nb] = __builtin_amdgcn_mfma_f32_16x16x32_bf16(wfa, uf[1][ks], aa[1][nb], 0, 0, 0); ax[1][nb] = __builtin_amdgcn_mfma_f32_16x16x32_bf16(wfx, uf[1][ks], ax[1][nb], 0, 0, 0); }
                const int l2 = opaque_tid() & 63, fr2 = l2 & 15, fq2 = l2 >> 4;
                const LAS float* blp = BL + dir * 384 + 32 * fq2;
                float sml[2][2], smh[2][2];
#pragma unroll
                for (int tg = 0; tg < 2; ++tg) {
#pragma unroll
                    for (int nb = 0; nb < 8; ++nb) {
                        const f32x4 ba = *(const LAS f32x4*)(blp + 4 * nb), bx = *(const LAS f32x4*)(blp + 128 + 4 * nb), c8 = *(const LAS f32x4*)(blp + 256 + 4 * nb);
                        const unsigned w0 = (unsigned)(unsigned short)uf[tg][nb >> 1][(nb & 1) * 4 + 0] | ((unsigned)(unsigned short)uf[tg][nb >> 1][(nb & 1) * 4 + 1] << 16);
                        const unsigned w1 = (unsigned)(unsigned short)uf[tg][nb >> 1][(nb & 1) * 4 + 2] | ((unsigned)(unsigned short)uf[tg][nb >> 1][(nb & 1) * 4 + 3] << 16);
                        const float uvv[4] = {__uint_as_float(w0 << 16), __uint_as_float(w0 & 0xffff0000u), __uint_as_float(w1 << 16), __uint_as_float(w1 & 0xffff0000u)};
                        float av[4], bv[4];
#pragma unroll
                        for (int i = 0; i < 4; ++i) { const float ga = __builtin_amdgcn_rcpf(1.f + __builtin_amdgcn_exp2f(fmaf(aa[tg][nb][i], -L2E, ba[i]))), gx = __builtin_amdgcn_rcpf(1.f + __builtin_amdgcn_exp2f(fmaf(ax[tg][nb][i], -L2E, bx[i])));
                            const float la2 = c8[i] * ga; const float a = __builtin_amdgcn_exp2f(la2);
                            av[i] = la2; bv[i] = __builtin_amdgcn_sqrtf(fmaxf(fmaf(-a, a, 1.f), 0.f)) * gx * uvv[i]; }
                        u32x2 pa, pb; pa.x = cvt_pk_bf16(av[0], av[1]); pa.y = cvt_pk_bf16(av[2], av[3]); pb.x = cvt_pk_bf16(bv[0], bv[1]); pb.y = cvt_pk_bf16(bv[2], bv[3]);
                        const int off = fr2 * 256 + (((4 * fq2 + (nb >> 1)) ^ fr2) << 4) + (nb & 1) * 8;
                        *(LAS u32x2*)(TB + off) = pa; *(LAS u32x2*)(TB + 4096 + off) = pb; }
                    asm volatile("s_waitcnt lgkmcnt(0)" ::: "memory");
#pragma unroll
                    for (int q = 0; q < 4; ++q) { const int row = 4 * q + fq2, chunk = fr2; const size_t go = (size_t)(wv * 32 + tg * 16 + row) * LBD + 8 * chunk;
                        const u32x4 va = *(const LAS u32x4*)(TB + row * 256 + ((chunk ^ row) << 4)), vb = *(const LAS u32x4*)(TB + 4096 + row * 256 + ((chunk ^ row) << 4));
                        *(u32x4*)(AB + (size_t)(unit * 4 + dir * 2 + 0) * (256 * LBD) + go) = va; *(u32x4*)(AB + (size_t)(unit * 4 + dir * 2 + 1) * (256 * LBD) + go) = vb; }
                    { float sl0 = 0.f, sl1 = 0.f, h0 = 0.f, h1 = 0.f; const int cc16 = (l2 >> 2) << 4, cin = (l2 & 3) * 4;
#pragma unroll
                      for (int i = 0; i < 16; ++i) { const int ri = dir ? 15 - i : i; const int ad = ri * 256 + (cc16 ^ (ri << 4)) + cin;
                          const unsigned wa_ = *(const LAS unsigned*)(TB + ad), wb_ = *(const LAS unsigned*)(TB + 4096 + ad);
                          const float la0 = __uint_as_float(wa_ << 16), la1 = __uint_as_float(wa_ & 0xffff0000u);
                          h0 = fmaf(__builtin_amdgcn_exp2f(la0), h0, __uint_as_float(wb_ << 16)); h1 = fmaf(__builtin_amdgcn_exp2f(la1), h1, __uint_as_float(wb_ & 0xffff0000u));
                          sl0 += la0; sl1 += la1; }
                      sml[tg][0] = sl0; sml[tg][1] = sl1; smh[tg][0] = h0; smh[tg][1] = h1; }
                }
                {
                  const int c = c0 + 2 * l2, b_ = t0 / S, chk = ((t0 & (S - 1)) >> 5) + wv;
                  f32x2 Pv, Hv;
#pragma unroll
                  for (int j = 0; j < 2; ++j) { const float A0 = __builtin_amdgcn_exp2f(sml[0][j]), A1 = __builtin_amdgcn_exp2f(sml[1][j]);
                      Pv[j] = __builtin_amdgcn_exp2f(sml[0][j] + sml[1][j]); Hv[j] = dir ? fmaf(A0, smh[1][j], smh[0][j]) : fmaf(A1, smh[0][j], smh[1][j]); }
                  float* sp = SUMM + ((size_t)((b_ * 2 + dir) * 128 + chk) * D) * 2 + (size_t)(c >> 2) * 8 + (c & 3);
                  *(f32x2*)sp = Pv; *(f32x2*)(sp + 4) = Hv; }
            }
        }
#undef SWZ
        __syncthreads();
    }
    SEAM(7);
    REP(9) if (IN(9)) {
        const int ptid = opaque_tid();
        const float* SUMM = (const float*)(ws + WS_SUMM); float* CARRY = (float*)(ws + WS_CARRY);
        for (int it = blockIdx.x * NTHR + ptid; it < NB * 2 * (D / 4) * 16; it += G * NTHR) {
            const int seg = it & 15, c4 = (it >> 4) % (D / 4), dir = ((it >> 4) / (D / 4)) % 2, b = (it >> 4) / (D / 4) / 2;
            f32x4 P[8], H[8];
#pragma unroll
            for (int j = 0; j < 8; ++j) { const int k = seg * 8 + j, ch = dir ? 127 - k : k; const size_t base = (size_t)((b * 2 + dir) * 128 + ch) * D + c4 * 4;
                P[j] = *(const f32x4*)(SUMM + base * 2); H[j] = *(const f32x4*)(SUMM + base * 2 + 4); }
            f32x4 A = P[0], Bv = H[0];
#pragma unroll
            for (int j = 1; j < 8; ++j) { Bv = P[j] * Bv + H[j]; A = A * P[j]; }
#pragma unroll
            for (int off = 1; off < 16; off <<= 1) { f32x4 Ap, Bp;
#pragma unroll
                for (int q = 0; q < 4; ++q) { Ap[q] = __shfl_up(A[q], off, 16); Bp[q] = __shfl_up(Bv[q], off, 16); }
                if (seg >= off) { Bv = A * Bp + Bv; A = A * Ap; } }
            f32x4 h;
#pragma unroll
            for (int q = 0; q < 4; ++q) h[q] = __shfl_up(Bv[q], 1, 16);
            if (seg == 0) h = (f32x4){0.f, 0.f, 0.f, 0.f};
#pragma unroll
            for (int j = 0; j < 8; ++j) { const int k = seg * 8 + j, ch = dir ? 127 - k : k; const size_t base = (size_t)((b * 2 + dir) * 128 + ch) * D + c4 * 4;
                *(f32x4*)(CARRY + base) = h; h = P[j] * h + H[j]; }
        }
    }
    SEAM(9);
    REP(10) if (IN(10)) {
        const int ptid = opaque_tid();
        const bf16_t* AB = (const bf16_t*)(ws + WS_AB); const float* CARRY = (const float*)(ws + WS_CARRY); const bf16_t* Y = (const bf16_t*)(ws + WS_Y); bf16_t* Z = (bf16_t*)(ws + WS_Z);
        for (int it = blockIdx.x * NTHR + ptid; it < NB * 128 * (D / 2); it += G * NTHR) {
            const int c2 = it % (D / 2), ch = (it / (D / 2)) % 128, b = it / (D / 2) / 128; const int c = c2 * 2;
            const bf16_t* af = AB + (size_t)((c >> 7) * 4) * (256 * LBD) + (c & 127); const bf16_t* bf = af + 256 * LBD; const bf16_t* ab = af + 2 * 256 * LBD; const bf16_t* bb = af + 3 * 256 * LBD;
#define LD2(p) ({ const unsigned _w = *(const unsigned*)(p); (f32x2){__uint_as_float(_w << 16), __uint_as_float(_w & 0xffff0000u)}; })
#define EXP2V(v) ((f32x2){__builtin_amdgcn_exp2f((v)[0]), __builtin_amdgcn_exp2f((v)[1])})
            f32x2 h = *(const f32x2*)(CARRY + (size_t)((b * 2 + 0) * 128 + ch) * D + c);
            LAS f32x2* hf = (LAS f32x2*)lds + ptid;
            const size_t o0 = (size_t)(b * S + ch * 32) * D; const int tk0 = b * S + ch * 32; const size_t q0 = (size_t)(tk0 >> 8) * (LB * 4 * 256 * LBD) + (size_t)(tk0 & 255) * LBD;
#pragma unroll 8
            for (int i = 0; i < 32; ++i) { const size_t o = q0 + (size_t)i * LBD; const f32x2 la = LD2(af + o); h = EXP2V(la) * h + LD2(bf + o); hf[i * NTHR] = h; }
            h = *(const f32x2*)(CARRY + (size_t)((b * 2 + 1) * 128 + ch) * D + c);
#pragma unroll 8
            for (int i = 31; i >= 0; --i) { const size_t o = o0 + (size_t)i * D, q = q0 + (size_t)i * LBD; const f32x2 la = LD2(ab + q); h = EXP2V(la) * h + LD2(bb + q);
                const unsigned yv = *(const unsigned*)(Y + o + c); const float y0 = __uint_as_float(yv << 16), y1 = __uint_as_float(yv & 0xffff0000u);
                const f32x2 hv = hf[i * NTHR];
                *(unsigned*)(Z + o + c) = cvt_pk_bf16(y0 * (hv[0] + h[0]), y1 * (hv[1] + h[1])); }
#undef LD2
#undef EXP2V
        }
    }
    SEAM(10);
    REP(11) if (IN(11)) {
        Gemm g{(const bf16_t*)(ws + WS_Z), WB + WT_OUT1, D, D, 0}; StaticOrder So; So.init(T, D, G, (int)blockIdx.x);
        EpiResid E{(const float*)(ws + WS_X2), (float*)(ws + WS_X1), nullptr, PART + 24 * T, PL, nullptr, 1.f};
        gemm_phase<EpiResid, StaticOrder, 0, false>(lds, g, So, E);
    }
    SEAM(11);
    REP(12) if (IN(12)) { PHASE_IDS();
        const float* X3 = (const float*)(ws + WS_X1); const float* P3 = PART + 24 * T; const float* gn = args.in[24]; const float* rw = args.in[25];
        int* LIST = (int*)(ws + WS_LIST); int* INV = (int*)(ws + WS_INV); float* GATEW = (float*)(ws + WS_GATEW); unsigned* CNT = ctl + CW_CNT;
        volatile LAS int* sel = (volatile LAS int*)(lds + MISC_OFF + 8192);
        unsigned char* XN8 = (unsigned char*)(ws + WS_HA);
        LAS float* RT = (LAS float*)lds;
        f32x4 xr[8], xq[8];
        if ((int)blockIdx.x * 32 < T) {
#pragma unroll
            for (int j = 0; j < 8; ++j) xr[j] = *(const f32x4*)(X3 + (size_t)(blockIdx.x * 32 + wave * 4) * D + lane * 4 + 256 * j); }
        __syncthreads();
        for (int idx = tid; idx < D * 2; idx += NTHR) { const int c = idx >> 1, hf = idx & 1, slot = ((c >> 8) * 4 + (c & 3)) * 64 + ((c & 255) >> 2);
            *(LAS f32x4*)(RT + slot * 8 + hf * 4) = *(const f32x4*)(rw + (size_t)c * NE + hf * 4) * gn[c]; }
        __syncthreads();
        for (int t0 = blockIdx.x * 32; t0 < T; t0 += G * 32) {
            if (t0 != (int)blockIdx.x * 32) {
#pragma unroll
                for (int j = 0; j < 8; ++j) xr[j] = *(const f32x4*)(X3 + (size_t)(t0 + wave * 4) * D + lane * 4 + 256 * j); }
#pragma unroll 1
            for (int q = 0; q < 4; ++q) { const int tl = wave * 4 + q, t = t0 + tl;
                if (q < 3) {
#pragma unroll
                    for (int j = 0; j < 8; ++j) xq[j] = *(const f32x4*)(X3 + (size_t)(t + 1) * D + lane * 4 + 256 * j); }
                const float rstd = row_rstd(P3, t); float lg[NE];
#pragma unroll
                for (int e = 0; e < NE; ++e) lg[e] = 0.f;
#pragma unroll
                for (int j = 0; j < 8; ++j) { const int c0 = lane * 4 + 256 * j; const f32x4 xv = xr[j] * rstd;
                    *(unsigned*)(XN8 + (size_t)t * D + c0) = pk4_fp8(xv[0], xv[1], xv[2], xv[3]);
#pragma unroll
                    for (int i = 0; i < 4; ++i) { const float hv = xv[i]; const LAS float* rp = RT + ((j * 4 + i) * 64 + lane) * 8; const f32x4 r0 = *(const LAS f32x4*)rp, r1 = *(const LAS f32x4*)(rp + 4);
                        lg[0] += hv * r0[0]; lg[1] += hv * r0[1]; lg[2] += hv * r0[2]; lg[3] += hv * r0[3]; lg[4] += hv * r1[0]; lg[5] += hv * r1[1]; lg[6] += hv * r1[2]; lg[7] += hv * r1[3]; } }
#pragma unroll
                for (int e = 0; e < NE; ++e) lg[e] = wave_sum(lg[e]);
                int i1 = 0; float v1 = lg[0];
#pragma unroll
                for (int e = 1; e < NE; ++e) if (lg[e] > v1) { v1 = lg[e]; i1 = e; }
                int i2 = -1; float v2 = -3.0e38f;
#pragma unroll
                for (int e = 0; e < NE; ++e) if (e != i1 && lg[e] > v2) { v2 = lg[e]; i2 = e; }
                const float e2 = __expf(v2 - v1), g1 = 1.f / (1.f + e2), g2 = e2 / (1.f + e2);
                if (lane == 0) { sel[2 * tl] = i1; sel[2 * tl + 1] = i2; GATEW[2 * t] = g1; GATEW[2 * t + 1] = g2; }
#pragma unroll
                for (int j = 0; j < 8; ++j) xr[j] = xq[j];
            }
            __syncthreads();
            if (tid < NE) { int n = 0; for (int a = 0; a < 64; ++a) n += (sel[a] == tid) ? 1 : 0;
                sel[64 + tid] = n ? (int)__hip_atomic_fetch_add(CNT + tid, (unsigned)n, __ATOMIC_RELAXED, __HIP_MEMORY_SCOPE_AGENT) : 0; }
            __syncthreads();
            if (tid < 64) { const int e = sel[tid]; int rank = 0; for (int a = 0; a < tid; ++a) rank += (sel[a] == e) ? 1 : 0;
                const int ent = 2 * (t0 + (tid >> 1)) + (tid & 1), pos = sel[64 + e] + rank; LIST[e * T + pos] = ent; INV[ent] = e * T + pos; }
            __syncthreads();
        }
    }
    SEAM(12);
    if (IN(13) || IN(14)) {
        volatile LAS int* tab = (volatile LAS int*)(lds + MISC_OFF + 12288);
        if (tid < NE) tab[tid] = (int)__hip_atomic_load(ctl + CW_CNT + tid, __ATOMIC_RELAXED, __HIP_MEMORY_SCOPE_AGENT);
        __syncthreads();
        if (tid == 0) { int p = 0; for (int e = 0; e < NE; ++e) { tab[8 + e] = p; p += (tab[e] + BM - 1) / BM; } tab[16] = p; }
        __syncthreads();
        REP(13) if (IN(13)) {
            Gemm g{(const bf16_t*)(ws + WS_HA), WB + WT_MGU, 2 * FF, D, (size_t)2 * FF * D}; MoeOrder Mo; Mo.init(tab, (const int*)(ws + WS_LIST), 2 * FF / BM, G, (int)blockIdx.x);
            EpiGateUp<true> E{(bf16_t*)(ws + WS_MACT), PART + 24 * T, (const int*)(ws + WS_LIST)};
            gemm_phase<EpiGateUp<true>, MoeOrder, 1, true, true>(lds, g, Mo, E);
        }
        SEAM(13);
        REP(14) if (IN(14)) {
            Gemm g{(const bf16_t*)(ws + WS_MACT), WB + WT_MDN, D, FF, (size_t)FF * D}; MoeOrder Mo; Mo.init(tab, (const int*)(ws + WS_LIST), D / BM, G, (int)blockIdx.x); Mo.ksplit = (G == 256 && Mo.nwg >= 2 * G) ? 1 : 0; Mo.KT4 = FF / 128 / 4;
            EpiMoeDown E{(bf16_t*)(ws + WS_CONTRIB), (const int*)(ws + WS_LIST), (const float*)(ws + WS_GATEW), (float*)(ws + WS_PARTK)};
            gemm_phase<EpiMoeDown, MoeOrder, 0, false, true>(lds, g, Mo, E);
        }
    }
    SEAM(14);
    REP(15) if (IN(15)) { PHASE_IDS();
        const float* X3 = (const float*)(ws + WS_X1); const bf16_t* C = (const bf16_t*)(ws + WS_CONTRIB); const float* gn = args.in[29];
        const int* INV = (const int*)(ws + WS_INV); const float* GATEW = (const float*)(ws + WS_GATEW); const float* PARTK = (const float*)(ws + WS_PARTK);
        volatile LAS int* tab = (volatile LAS int*)(lds + MISC_OFF + 12288);
        __syncthreads();
        if (tid < NE) tab[tid] = (int)__hip_atomic_load(ctl + CW_CNT + tid, __ATOMIC_RELAXED, __HIP_MEMORY_SCOPE_AGENT);
        __syncthreads();
        if (tid == 0) { int p = 0; for (int e = 0; e < NE; ++e) { tab[8 + e] = p; p += (tab[e] + BM - 1) / BM; } tab[16] = p; }
        __syncthreads();
        const int nwg = __builtin_amdgcn_readfirstlane(tab[16]) * (D / BM); const bool ksplit = (G == 256 && nwg >= 2 * G);
        const int cq = nwg / NXCD, cr = nwg % NXCD, cb_ = cr * (cq + 1);
        for (int t = gw; t < T; t += NGW) { f32x4 v[8]; float ss = 0.f;
            u32x2 ca[2][8];
#pragma unroll
            for (int j = 0; j < 8; ++j) { v[j] = *(const f32x4*)(X3 + (size_t)t * D + lane * 4 + 256 * j);
                ca[0][j] = *(const u32x2*)(C + (size_t)(2 * t) * D + lane * 4 + 256 * j); ca[1][j] = *(const u32x2*)(C + (size_t)(2 * t + 1) * D + lane * 4 + 256 * j); }
            unsigned smask = 0u;
            int ridx_[2][8]; int lr_[2] = {0, 0}; float gw8_[2] = {0.f, 0.f};
            if (ksplit) {
#pragma unroll
                for (int k = 0; k < 2; ++k) { const int ent = 2 * t + k; const int inv = __builtin_amdgcn_readfirstlane(INV[ent]); const int e = inv >> 13, li = inv & (T - 1);
                    const int p0 = __builtin_amdgcn_readfirstlane(tab[8 + e]), npan = __builtin_amdgcn_readfirstlane(tab[9 + e]) - p0, pl = li >> 8; lr_[k] = li & 255; gw8_[k] = GATEW[ent] * W8_INV;
#pragma unroll
                    for (int j = 0; j < 8; ++j) { const int wg = p0 * (D / BM) + j * npan + pl; int x, off;
                        if (wg < cb_) { x = wg / (cq + 1); off = wg - x * (cq + 1); } else { const int w2 = wg - cb_; x = w2 / cq; off = w2 - x * cq; x += cr; }
                        ridx_[k][j] = (off - 2 * G / NXCD) * NXCD + x; if (off >= 2 * G / NXCD) smask |= 1u << (k * 8 + j); } } }
#pragma unroll
            for (int k = 0; k < 2; ++k)
#pragma unroll
                for (int j = 0; j < 8; ++j) { const u32x2 c2 = ca[k][j];
                    const f32x4 cv = {__uint_as_float(c2.x << 16), __uint_as_float(c2.x & 0xffff0000u), __uint_as_float(c2.y << 16), __uint_as_float(c2.y & 0xffff0000u)};
                    if (!((smask >> (k * 8 + j)) & 1u)) v[j] = v[j] + cv; }
            if (smask) {
#pragma unroll
                for (int k = 0; k < 2; ++k)
#pragma unroll
                    for (int j = 0; j < 8; ++j) if ((smask >> (k * 8 + j)) & 1u) { const float* pp = PARTK + ((size_t)(ridx_[k][j] * 4) << 16) + lr_[k] * BM + lane * 4;
                        const f32x4 sm = (*(const f32x4*)pp + *(const f32x4*)(pp + 65536)) + (*(const f32x4*)(pp + 2 * 65536) + *(const f32x4*)(pp + 3 * 65536));
                        v[j] = v[j] + sm * gw8_[k]; } }
#pragma unroll
            for (int j = 0; j < 8; ++j) ss += (v[j][0] * v[j][0] + v[j][1] * v[j][1]) + (v[j][2] * v[j][2] + v[j][3] * v[j][3]);
            ss = wave_sum(ss); const float rs = rsqrtf(ss * (1.0f / D) + EPS);
#pragma unroll
            for (int j = 0; j < 8; ++j) { const int c0 = lane * 4 + 256 * j; *(f32x4*)(args.out + (size_t)t * D + c0) = v[j] * rs * *(const f32x4*)(gn + c0); } }
    }
#undef IN
#undef SEAM
}

static int g_grid = 0;
static void mega_launch(hipStream_t st, const float* const* in, float* out, unsigned char* ws, int lo, int hi) {
    MArgs a{};
    for (int i = 0; i < 30; ++i) a.in[i] = in[i];
    a.out = out; a.ws = ws; a.ph_lo = lo; a.ph_hi = hi;
    hipLaunchKernelGGL(mega, dim3(g_grid), dim3(NTHR), LDS_BYTES, st, a);
}

extern "C" void kernel_launch(void* const* d_in, const int* in_sizes, int n_in, void* d_out, int out_size, void* d_ws, size_t ws_size, hipStream_t stream) {
    if (n_in != 30 || out_size != T * D || ws_size < WS_END2) { fprintf(stderr, "kernel_launch: unexpected shapes n_in %d out %d ws %zu (need %zu)\n", n_in, out_size, ws_size, (size_t)WS_END); return; }
    const float* const* in = (const float* const*)d_in;
    unsigned char* ws = (unsigned char*)d_ws;
    if (g_grid == 0) {
        int dev = 0, cus = 0;
        if (hipGetDevice(&dev) != hipSuccess || hipDeviceGetAttribute(&cus, hipDeviceAttributeMultiprocessorCount, dev) != hipSuccess) { fprintf(stderr, "kernel_launch: device query failed\n"); return; }
        if (hipFuncSetAttribute((const void*)mega, hipFuncAttributeMaxDynamicSharedMemorySize, LDS_BYTES) != hipSuccess) { fprintf(stderr, "kernel_launch: hipFuncSetAttribute failed\n"); return; }
        int per_cu = 0;
        if (hipOccupancyMaxActiveBlocksPerMultiprocessor(&per_cu, (const void*)mega, NTHR, LDS_BYTES) != hipSuccess || per_cu < 1) { fprintf(stderr, "kernel_launch: occupancy query says %d\n", per_cu); (void)hipGetLastError(); }
        g_grid = cus;
    }
    (void)hipMemsetAsync(ws + WS_CTL, 0, CTL_BYTES, stream);
    mega_launch(stream, in, (float*)d_out, ws, 0, 16);
}
```
